# Optimizing an MI355X kernel written in HIP

```python
import jax, jax.numpy as jnp
from jax import lax
import numpy as np

D_MODEL = 2048
BATCH = 4
SEQ = 2048
DEPTH = 1

CHUNK = 64
Q_BLOCK = 128
SB_HEADS = 8
HEAD_DIM = 128
SB_WIDTH = SB_HEADS * HEAD_DIM
MLA_HEADS = 8
MLA_Q_RANK = 512
MLA_KV_RANK = 256
MLA_NOPE = 128
MLA_ROPE = 64
MLA_V = 128
MLA_WIDTH = MLA_HEADS * MLA_V
MIX_WIDTH = SB_WIDTH + MLA_WIDTH
IN_PROJ = 3 * SB_WIDTH + MLA_Q_RANK + MLA_KV_RANK + MLA_ROPE
ROPE_THETA = 10000.0
N_EXPERTS = 32
TOP_K = 4
D_FF = 2048
SWIGLU_LIMIT = 7.0
SWIGLU_ALPHA = 1.702
MOE_BLOCK = 128
LN_EPS = 1e-5
RMS_EPS = 1e-6
DEEPNORM_ALPHA = (2 * DEPTH) ** 0.25
DEEPNORM_BETA = (8 * DEPTH) ** -0.25

kernel_name = 'hybrid_sb_mla_moe_deepnorm'


def layer_norm(x, g, b):
    xf = x.astype(jnp.float32)
    mu = jnp.mean(xf, -1, keepdims=True)
    xc = xf - mu
    var = jnp.mean(xc * xc, -1, keepdims=True)
    return (xc * lax.rsqrt(var + LN_EPS) * g.astype(jnp.float32) + b.astype(jnp.float32)).astype(x.dtype)


def rms_norm(x, g):
    xf = x.astype(jnp.float32)
    ms = jnp.mean(xf * xf, -1, keepdims=True)
    return (xf * lax.rsqrt(ms + RMS_EPS) * g.astype(jnp.float32)).astype(x.dtype)


def rope(x, positions):
    half = x.shape[-1] // 2
    inv_freq = ROPE_THETA ** (-(jnp.arange(half, dtype=jnp.float32) * 2.0 / x.shape[-1]))
    ang = positions[..., None].astype(jnp.float32) * inv_freq
    cos = jnp.cos(ang)[:, :, None, :]
    sin = jnp.sin(ang)[:, :, None, :]
    xf = x.astype(jnp.float32)
    x1, x2 = xf[..., :half], xf[..., half:]
    return jnp.concatenate([x1 * cos - x2 * sin, x2 * cos + x1 * sin], -1).astype(x.dtype)


def stick_breaking_attention(q, k, v):
    S = q.shape[1]
    scale = q.shape[-1] ** -0.5
    outs = []
    for qb in range(S // Q_BLOCK):
        q0 = qb * Q_BLOCK
        kend = q0 + Q_BLOCK
        z = jnp.einsum('bqhd,bkhd->bhqk', q[:, q0:kend], k[:, :kend],
                       preferred_element_type=jnp.float32) * scale
        t_idx = (q0 + jnp.arange(Q_BLOCK))[:, None]
        s_idx = jnp.arange(kend)[None, :]
        past = s_idx < t_idx
        neg_log_keep = jnp.where(past, jax.nn.softplus(z), 0.0)
        between = lax.cumsum(neg_log_keep, axis=3, reverse=True) - neg_log_keep
        w = jnp.where(past, jnp.exp(jax.nn.log_sigmoid(z) - between), 0.0)
        outs.append(jnp.einsum('bhqk,bkhd->bqhd', w.astype(v.dtype), v[:, :kend]))
    return jnp.concatenate(outs, axis=1)


def chunk_causal_softmax_attention(q, k, v):
    S = q.shape[1]
    scale = q.shape[-1] ** -0.5
    outs = []
    for qb in range(S // Q_BLOCK):
        q0 = qb * Q_BLOCK
        kend = q0 + Q_BLOCK
        s = jnp.einsum('bqhd,bkhd->bhqk', q[:, q0:kend], k[:, :kend],
                       preferred_element_type=jnp.float32) * scale
        t_chunk = (q0 + jnp.arange(Q_BLOCK))[:, None] // CHUNK
        s_chunk = jnp.arange(kend)[None, :] // CHUNK
        s = jnp.where(s_chunk <= t_chunk, s, -jnp.inf)
        p = jax.nn.softmax(s, axis=-1)
        outs.append(jnp.einsum('bhqk,bkhd->bqhd', p.astype(v.dtype), v[:, :kend]))
    return jnp.concatenate(outs, axis=1)


def hybrid_mixer(h, positions, w_in, q_a_norm, w_q_b, kv_a_norm, w_kv_b, sb_out_norm, mla_out_norm, w_o):
    B, S, _ = h.shape
    u = h @ w_in
    splits = [SB_WIDTH, 2 * SB_WIDTH, 3 * SB_WIDTH,
              3 * SB_WIDTH + MLA_Q_RANK, 3 * SB_WIDTH + MLA_Q_RANK + MLA_KV_RANK]
    sb_q, sb_k, sb_v, q_lat, kv_lat, k_rope = jnp.split(u, splits, axis=-1)
    hs = (B, S, SB_HEADS, HEAD_DIM)
    sb_o = stick_breaking_attention(sb_q.reshape(hs), sb_k.reshape(hs), sb_v.reshape(hs))
    sb_o = rms_norm(sb_o.reshape(B, S, SB_WIDTH), sb_out_norm)
    q = (rms_norm(q_lat, q_a_norm) @ w_q_b).reshape(B, S, MLA_HEADS, MLA_NOPE + MLA_ROPE)
    q_nope, q_pe = q[..., :MLA_NOPE], rope(q[..., MLA_NOPE:], positions)
    kv = (rms_norm(kv_lat, kv_a_norm) @ w_kv_b).reshape(B, S, MLA_HEADS, MLA_NOPE + MLA_V)
    k_nope, mla_v = kv[..., :MLA_NOPE], kv[..., MLA_NOPE:]
    k_pe = jnp.broadcast_to(rope(k_rope[:, :, None, :], positions), (B, S, MLA_HEADS, MLA_ROPE))
    mla_q = jnp.concatenate([q_nope, q_pe], -1)
    mla_k = jnp.concatenate([k_nope, k_pe], -1)
    mla_o = chunk_causal_softmax_attention(mla_q, mla_k, mla_v)
    mla_o = rms_norm(mla_o.reshape(B, S, MLA_WIDTH), mla_out_norm)
    return jnp.concatenate([sb_o, mla_o], -1) @ w_o


def moe_ffn(h, w_router, b_router, w_gate_up, b_gate_up, w_down, b_down):
    B, S, D = h.shape
    T = B * S
    xf = h.reshape(T, D)
    logits = (xf @ w_router + b_router).astype(jnp.float32)
    top_vals, top_idx = lax.top_k(logits, TOP_K)
    gates = jax.nn.softmax(top_vals, axis=-1)
    n_assign = T * TOP_K
    e_flat = top_idx.reshape(-1)
    tok_flat = jnp.arange(n_assign, dtype=jnp.int32) // TOP_K
    gate_flat = gates.reshape(-1)
    order = jnp.argsort(e_flat)
    e_sorted = e_flat[order]
    counts = jnp.bincount(e_flat, length=N_EXPERTS)
    starts = jnp.cumsum(counts) - counts
    padded = ((counts + MOE_BLOCK - 1) // MOE_BLOCK) * MOE_BLOCK
    padded_ends = jnp.cumsum(padded)
    padded_starts = padded_ends - padded
    rank = jnp.arange(n_assign, dtype=jnp.int32) - starts[e_sorted]
    dest = padded_starts[e_sorted] + rank
    n_rows = n_assign + N_EXPERTS * MOE_BLOCK
    n_blocks = n_rows // MOE_BLOCK
    row_tok = jnp.zeros((n_rows,), jnp.int32).at[dest].set(tok_flat[order])
    row_gate = jnp.zeros((n_rows,), jnp.float32).at[dest].set(gate_flat[order])
    block_expert = jnp.minimum(
        jnp.searchsorted(padded_ends, jnp.arange(n_blocks, dtype=jnp.int32) * MOE_BLOCK, side='right'),
        N_EXPERTS - 1)
    x_rows = xf[row_tok].reshape(n_blocks, MOE_BLOCK, D)

    def expert_block(args):
        xb, e = args
        gu = xb @ w_gate_up[e] + b_gate_up[e]
        g, up = gu[:, :D_FF], gu[:, D_FF:]
        g = jnp.minimum(g, SWIGLU_LIMIT)
        up = jnp.clip(up, -SWIGLU_LIMIT, SWIGLU_LIMIT)
        act = (up + 1.0) * (g * jax.nn.sigmoid(SWIGLU_ALPHA * g))
        return act @ w_down[e] + b_down[e]

    y_rows = lax.map(expert_block, (x_rows, block_expert)).reshape(n_rows, D)
    out = jnp.zeros((T, D), jnp.float32).at[row_tok].add(y_rows.astype(jnp.float32) * row_gate[:, None])
    return out.astype(h.dtype).reshape(B, S, D)


def setup_inputs(seed: int = 0) -> dict:
    key = jax.random.key(seed)
    ks = jax.random.split(key, 24)
    f32 = jnp.float32

    def nrm(k, shape, scale):
        return jax.random.normal(k, shape, f32) * scale

    x = jax.random.normal(ks[0], (BATCH, SEQ, D_MODEL), f32)
    offs = jax.random.randint(ks[1], (BATCH, 1), 0, 64, dtype=jnp.int32) * CHUNK
    positions = offs + jnp.arange(SEQ, dtype=jnp.int32)[None, :]
    ln_in_g = 1.0 + nrm(ks[2], (D_MODEL,), 0.02)
    ln_in_b = nrm(ks[3], (D_MODEL,), 0.02)
    in_scale = jnp.ones((IN_PROJ,), f32).at[2 * SB_WIDTH:3 * SB_WIDTH].set(DEEPNORM_BETA)
    w_in = nrm(ks[4], (DEPTH, D_MODEL, IN_PROJ), D_MODEL ** -0.5) * in_scale
    q_a_norm = 1.0 + nrm(ks[5], (DEPTH, MLA_Q_RANK), 0.02)
    w_q_b = nrm(ks[6], (DEPTH, MLA_Q_RANK, MLA_HEADS * (MLA_NOPE + MLA_ROPE)), MLA_Q_RANK ** -0.5)
    kv_a_norm = 1.0 + nrm(ks[7], (DEPTH, MLA_KV_RANK), 0.02)
    kv_scale = jnp.tile(jnp.concatenate([jnp.ones((MLA_NOPE,), f32),
                                         jnp.full((MLA_V,), DEEPNORM_BETA, f32)]), MLA_HEADS)
    w_kv_b = nrm(ks[8], (DEPTH, MLA_KV_RANK, MLA_HEADS * (MLA_NOPE + MLA_V)), MLA_KV_RANK ** -0.5) * kv_scale
    sb_out_norm = 1.0 + nrm(ks[9], (DEPTH, SB_WIDTH), 0.02)
    mla_out_norm = 1.0 + nrm(ks[10], (DEPTH, MLA_WIDTH), 0.02)
    w_o = nrm(ks[11], (DEPTH, MIX_WIDTH, D_MODEL), MIX_WIDTH ** -0.5 * DEEPNORM_BETA)
    ln_mix_g = 1.0 + nrm(ks[12], (DEPTH, D_MODEL), 0.02)
    ln_mix_b = nrm(ks[13], (DEPTH, D_MODEL), 0.02)
    w_router = nrm(ks[14], (DEPTH, D_MODEL, N_EXPERTS), D_MODEL ** -0.5)
    b_router = nrm(ks[15], (DEPTH, N_EXPERTS), 0.01)
    w_gate_up = nrm(ks[16], (DEPTH, N_EXPERTS, D_MODEL, 2 * D_FF), D_MODEL ** -0.5 * DEEPNORM_BETA)
    b_gate_up = nrm(ks[17], (DEPTH, N_EXPERTS, 2 * D_FF), 0.02)
    w_down = nrm(ks[18], (DEPTH, N_EXPERTS, D_FF, D_MODEL), D_FF ** -0.5 * DEEPNORM_BETA)
    b_down = nrm(ks[19], (DEPTH, N_EXPERTS, D_MODEL), 0.02)
    ln_ffn_g = 1.0 + nrm(ks[20], (DEPTH, D_MODEL), 0.02)
    ln_ffn_b = nrm(ks[21], (DEPTH, D_MODEL), 0.02)
    return {'x': x, 'positions': positions, 'ln_in_g': ln_in_g, 'ln_in_b': ln_in_b,
            'w_in': w_in, 'q_a_norm': q_a_norm, 'w_q_b': w_q_b, 'kv_a_norm': kv_a_norm,
            'w_kv_b': w_kv_b, 'sb_out_norm': sb_out_norm, 'mla_out_norm': mla_out_norm,
            'w_o': w_o, 'ln_mix_g': ln_mix_g, 'ln_mix_b': ln_mix_b,
            'w_router': w_router, 'b_router': b_router, 'w_gate_up': w_gate_up,
            'b_gate_up': b_gate_up, 'w_down': w_down, 'b_down': b_down,
            'ln_ffn_g': ln_ffn_g, 'ln_ffn_b': ln_ffn_b}


def reference(x, positions, ln_in_g, ln_in_b, w_in, q_a_norm, w_q_b, kv_a_norm, w_kv_b,
              sb_out_norm, mla_out_norm, w_o, ln_mix_g, ln_mix_b, w_router, b_router,
              w_gate_up, b_gate_up, w_down, b_down, ln_ffn_g, ln_ffn_b):
    h = layer_norm(x, ln_in_g, ln_in_b)
    for l in range(DEPTH):
        mix = hybrid_mixer(h, positions, w_in[l], q_a_norm[l], w_q_b[l], kv_a_norm[l], w_kv_b[l],
                           sb_out_norm[l], mla_out_norm[l], w_o[l])
        h = layer_norm(DEEPNORM_ALPHA * h + mix, ln_mix_g[l], ln_mix_b[l])
        ffn = moe_ffn(h, w_router[l], b_router[l], w_gate_up[l], b_gate_up[l], w_down[l], b_down[l])
        h = layer_norm(DEEPNORM_ALPHA * h + ffn, ln_ffn_g[l], ln_ffn_b[l])
    return h
```

```cpp
#include <hip/hip_runtime.h>
#include <stdint.h>

#define DI __device__ __forceinline__
typedef unsigned short bf16_t;
typedef __attribute__((ext_vector_type(8))) short bf16x8;
typedef __attribute__((ext_vector_type(16))) float f32x16;
typedef __attribute__((ext_vector_type(2))) __bf16 bf16x2_t;
typedef __attribute__((ext_vector_type(2))) float f32x2_t;

constexpr int NTOK = 8192, DM = 2048, SEQ = 2048;
constexpr int INP = 3904;
constexpr int NEXP = 32, DFF = 2048;
constexpr float LN_EPS = 1e-5f, RMS_EPS = 1e-6f;
constexpr float DN_ALPHA = 1.189207115002721f;
constexpr int NTHREADS = 512, NWAVES = 8;

struct Params {
  const float* x; const int* pos; const float* ln_in_g; const float* ln_in_b; const float* w_in;
  const float* q_a_norm; const float* w_q_b; const float* kv_a_norm; const float* w_kv_b;
  const float* sb_out_norm; const float* mla_out_norm; const float* w_o; const float* ln_mix_g; const float* ln_mix_b;
  const float* w_router; const float* b_router; const float* w_gate_up; const float* b_gate_up;
  const float* w_down; const float* b_down; const float* ln_ffn_g; const float* ln_ffn_b;
  float* out;
  int* cnt;
  float* h0f;
  bf16_t* h0b;
  bf16_t* qkv;
  bf16_t* qlat;
  bf16_t* kvlat;
  bf16_t* krope;
  float* rstd_q;
  float* rstd_kv;
  bf16_t* mq;
  bf16_t* mkv;
  bf16_t* oA;
  bf16_t* oB;
  bf16_t* on;
  float* z1;
  float* h1f;
  bf16_t* h1b;
  float* gate;
  int* rowlist;
  bf16_t* act;
  bf16_t* yb;
};

DI unsigned pack2(float a, float b) {
  f32x2_t v = {a, b};
  bf16x2_t r = __builtin_convertvector(v, bf16x2_t);
  return __builtin_bit_cast(unsigned, r);
}
DI bf16_t f2bf(float a) { return (bf16_t)(pack2(a, 0.f) & 0xffffu); }
DI float bf2f(bf16_t h) { return __uint_as_float(((unsigned)h) << 16); }
DI float bflo(unsigned u) { return __uint_as_float(u << 16); }
DI float bfhi(unsigned u) { return __uint_as_float(u & 0xffff0000u); }
DI int crow(int reg, int h) { return (reg & 3) + 8 * (reg >> 2) + 4 * h; }
DI float wave_sum(float v) {
#pragma unroll
  for (int o = 32; o > 0; o >>= 1) v += __shfl_xor(v, o);
  return v;
}
DI float wave_max(float v) {
#pragma unroll
  for (int o = 32; o > 0; o >>= 1) v = fmaxf(v, __shfl_xor(v, o));
  return v;
}

__constant__ float INV_FREQ[32] = {1.000000000e+00f, 7.498942093e-01f, 5.623413252e-01f, 4.216965034e-01f, 3.162277660e-01f, 2.371373706e-01f, 1.778279410e-01f, 1.333521432e-01f, 1.000000000e-01f, 7.498942093e-02f, 5.623413252e-02f, 4.216965034e-02f, 3.162277660e-02f, 2.371373706e-02f, 1.778279410e-02f, 1.333521432e-02f, 1.000000000e-02f, 7.498942093e-03f, 5.623413252e-03f, 4.216965034e-03f, 3.162277660e-03f, 2.371373706e-03f, 1.778279410e-03f, 1.333521432e-03f, 1.000000000e-03f, 7.498942093e-04f, 5.623413252e-04f, 4.216965034e-04f, 3.162277660e-04f, 2.371373706e-04f, 1.778279410e-04f, 1.333521432e-04f};
DI void rope_sc(int pos, int i, float& sn, float& cs) {
  const float ang = (float)pos * INV_FREQ[i];
  double rev = (double)ang * 0.15915494309189535;
  rev -= rint(rev);
  const float fr = (float)rev;
  sn = __builtin_amdgcn_sinf(fr);
  cs = __builtin_amdgcn_cosf(fr);
}
#define MFMA32(a, b, c) __builtin_amdgcn_mfma_f32_32x32x16_bf16((a), (b), (c), 0, 0, 0)

DI void ln_row_store(const float (&v)[32], int lane, const float* g, const float* b, float* outf, bf16_t* outb) {
  float s = 0.f;
#pragma unroll
  for (int i = 0; i < 32; ++i) s += v[i];
  s = wave_sum(s);
  const float mu = s * (1.f / 2048.f);
  float q = 0.f;
#pragma unroll
  for (int i = 0; i < 32; ++i) { const float d = v[i] - mu; q += d * d; }
  q = wave_sum(q);
  const float rs = rsqrtf(q * (1.f / 2048.f) + LN_EPS);
#pragma unroll
  for (int i = 0; i < 8; ++i) {
    const int c = (i * 64 + lane) * 4;
    const float4 gg = *(const float4*)(g + c);
    const float4 bb = *(const float4*)(b + c);
    float4 o;
    o.x = (v[4 * i + 0] - mu) * rs * gg.x + bb.x;
    o.y = (v[4 * i + 1] - mu) * rs * gg.y + bb.y;
    o.z = (v[4 * i + 2] - mu) * rs * gg.z + bb.z;
    o.w = (v[4 * i + 3] - mu) * rs * gg.w + bb.w;
    if (outf) *(float4*)(outf + c) = o;
    if (outb) { uint2 pk; pk.x = pack2(o.x, o.y); pk.y = pack2(o.z, o.w); *(uint2*)(outb + c) = pk; }
  }
}

DI void phase_ln_in(const Params& p, int bid, int nb) {
  const int lane = threadIdx.x & 63, wv = threadIdx.x >> 6;
  for (int t = bid * NWAVES + wv; t < NTOK; t += nb * NWAVES) {
    float v[32];
    const float* xr = p.x + (size_t)t * DM;
#pragma unroll
    for (int i = 0; i < 8; ++i) {
      const float4 a = *(const float4*)(xr + (i * 64 + lane) * 4);
      v[4 * i] = a.x; v[4 * i + 1] = a.y; v[4 * i + 2] = a.z; v[4 * i + 3] = a.w;
    }
    ln_row_store(v, lane, p.ln_in_g, p.ln_in_b, p.h0f + (size_t)t * DM, p.h0b + (size_t)t * DM);
  }
}

constexpr int GA_LD = 40;
constexpr int GB_LD = 136;
constexpr int G_SMEM = 128 * GA_LD * 2 + 32 * GB_LD * 2;

template <class CFG>
DI void gemm_tile(const CFG& cfg, char* smem) {
  bf16_t* As = (bf16_t*)smem;
  bf16_t* Bs = (bf16_t*)(smem + 128 * GA_LD * 2);
  const int tid = threadIdx.x, lane = tid & 63, wv = tid >> 6, wm = wv >> 1, wn = wv & 1;
  const int l31 = lane & 31, hh = lane >> 5;
  const int a_r = tid >> 2, a_c = (tid & 3) * 8;
  const bf16_t* aptr = cfg.arow(a_r);
  const int b_k0 = tid >> 5, b_c = (tid & 31) * 4;
  f32x16 acc0, acc1;
#pragma unroll
  for (int i = 0; i < 16; ++i) { acc0[i] = 0.f; acc1[i] = 0.f; }
  const int K = cfg.K();
  for (int k0 = 0; k0 < K; k0 += 32) {
    uint4 av = make_uint4(0u, 0u, 0u, 0u);
    if (aptr) av = *(const uint4*)(aptr + k0 + a_c);
    const float4 b0 = cfg.bload(k0 + b_k0, b_c);
    const float4 b1 = cfg.bload(k0 + b_k0 + 16, b_c);
    __syncthreads();
    *(uint4*)(As + a_r * GA_LD + a_c) = av;
    { uint2 pk; pk.x = pack2(b0.x, b0.y); pk.y = pack2(b0.z, b0.w); *(uint2*)(Bs + b_k0 * GB_LD + b_c) = pk; }
    { uint2 pk; pk.x = pack2(b1.x, b1.y); pk.y = pack2(b1.z, b1.w); *(uint2*)(Bs + (b_k0 + 16) * GB_LD + b_c) = pk; }
    __syncthreads();
#pragma unroll
    for (int s = 0; s < 2; ++s) {
      const bf16x8 af = *(const bf16x8*)(As + (wm * 32 + l31) * GA_LD + 16 * s + 8 * hh);
      bf16x8 bf0, bf1;
#pragma unroll
      for (int j = 0; j < 8; ++j) {
        const int kk = 16 * s + 8 * hh + j;
        bf0[j] = (short)Bs[kk * GB_LD + wn * 64 + l31];
        bf1[j] = (short)Bs[kk * GB_LD + wn * 64 + 32 + l31];
      }
      acc0 = MFMA32(af, bf0, acc0);
      acc1 = MFMA32(af, bf1, acc1);
    }
  }
#pragma unroll
  for (int i = 0; i < 16; ++i) cfg.epi(wm * 32 + crow(i, hh), wn * 64 + l31, acc0[i], acc1[i]);
  __syncthreads();
}

struct CfgInProj {
  const Params& p; int tm, tn;
  DI int K() const { return DM; }
  DI const bf16_t* arow(int r) const { return p.h0b + (size_t)(tm * 128 + r) * DM; }
  DI float4 bload(int k, int c) const {
    const int gc = tn * 128 + c;
    if (gc < INP) return *(const float4*)(p.w_in + (size_t)k * INP + gc);
    return make_float4(0.f, 0.f, 0.f, 0.f);
  }
  DI void epi(int r, int c, float v0, float v1) const {
    const int t = tm * 128 + r; const int gc = tn * 128 + c;
    if (gc < 3072) { p.qkv[(size_t)t * 3072 + gc] = f2bf(v0); p.qkv[(size_t)t * 3072 + gc + 32] = f2bf(v1); }
    else if (gc < 3584) { p.qlat[(size_t)t * 512 + gc - 3072] = f2bf(v0); p.qlat[(size_t)t * 512 + gc - 3072 + 32] = f2bf(v1); }
    else if (gc < 3840) { p.kvlat[(size_t)t * 256 + gc - 3584] = f2bf(v0); p.kvlat[(size_t)t * 256 + gc - 3584 + 32] = f2bf(v1); }
    else if (gc < 3872) {
      const int i = gc - 3840;
      float sn, cs; rope_sc(p.pos[t], i, sn, cs);
      p.krope[(size_t)t * 64 + i] = f2bf(v0 * cs - v1 * sn);
      p.krope[(size_t)t * 64 + i + 32] = f2bf(v1 * cs + v0 * sn);
    }
  }
};
DI void phase_in_proj(const Params& p, char* smem, int bid, int nb) {
  constexpr int NT = 31;
  for (int u = bid; u < 64 * NT; u += nb) {
    CfgInProj cfg{p, u / NT, u % NT};
    gemm_tile(cfg, smem);
  }
}

DI void phase_rms_stats(const Params& p, int bid, int nb) {
  const int lane = threadIdx.x & 63, wv = threadIdx.x >> 6;
  for (int t = bid * NWAVES + wv; t < NTOK; t += nb * NWAVES) {
    const uint4 a = *(const uint4*)(p.qlat + (size_t)t * 512 + lane * 8);
    float s = bflo(a.x) * bflo(a.x) + bfhi(a.x) * bfhi(a.x) + bflo(a.y) * bflo(a.y) + bfhi(a.y) * bfhi(a.y)
            + bflo(a.z) * bflo(a.z) + bfhi(a.z) * bfhi(a.z) + bflo(a.w) * bflo(a.w) + bfhi(a.w) * bfhi(a.w);
    s = wave_sum(s);
    const uint2 b = *(const uint2*)(p.kvlat + (size_t)t * 256 + lane * 4);
    float s2 = bflo(b.x) * bflo(b.x) + bfhi(b.x) * bfhi(b.x) + bflo(b.y) * bflo(b.y) + bfhi(b.y) * bfhi(b.y);
    s2 = wave_sum(s2);
    if (lane == 0) {
      p.rstd_q[t] = rsqrtf(s * (1.f / 512.f) + RMS_EPS);
      p.rstd_kv[t] = rsqrtf(s2 * (1.f / 256.f) + RMS_EPS);
    }
  }
}

struct CfgMlaQ {
  const Params& p; int tm, tn;
  DI int K() const { return 512; }
  DI const bf16_t* arow(int r) const { return p.qlat + (size_t)(tm * 128 + r) * 512; }
  DI float4 bload(int k, int c) const {
    float4 w = *(const float4*)(p.w_q_b + (size_t)k * 1536 + tn * 128 + c);
    const float g = p.q_a_norm[k];
    w.x *= g; w.y *= g; w.z *= g; w.w *= g;
    return w;
  }
  DI void epi(int r, int c, float v0, float v1) const {
    const int t = tm * 128 + r; const int gc = tn * 128 + c;
    const float rs = p.rstd_q[t];
    v0 *= rs; v1 *= rs;
    const int cb = gc & ~31;
    if ((cb % 192) == 128) {
      const int i = gc - cb;
      float sn, cs; rope_sc(p.pos[t], i, sn, cs);
      const float a = v0 * cs - v1 * sn, b = v1 * cs + v0 * sn;
      v0 = a; v1 = b;
    }
    p.mq[(size_t)t * 1536 + gc] = f2bf(v0);
    p.mq[(size_t)t * 1536 + gc + 32] = f2bf(v1);
  }
};
struct CfgMlaKV {
  const Params& p; int tm, tn;
  DI int K() const { return 256; }
  DI const bf16_t* arow(int r) const { return p.kvlat + (size_t)(tm * 128 + r) * 256; }
  DI float4 bload(int k, int c) const {
    float4 w = *(const float4*)(p.w_kv_b + (size_t)k * 2048 + tn * 128 + c);
    const float g = p.kv_a_norm[k];
    w.x *= g; w.y *= g; w.z *= g; w.w *= g;
    return w;
  }
  DI void epi(int r, int c, float v0, float v1) const {
    const int t = tm * 128 + r; const int gc = tn * 128 + c;
    const float rs = p.rstd_kv[t];
    p.mkv[(size_t)t * 2048 + gc] = f2bf(v0 * rs);
    p.mkv[(size_t)t * 2048 + gc + 32] = f2bf(v1 * rs);
  }
};
DI void phase_mla_proj(const Params& p, char* smem, int bid, int nb) {
  for (int u = bid; u < 64 * 12 + 64 * 16; u += nb) {
    if (u < 64 * 12) { CfgMlaQ cfg{p, u / 12, u % 12}; gemm_tile(cfg, smem); }
    else { const int v = u - 64 * 12; CfgMlaKV cfg{p, v / 16, v % 16}; gemm_tile(cfg, smem); }
  }
}

DI bf16x8 pack_frag(const f32x16& x, int s) {
  uint4 r;
  r.x = pack2(x[8 * s + 0], x[8 * s + 1]); r.y = pack2(x[8 * s + 2], x[8 * s + 3]);
  r.z = pack2(x[8 * s + 4], x[8 * s + 5]); r.w = pack2(x[8 * s + 6], x[8 * s + 7]);
  return __builtin_bit_cast(bf16x8, r);
}

DI void sb_unit(const Params& p, int b, int hd, int qb) {
  const int lane = threadIdx.x & 63, l31 = lane & 31, hh = lane >> 5;
  const size_t tokbase = (size_t)b * SEQ;
  const bf16_t* qp = p.qkv + (tokbase + qb * 32 + l31) * 3072 + hd * 128 + 8 * hh;
  bf16x8 qf[8];
#pragma unroll
  for (int s = 0; s < 8; ++s) qf[s] = *(const bf16x8*)(qp + 16 * s);
  f32x16 o[4];
#pragma unroll
  for (int d = 0; d < 4; ++d)
#pragma unroll
    for (int i = 0; i < 16; ++i) o[d][i] = 0.f;
  float c = 0.f;
  const float scale = 0.08838834764831845f;
  for (int kb = qb; kb >= 0; --kb) {
    const bf16_t* kp = p.qkv + (tokbase + kb * 32 + l31) * 3072 + 1024 + hd * 128 + 8 * hh;
    f32x16 z;
#pragma unroll
    for (int i = 0; i < 16; ++i) z[i] = 0.f;
#pragma unroll
    for (int s = 0; s < 8; ++s) {
      const bf16x8 kf = *(const bf16x8*)(kp + 16 * s);
      z = MFMA32(kf, qf[s], z);
    }
    float sp[16];
    const bool diag = (kb == qb);
#pragma unroll
    for (int i = 0; i < 16; ++i) {
      const float zz = z[i] * scale;
      const float spv = fmaxf(zz, 0.f) + __logf(1.f + __expf(-fabsf(zz)));
      const bool past = !diag || (crow(i, hh) < l31);
      z[i] = zz - spv;
      sp[i] = past ? spv : 0.f;
    }
    float R[4], Rp[4];
#pragma unroll
    for (int g = 0; g < 4; ++g) { R[g] = (sp[4 * g] + sp[4 * g + 1]) + (sp[4 * g + 2] + sp[4 * g + 3]); Rp[g] = __shfl_xor(R[g], 32); }
    f32x16 w;
    float later = 0.f;
#pragma unroll
    for (int g = 3; g >= 0; --g) {
      const float base = c + later + (hh == 0 ? Rp[g] : 0.f);
      float sfx = 0.f;
#pragma unroll
      for (int e = 3; e >= 0; --e) {
        const int i = 4 * g + e;
        const bool past = !diag || (crow(i, hh) < l31);
        w[i] = past ? __expf(z[i] - (base + sfx)) : 0.f;
        sfx += sp[i];
      }
      later += R[g] + Rp[g];
    }
    c += later;
    const bf16x8 wf0 = pack_frag(w, 0), wf1 = pack_frag(w, 1);
    const bf16_t* vp = p.qkv + (tokbase + kb * 32) * 3072 + 2048 + hd * 128 + l31;
#pragma unroll
    for (int d = 0; d < 4; ++d) {
      bf16x8 v0, v1;
#pragma unroll
      for (int j = 0; j < 8; ++j) {
        const int key0 = 8 * (j >> 2) + 4 * hh + (j & 3);
        v0[j] = (short)vp[(size_t)key0 * 3072 + d * 32];
        v1[j] = (short)vp[(size_t)(16 + key0) * 3072 + d * 32];
      }
      o[d] = MFMA32(v0, wf0, o[d]);
      o[d] = MFMA32(v1, wf1, o[d]);
    }
  }
  bf16_t* op = p.oA + (tokbase + qb * 32 + l31) * 1024 + hd * 128;
#pragma unroll
  for (int d = 0; d < 4; ++d)
#pragma unroll
    for (int g = 0; g < 4; ++g) {
      uint2 pk; pk.x = pack2(o[d][4 * g], o[d][4 * g + 1]); pk.y = pack2(o[d][4 * g + 2], o[d][4 * g + 3]);
      *(uint2*)(op + d * 32 + 8 * g + 4 * hh) = pk;
    }
}

DI void mla_unit(const Params& p, int b, int hd, int qb) {
  const int lane = threadIdx.x & 63, l31 = lane & 31, hh = lane >> 5;
  const size_t tokbase = (size_t)b * SEQ;
  const bf16_t* qp = p.mq + (tokbase + qb * 32 + l31) * 1536 + hd * 192 + 8 * hh;
  bf16x8 qf[12];
#pragma unroll
  for (int s = 0; s < 12; ++s) qf[s] = *(const bf16x8*)(qp + 16 * s);
  f32x16 o[4];
#pragma unroll
  for (int d = 0; d < 4; ++d)
#pragma unroll
    for (int i = 0; i < 16; ++i) o[d][i] = 0.f;
  float mrun = -1e30f, lrun = 0.f;
  const float scale = 0.07216878364870322f;
  const int kend = ((qb >> 1) + 1) * 2;
  for (int kb = 0; kb < kend; ++kb) {
    const bf16_t* kp = p.mkv + (tokbase + kb * 32 + l31) * 2048 + hd * 256 + 8 * hh;
    const bf16_t* rp = p.krope + (tokbase + kb * 32 + l31) * 64 + 8 * hh;
    f32x16 z;
#pragma unroll
    for (int i = 0; i < 16; ++i) z[i] = 0.f;
#pragma unroll
    for (int s = 0; s < 8; ++s) {
      const bf16x8 kf = *(const bf16x8*)(kp + 16 * s);
      z = MFMA32(kf, qf[s], z);
    }
#pragma unroll
    for (int s = 0; s < 4; ++s) {
      const bf16x8 kf = *(const bf16x8*)(rp + 16 * s);
      z = MFMA32(kf, qf[8 + s], z);
    }
    float mx = -1e30f;
#pragma unroll
    for (int i = 0; i < 16; ++i) { z[i] *= scale; mx = fmaxf(mx, z[i]); }
    mx = fmaxf(mx, __shfl_xor(mx, 32));
    const float mnew = fmaxf(mrun, mx);
    const float alpha = __expf(mrun - mnew);
    float ls = 0.f;
#pragma unroll
    for (int i = 0; i < 16; ++i) { z[i] = __expf(z[i] - mnew); ls += z[i]; }
    ls += __shfl_xor(ls, 32);
    lrun = lrun * alpha + ls;
    mrun = mnew;
#pragma unroll
    for (int d = 0; d < 4; ++d)
#pragma unroll
      for (int i = 0; i < 16; ++i) o[d][i] *= alpha;
    const bf16x8 wf0 = pack_frag(z, 0), wf1 = pack_frag(z, 1);
    const bf16_t* vp = p.mkv + (tokbase + kb * 32) * 2048 + hd * 256 + 128 + l31;
#pragma unroll
    for (int d = 0; d < 4; ++d) {
      bf16x8 v0, v1;
#pragma unroll
      for (int j = 0; j < 8; ++j) {
        const int key0 = 8 * (j >> 2) + 4 * hh + (j & 3);
        v0[j] = (short)vp[(size_t)key0 * 2048 + d * 32];
        v1[j] = (short)vp[(size_t)(16 + key0) * 2048 + d * 32];
      }
      o[d] = MFMA32(v0, wf0, o[d]);
      o[d] = MFMA32(v1, wf1, o[d]);
    }
  }
  const float inv = 1.f / lrun;
  bf16_t* op = p.oB + (tokbase + qb * 32 + l31) * 1024 + hd * 128;
#pragma unroll
  for (int d = 0; d < 4; ++d)
#pragma unroll
    for (int g = 0; g < 4; ++g) {
      uint2 pk; pk.x = pack2(o[d][4 * g] * inv, o[d][4 * g + 1] * inv); pk.y = pack2(o[d][4 * g + 2] * inv, o[d][4 * g + 3] * inv);
      *(uint2*)(op + d * 32 + 8 * g + 4 * hh) = pk;
    }
}

DI void phase_attn(const Params& p, int bid, int nb) {
  const int wv = threadIdx.x >> 6;
  const int nwv = blockDim.x >> 6;
  for (int u = bid * nwv + wv; u < 4096; u += nb * nwv) {
    const int qb = 63 - (u >> 6);
    const int r = u & 63;
    const int kind = r & 1, hd = (r >> 1) & 7, b = r >> 4;
    if (kind == 0) sb_unit(p, b, hd, qb); else mla_unit(p, b, hd, qb);
  }
}

DI void phase_attn_norm(const Params& p, int bid, int nb) {
  const int lane = threadIdx.x & 63, wv = threadIdx.x >> 6;
  for (int t = bid * NWAVES + wv; t < NTOK; t += nb * NWAVES) {
#pragma unroll
    for (int grp = 0; grp < 2; ++grp) {
      const bf16_t* src = (grp ? p.oB : p.oA) + (size_t)t * 1024 + lane * 16;
      const float* g = (grp ? p.mla_out_norm : p.sb_out_norm) + lane * 16;
      const uint4 a0 = *(const uint4*)src, a1 = *(const uint4*)(src + 8);
      float v[16] = {bflo(a0.x), bfhi(a0.x), bflo(a0.y), bfhi(a0.y), bflo(a0.z), bfhi(a0.z), bflo(a0.w), bfhi(a0.w),
                     bflo(a1.x), bfhi(a1.x), bflo(a1.y), bfhi(a1.y), bflo(a1.z), bfhi(a1.z), bflo(a1.w), bfhi(a1.w)};
      float s = 0.f;
#pragma unroll
      for (int i = 0; i < 16; ++i) s += v[i] * v[i];
      s = wave_sum(s);
      const float rs = rsqrtf(s * (1.f / 1024.f) + RMS_EPS);
      uint4 o0, o1;
      o0.x = pack2(v[0] * rs * g[0], v[1] * rs * g[1]); o0.y = pack2(v[2] * rs * g[2], v[3] * rs * g[3]);
      o0.z = pack2(v[4] * rs * g[4], v[5] * rs * g[5]); o0.w = pack2(v[6] * rs * g[6], v[7] * rs * g[7]);
      o1.x = pack2(v[8] * rs * g[8], v[9] * rs * g[9]); o1.y = pack2(v[10] * rs * g[10], v[11] * rs * g[11]);
      o1.z = pack2(v[12] * rs * g[12], v[13] * rs * g[13]); o1.w = pack2(v[14] * rs * g[14], v[15] * rs * g[15]);
      bf16_t* dst = p.on + (size_t)t * 2048 + grp * 1024 + lane * 16;
      *(uint4*)dst = o0; *(uint4*)(dst + 8) = o1;
    }
  }
}

struct CfgWo {
  const Params& p; int tm, tn;
  DI int K() const { return 2048; }
  DI const bf16_t* arow(int r) const { return p.on + (size_t)(tm * 128 + r) * 2048; }
  DI float4 bload(int k, int c) const { return *(const float4*)(p.w_o + (size_t)k * 2048 + tn * 128 + c); }
  DI void epi(int r, int c, float v0, float v1) const {
    const size_t o = (size_t)(tm * 128 + r) * 2048 + tn * 128 + c;
    p.z1[o] = DN_ALPHA * p.h0f[o] + v0;
    p.z1[o + 32] = DN_ALPHA * p.h0f[o + 32] + v1;
  }
};
DI void phase_wo(const Params& p, char* smem, int bid, int nb) {
  for (int u = bid; u < 64 * 16; u += nb) { CfgWo cfg{p, u / 16, u % 16}; gemm_tile(cfg, smem); }
}

DI void phase_ln_router(const Params& p, char* smem, int bid, int nb) {
  float* hs = (float*)smem;
  float* red = hs + 8 * 2048;
  float* lg = red + 16 * 8 * 32;
  const int tid = threadIdx.x, lane = tid & 63, wv = tid >> 6;
  for (int t0 = bid * 8; t0 < NTOK; t0 += nb * 8) {
    const int t = t0 + wv;
    {
      float v[32];
      const float* zr = p.z1 + (size_t)t * DM;
#pragma unroll
      for (int i = 0; i < 8; ++i) {
        const float4 a = *(const float4*)(zr + (i * 64 + lane) * 4);
        v[4 * i] = a.x; v[4 * i + 1] = a.y; v[4 * i + 2] = a.z; v[4 * i + 3] = a.w;
      }
      ln_row_store(v, lane, p.ln_mix_g, p.ln_mix_b, p.h1f + (size_t)t * DM, p.h1b + (size_t)t * DM);
    }
    __syncthreads();
    for (int i = tid; i < 8 * 512; i += NTHREADS) {
      const int tok = i >> 9, c4 = i & 511;
      *(float4*)(hs + tok * 2048 + c4 * 4) = *(const float4*)(p.h1f + (size_t)(t0 + tok) * DM + c4 * 4);
    }
    __syncthreads();
    {
      const int e = tid & 31, ks = tid >> 5;
      float acc[8];
#pragma unroll
      for (int j = 0; j < 8; ++j) acc[j] = 0.f;
      for (int k = ks * 128; k < ks * 128 + 128; ++k) {
        const float w = p.w_router[(size_t)k * 32 + e];
#pragma unroll
        for (int j = 0; j < 8; ++j) acc[j] += hs[j * 2048 + k] * w;
      }
#pragma unroll
      for (int j = 0; j < 8; ++j) red[(ks * 8 + j) * 32 + e] = acc[j];
    }
    __syncthreads();
    if (tid < 256) {
      const int e = tid & 31, j = tid >> 5;
      float s = 0.f;
#pragma unroll
      for (int ks = 0; ks < 16; ++ks) s += red[(ks * 8 + j) * 32 + e];
      lg[j * 32 + e] = s + p.b_router[e];
    }
    __syncthreads();
    {
      float val = (lane < 32) ? lg[wv * 32 + lane] : -3.0e38f;
      float tv[4]; int ti[4];
#pragma unroll
      for (int k = 0; k < 4; ++k) {
        const float m = wave_max(val);
        const unsigned long long bal = __ballot(val == m);
        const int idx = __ffsll((long long)bal) - 1;
        tv[k] = m; ti[k] = idx;
        if (lane == idx) val = -3.0e38f;
      }
      const float e1 = __expf(tv[1] - tv[0]), e2 = __expf(tv[2] - tv[0]), e3 = __expf(tv[3] - tv[0]);
      const float inv = 1.f / (1.f + e1 + e2 + e3);
      if (lane < 4) {
        const float gk = (lane == 0 ? 1.f : lane == 1 ? e1 : lane == 2 ? e2 : e3) * inv;
        const int ek = lane == 0 ? ti[0] : lane == 1 ? ti[1] : lane == 2 ? ti[2] : ti[3];
        const int pos = atomicAdd(p.cnt + ek, 1);
        p.rowlist[ek * 8192 + pos] = t * 4 + lane;
        p.gate[t * 4 + lane] = gk;
      }
    }
    __syncthreads();
  }
}

struct MoeSched { int base[33]; int mt[32]; };
DI void moe_sched_build(const Params& p, MoeSched* s, int ntn) {
  if (threadIdx.x == 0) {
    int acc = 0;
    for (int e = 0; e < 32; ++e) { const int m = (p.cnt[e] + 127) >> 7; s->mt[e] = m; s->base[e] = acc; acc += m * ntn; }
    s->base[32] = acc;
  }
  __syncthreads();
}

struct CfgMoe1 {
  const Params& p; int e, m0, tn, cnt;
  DI int K() const { return DM; }
  DI const bf16_t* arow(int r) const {
    const int rr = m0 + r;
    if (rr >= cnt) return nullptr;
    const int a = p.rowlist[e * 8192 + rr];
    return p.h1b + (size_t)(a >> 2) * DM;
  }
  DI float4 bload(int k, int c) const {
    const int wn = c >> 6, nbk = (c >> 5) & 1, i = c & 31;
    const int gc = nbk * 2048 + tn * 64 + wn * 32 + i;
    return *(const float4*)(p.w_gate_up + ((size_t)e * 2048 + k) * 4096 + gc);
  }
  DI void epi(int r, int c, float v0, float v1) const {
    const int rr = m0 + r;
    if (rr >= cnt) return;
    const int a = p.rowlist[e * 8192 + rr];
    const int j = tn * 64 + (c >> 6) * 32 + (c & 31);
    float g = v0 + p.b_gate_up[e * 4096 + j];
    float up = v1 + p.b_gate_up[e * 4096 + 2048 + j];
    g = fminf(g, 7.f);
    up = fminf(fmaxf(up, -7.f), 7.f);
    const float sg = 1.f / (1.f + __expf(-1.702f * g));
    p.act[(size_t)a * 2048 + j] = f2bf((up + 1.f) * (g * sg));
  }
};
struct CfgMoe2 {
  const Params& p; int e, m0, tn, cnt;
  DI int K() const { return DFF; }
  DI const bf16_t* arow(int r) const {
    const int rr = m0 + r;
    if (rr >= cnt) return nullptr;
    const int a = p.rowlist[e * 8192 + rr];
    return p.act + (size_t)a * 2048;
  }
  DI float4 bload(int k, int c) const { return *(const float4*)(p.w_down + ((size_t)e * 2048 + k) * 2048 + tn * 128 + c); }
  DI void epi(int r, int c, float v0, float v1) const {
    const int rr = m0 + r;
    if (rr >= cnt) return;
    const int a = p.rowlist[e * 8192 + rr];
    const int gc = tn * 128 + c;
    const float gt = p.gate[a];
    p.yb[(size_t)a * 2048 + gc] = f2bf((v0 + p.b_down[e * 2048 + gc]) * gt);
    p.yb[(size_t)a * 2048 + gc + 32] = f2bf((v1 + p.b_down[e * 2048 + gc + 32]) * gt);
  }
};
template <int WHICH>
DI void phase_moe(const Params& p, char* smem, int bid, int nb) {
  constexpr int NTN = WHICH == 1 ? 32 : 16;
  MoeSched* sch = (MoeSched*)(smem + G_SMEM);
  moe_sched_build(p, sch, NTN);
  const int total = sch->base[32];
  for (int u = bid; u < total; u += nb) {
    int e = 0;
    while (u >= sch->base[e + 1]) ++e;
    const int loc = u - sch->base[e];
    const int mt = sch->mt[e];
    const int tn = loc / mt, tmi = loc % mt;
    if (WHICH == 1) { CfgMoe1 cfg{p, e, tmi * 128, tn, p.cnt[e]}; gemm_tile(cfg, smem); }
    else { CfgMoe2 cfg{p, e, tmi * 128, tn, p.cnt[e]}; gemm_tile(cfg, smem); }
  }
}

DI void phase_final(const Params& p, int bid, int nb) {
  const int lane = threadIdx.x & 63, wv = threadIdx.x >> 6;
  for (int t = bid * NWAVES + wv; t < NTOK; t += nb * NWAVES) {
    float v[32];
    const float* hr = p.h1f + (size_t)t * DM;
#pragma unroll
    for (int i = 0; i < 8; ++i) {
      const int c = (i * 64 + lane) * 4;
      const float4 a = *(const float4*)(hr + c);
      float s0 = 0.f, s1 = 0.f, s2 = 0.f, s3 = 0.f;
#pragma unroll
      for (int k = 0; k < 4; ++k) {
        const uint2 y = *(const uint2*)(p.yb + (size_t)(t * 4 + k) * 2048 + c);
        s0 += bflo(y.x); s1 += bfhi(y.x); s2 += bflo(y.y); s3 += bfhi(y.y);
      }
      v[4 * i] = DN_ALPHA * a.x + s0; v[4 * i + 1] = DN_ALPHA * a.y + s1;
      v[4 * i + 2] = DN_ALPHA * a.z + s2; v[4 * i + 3] = DN_ALPHA * a.w + s3;
    }
    ln_row_store(v, lane, p.ln_ffn_g, p.ln_ffn_b, p.out + (size_t)t * DM, nullptr);
  }
}

extern __shared__ __attribute__((aligned(16))) char dyn_smem[];
#define KDEF(name, body) __global__ void __launch_bounds__(NTHREADS, 2) name(Params p) { body; }
KDEF(k_ln_in, phase_ln_in(p, blockIdx.x, gridDim.x))
KDEF(k_in_proj, phase_in_proj(p, dyn_smem, blockIdx.x, gridDim.x))
KDEF(k_rms_stats, phase_rms_stats(p, blockIdx.x, gridDim.x))
KDEF(k_mla_proj, phase_mla_proj(p, dyn_smem, blockIdx.x, gridDim.x))
__global__ void __launch_bounds__(256, 1) k_attn(Params p) { phase_attn(p, blockIdx.x, gridDim.x); }
KDEF(k_attn_norm, phase_attn_norm(p, blockIdx.x, gridDim.x))
KDEF(k_wo, phase_wo(p, dyn_smem, blockIdx.x, gridDim.x))
KDEF(k_ln_router, phase_ln_router(p, dyn_smem, blockIdx.x, gridDim.x))
KDEF(k_moe1, phase_moe<1>(p, dyn_smem, blockIdx.x, gridDim.x))
KDEF(k_moe2, phase_moe<2>(p, dyn_smem, blockIdx.x, gridDim.x))
KDEF(k_final, phase_final(p, blockIdx.x, gridDim.x))

extern "C" void kernel_launch(void* const* d_in, const int* in_sizes, int n_in, void* d_out, int out_size, void* d_ws,
                              size_t ws_size, hipStream_t stream) {
  Params p{};
  p.x = (const float*)d_in[0]; p.pos = (const int*)d_in[1]; p.ln_in_g = (const float*)d_in[2]; p.ln_in_b = (const float*)d_in[3];
  p.w_in = (const float*)d_in[4]; p.q_a_norm = (const float*)d_in[5]; p.w_q_b = (const float*)d_in[6];
  p.kv_a_norm = (const float*)d_in[7]; p.w_kv_b = (const float*)d_in[8]; p.sb_out_norm = (const float*)d_in[9];
  p.mla_out_norm = (const float*)d_in[10]; p.w_o = (const float*)d_in[11]; p.ln_mix_g = (const float*)d_in[12];
  p.ln_mix_b = (const float*)d_in[13]; p.w_router = (const float*)d_in[14]; p.b_router = (const float*)d_in[15];
  p.w_gate_up = (const float*)d_in[16]; p.b_gate_up = (const float*)d_in[17]; p.w_down = (const float*)d_in[18];
  p.b_down = (const float*)d_in[19]; p.ln_ffn_g = (const float*)d_in[20]; p.ln_ffn_b = (const float*)d_in[21];
  p.out = (float*)d_out;
  char* w = (char*)d_ws;
  size_t off = 0;
  auto take = [&](size_t bytes) { char* r = w + off; off += (bytes + 255) & ~(size_t)255; return r; };
  p.cnt = (int*)take(4096);
  p.h0f = (float*)take((size_t)NTOK * DM * 4);
  p.h0b = (bf16_t*)take((size_t)NTOK * DM * 2);
  p.qkv = (bf16_t*)take((size_t)NTOK * 3072 * 2);
  p.qlat = (bf16_t*)take((size_t)NTOK * 512 * 2);
  p.kvlat = (bf16_t*)take((size_t)NTOK * 256 * 2);
  p.krope = (bf16_t*)take((size_t)NTOK * 64 * 2);
  p.rstd_q = (float*)take((size_t)NTOK * 4);
  p.rstd_kv = (float*)take((size_t)NTOK * 4);
  p.mq = (bf16_t*)take((size_t)NTOK * 1536 * 2);
  p.mkv = (bf16_t*)take((size_t)NTOK * 2048 * 2);
  p.oA = (bf16_t*)take((size_t)NTOK * 1024 * 2);
  p.oB = (bf16_t*)take((size_t)NTOK * 1024 * 2);
  p.on = (bf16_t*)take((size_t)NTOK * 2048 * 2);
  p.z1 = (float*)take((size_t)NTOK * DM * 4);
  p.h1f = (float*)take((size_t)NTOK * DM * 4);
  p.h1b = (bf16_t*)take((size_t)NTOK * DM * 2);
  p.gate = (float*)take((size_t)NTOK * 4 * 4);
  p.rowlist = (int*)take((size_t)32 * 8192 * 4);
  p.act = (bf16_t*)take((size_t)NTOK * 4 * 2048 * 2);
  p.yb = (bf16_t*)take((size_t)NTOK * 4 * 2048 * 2);

  hipMemsetAsync(p.cnt, 0, 4096, stream);
  const int G = 1024;
  const size_t gs = G_SMEM + 512;
  const size_t rs = (8 * 2048 + 16 * 8 * 32 + 8 * 32) * 4;
  static bool attr_done = false;
  if (!attr_done) {
    hipFuncSetAttribute((const void*)k_ln_router, hipFuncAttributeMaxDynamicSharedMemorySize, (int)rs);
    attr_done = true;
  }
  k_ln_in<<<G, NTHREADS, 0, stream>>>(p);
  k_in_proj<<<64 * 31, NTHREADS, gs, stream>>>(p);
  k_rms_stats<<<G, NTHREADS, 0, stream>>>(p);
  k_mla_proj<<<64 * 28, NTHREADS, gs, stream>>>(p);
  k_attn<<<1024, 256, 0, stream>>>(p);
  k_attn_norm<<<G, NTHREADS, 0, stream>>>(p);
  k_wo<<<64 * 16, NTHREADS, gs, stream>>>(p);
  k_ln_router<<<G, NTHREADS, rs, stream>>>(p);
  k_moe1<<<2048, NTHREADS, gs, stream>>>(p);
  k_moe2<<<2048, NTHREADS, gs, stream>>>(p);
  k_final<<<G, NTHREADS, 0, stream>>>(p);
}
```

```cpp
#include <hip/hip_runtime.h>
#include <stdint.h>
#include <type_traits>

#define DI __device__ __forceinline__
typedef unsigned short bf16_t;
typedef __attribute__((ext_vector_type(8))) short bf16x8;
typedef __attribute__((ext_vector_type(16))) float f32x16;
typedef __attribute__((ext_vector_type(2))) __bf16 bf16x2_t;
typedef __attribute__((ext_vector_type(2))) float f32x2_t;

constexpr int NTOK = 8192, DM = 2048, SEQ = 2048;
constexpr int INP = 3904;
constexpr int NEXP = 32, DFF = 2048;
constexpr float LN_EPS = 1e-5f, RMS_EPS = 1e-6f;
constexpr float DN_ALPHA = 1.189207115002721f;
constexpr int NTHREADS = 512, NWAVES = 8;
#ifndef DENSE_DMA
#define DENSE_DMA 1
#endif
#ifndef JOIN_LATE
#define JOIN_LATE 2
#endif
#ifndef CV_REPEAT
#define CV_REPEAT 1
#endif
#ifndef CV_FUNC
#define CV_FUNC convert_experts_dma
#endif
#ifndef MOE_PROBE
#define MOE_PROBE 0
#endif
#ifndef CV_EXTRA
#define CV_EXTRA 4
#endif
#ifndef CVG
#define CVG 4
#endif
#ifndef CV_PER_16
#define CV_PER_16 5
#endif
#ifndef MOE_FP8
#define MOE_FP8 2
#endif

struct Params {
  const float* x; const int* pos; const float* ln_in_g; const float* ln_in_b; const float* w_in;
  const float* q_a_norm; const float* w_q_b; const float* kv_a_norm; const float* w_kv_b;
  const float* sb_out_norm; const float* mla_out_norm; const float* w_o; const float* ln_mix_g; const float* ln_mix_b;
  const float* w_router; const float* b_router; const float* w_gate_up; const float* b_gate_up;
  const float* w_down; const float* b_down; const float* ln_ffn_g; const float* ln_ffn_b;
  float* out;
  int wid0, pad0;
  unsigned* bar;
  int* cnt;
  float* h0f;
  bf16_t* h0b;
  bf16_t* qkv;
  bf16_t* qlat;
  bf16_t* kvlat;
  bf16_t* krope;
  bf16_t* qn;
  bf16_t* kvn;
  bf16_t* mq;
  bf16_t* mkv;
  bf16_t* oA;
  bf16_t* oB;
  bf16_t* on;
  float* z1;
  bf16_t* z1b;
  float* h1f;
  bf16_t* h1b;
  float* gate;
  int* rowlist;
  bf16_t* act;
  bf16_t* yb;
  bf16_t* wt_in;
  bf16_t* wt_o;
  bf16_t* wt_q;
  bf16_t* wt_kv;
  unsigned char* wq1;
  unsigned char* wq2;
  unsigned char* cvdump;
  unsigned char* h1q;
  unsigned char* actq;
};

DI unsigned pack2(float a, float b) {
  f32x2_t v = {a, b};
  bf16x2_t r = __builtin_convertvector(v, bf16x2_t);
  return __builtin_bit_cast(unsigned, r);
}
DI bf16_t f2bf(float a) { return (bf16_t)(pack2(a, 0.f) & 0xffffu); }
DI float bf2f(bf16_t h) { return __uint_as_float(((unsigned)h) << 16); }
DI float bflo(unsigned u) { return __uint_as_float(u << 16); }
DI float bfhi(unsigned u) { return __uint_as_float(u & 0xffff0000u); }
DI int crow(int reg, int h) { return (reg & 3) + 8 * (reg >> 2) + 4 * h; }
DI float wave_sum(float v) {
#pragma unroll
  for (int o = 32; o > 0; o >>= 1) v += __shfl_xor(v, o);
  return v;
}
DI float wave_max(float v) {
#pragma unroll
  for (int o = 32; o > 0; o >>= 1) v = fmaxf(v, __shfl_xor(v, o));
  return v;
}

__constant__ float INV_FREQ[32] = {1.000000000e+00f, 7.498942093e-01f, 5.623413252e-01f, 4.216965034e-01f, 3.162277660e-01f, 2.371373706e-01f, 1.778279410e-01f, 1.333521432e-01f, 1.000000000e-01f, 7.498942093e-02f, 5.623413252e-02f, 4.216965034e-02f, 3.162277660e-02f, 2.371373706e-02f, 1.778279410e-02f, 1.333521432e-02f, 1.000000000e-02f, 7.498942093e-03f, 5.623413252e-03f, 4.216965034e-03f, 3.162277660e-03f, 2.371373706e-03f, 1.778279410e-03f, 1.333521432e-03f, 1.000000000e-03f, 7.498942093e-04f, 5.623413252e-04f, 4.216965034e-04f, 3.162277660e-04f, 2.371373706e-04f, 1.778279410e-04f, 1.333521432e-04f};
DI void rope_sc(int pos, int i, float& sn, float& cs) {
  const float ang = (float)pos * INV_FREQ[i];
  double rev = (double)ang * 0.15915494309189535;
  rev -= rint(rev);
  const float fr = (float)rev;
  sn = __builtin_amdgcn_sinf(fr);
  cs = __builtin_amdgcn_cosf(fr);
}
typedef __attribute__((ext_vector_type(4))) short s16x4;
#define LDS_AS __attribute__((address_space(3)))
DI s16x4 tr_read4(const bf16_t* p) { return __builtin_amdgcn_ds_read_tr16_b64_v4i16((LDS_AS s16x4*)p); }
DI bf16x8 tr_frag(const bf16_t* p0, const bf16_t* p1) {
  const s16x4 a = tr_read4(p0), b = tr_read4(p1);
  return __builtin_shufflevector(a, b, 0, 1, 2, 3, 4, 5, 6, 7);
}
DI int lane_id_now() { int l; asm volatile("v_mbcnt_lo_u32_b32 %0, -1, 0\n\tv_mbcnt_hi_u32_b32 %0, -1, %0" : "=v"(l)); return l; }
#define OPAQUE_TID(P) (((P).wid0 << 6) | lane_id_now())
DI int pack4_fp8(float a, float b, float c, float d) {
  int pk = 0;
  pk = __builtin_amdgcn_cvt_pk_fp8_f32(a, b, pk, false);
  pk = __builtin_amdgcn_cvt_pk_fp8_f32(c, d, pk, true);
  return pk;
}
#define MFMA32(a, b, c) __builtin_amdgcn_mfma_f32_32x32x16_bf16((a), (b), (c), 0, 0, 0)

DI void ln_row_store(const float (&v)[32], int lane, const float* g, const float* b, float* outf, bf16_t* outb) {
  float s = 0.f;
#pragma unroll
  for (int i = 0; i < 32; ++i) s += v[i];
  s = wave_sum(s);
  const float mu = s * (1.f / 2048.f);
  float q = 0.f;
#pragma unroll
  for (int i = 0; i < 32; ++i) { const float d = v[i] - mu; q += d * d; }
  q = wave_sum(q);
  const float rs = rsqrtf(q * (1.f / 2048.f) + LN_EPS);
#pragma unroll
  for (int i = 0; i < 8; ++i) {
    const int c = (i * 64 + lane) * 4;
    const float4 gg = *(const float4*)(g + c);
    const float4 bb = *(const float4*)(b + c);
    float4 o;
    o.x = (v[4 * i + 0] - mu) * rs * gg.x + bb.x;
    o.y = (v[4 * i + 1] - mu) * rs * gg.y + bb.y;
    o.z = (v[4 * i + 2] - mu) * rs * gg.z + bb.z;
    o.w = (v[4 * i + 3] - mu) * rs * gg.w + bb.w;
    if (outf) *(float4*)(outf + c) = o;
    if (outb) { uint2 pk; pk.x = pack2(o.x, o.y); pk.y = pack2(o.z, o.w); *(uint2*)(outb + c) = pk; }
  }
}

DI void phase_ln_in(const Params& p, int bid, int nb) {
  const int tid_ = OPAQUE_TID(p), lane = tid_ & 63, wv = tid_ >> 6;
  for (int t = bid * NWAVES + wv; t < NTOK; t += nb * NWAVES) {
    float v[32];
    const float* xr = p.x + (size_t)t * DM;
#pragma unroll
    for (int i = 0; i < 8; ++i) {
      const float4 a = *(const float4*)(xr + (i * 64 + lane) * 4);
      v[4 * i] = a.x; v[4 * i + 1] = a.y; v[4 * i + 2] = a.z; v[4 * i + 3] = a.w;
    }
    ln_row_store(v, lane, p.ln_in_g, p.ln_in_b, nullptr, p.h0b + (size_t)t * DM);
  }
}

#define XB_TMO      128
#define XB_XCNT(j)  (256  + 64 * (j))
#define XB_XSUB(j)  (1280 + 64 * (j))
#define XB_XGEN(j)  (2304 + 64 * (j))
#define XB_TOP      3328
#define XB_TOPGEN   3392
#define XCD_BAR_WORDS 3456
#define XB_SPIN_CAP (1u << 18)
#define LAS __attribute__((address_space(3)))

__device__ __forceinline__ unsigned xb_ld(unsigned* p)              { return __hip_atomic_load(p, __ATOMIC_RELAXED, __HIP_MEMORY_SCOPE_AGENT); }
__device__ __forceinline__ unsigned xb_add(unsigned* p, unsigned v) { return __hip_atomic_fetch_add(p, v, __ATOMIC_RELAXED, __HIP_MEMORY_SCOPE_AGENT); }
__device__ __forceinline__ unsigned xb_xcc_id() { return (unsigned)__builtin_amdgcn_s_getreg((3 << 11) | 20) & 0xFu; }
#define XB_SPIN(cond, bar) do { unsigned _sp = 0; while (cond) { __builtin_amdgcn_s_sleep(1); \
    if ((++_sp & 255u) == 0u) { if (xb_ld(&(bar)[XB_TMO])) break; if (_sp > XB_SPIN_CAP) { atomicAdd(&(bar)[XB_TMO], 1u); break; } } } } while (0)

struct XcdBarrier {
    unsigned* bar; unsigned x;
    volatile LAS unsigned* st;
    unsigned G;
};

__device__ __forceinline__ XcdBarrier xcd_barrier_post(unsigned* bar, volatile LAS unsigned* st, unsigned G) {
    XcdBarrier b; b.bar = bar; b.x = xb_xcc_id(); b.st = st; b.G = G;
    if (threadIdx.x == 0) (void)xb_add(&bar[XB_XCNT(b.x)], 1u);
    return b;
}
__device__ __forceinline__ void xcd_barrier_complete(unsigned* bar, unsigned x, unsigned G, unsigned& nloc, unsigned& nx) {
    unsigned sum, cnt, mine, sp = 0u;
    for (;;) {
        sum = 0u; cnt = 0u; mine = 0u;
#pragma unroll
        for (unsigned j = 0; j < 16; ++j) { const unsigned c = xb_ld(&bar[XB_XCNT(j)]); sum += c; cnt += (c > 0u) ? 1u : 0u; mine = (j == x) ? c : mine; }
        if (sum == G) break;
        __builtin_amdgcn_s_sleep(1);
        if ((++sp & 255u) == 0u) { if (xb_ld(&bar[XB_TMO])) break; if (sp > XB_SPIN_CAP) { atomicAdd(&bar[XB_TMO], 1u); break; } }
    }
    nloc = mine > 0u ? mine : 1u; nx = cnt > 0u ? cnt : 1u;
}

__device__ __forceinline__ void xcd_barrier(const XcdBarrier& b) {
    asm volatile("s_waitcnt vmcnt(0)" ::: "memory");
    __syncthreads();
    if (threadIdx.x == 0) {
        unsigned* bar = b.bar;
        __builtin_amdgcn_s_waitcnt(0);
        unsigned nloc = b.st[0], nx = b.st[1];
        if (nloc == 0u) { xcd_barrier_complete(bar, b.x, b.G, nloc, nx); b.st[0] = nloc; b.st[1] = nx; }
        const unsigned old = xb_add(&bar[XB_XSUB(b.x)], 1u);
        const unsigned gen = old / nloc;
        if (old + 1u == (gen + 1u) * nloc) {
            __builtin_amdgcn_fence(__ATOMIC_RELEASE, "agent");
            asm volatile("s_waitcnt vmcnt(0)" ::: "memory");
            const unsigned og = xb_add(&bar[XB_TOP], 1u);
            const unsigned tg = og / nx;
            if (og + 1u == (tg + 1u) * nx) xb_add(&bar[XB_TOPGEN], 1u);
            else XB_SPIN(xb_ld(&bar[XB_TOPGEN]) == tg, bar);
            __builtin_amdgcn_fence(__ATOMIC_ACQUIRE, "agent");
            xb_add(&bar[XB_XGEN(b.x)], 1u);
            asm volatile("s_waitcnt vmcnt(0)" ::: "memory");
        } else {
            XB_SPIN(xb_ld(&bar[XB_XGEN(b.x)]) == gen, bar);
            __builtin_amdgcn_fence(__ATOMIC_ACQUIRE, "agent");
            asm volatile("s_waitcnt vmcnt(0)" ::: "memory");
        }
    }
    __syncthreads();
}

constexpr int HTB = 16384;
constexpr int G256_LDS = 8 * HTB;
#define G_SA(b, h) (((b) * 2 + (h)) * HTB)
#define G_SB(b, h) ((4 + (b) * 2 + (h)) * HTB)
typedef __attribute__((ext_vector_type(4))) float f32x4;
typedef __attribute__((ext_vector_type(4))) unsigned u32x4;
typedef __attribute__((ext_vector_type(2))) unsigned u32x2;

DI int lds_byte(int r, int c) { const int st = (r >> 4) * 2 + (c >> 5), rr = r & 15, cc = c & 31, ob = rr * 64 + cc * 2; return st * 1024 + (ob ^ (((ob >> 9) & 1) << 5)); }
DI void stage_rc(int b, int& R, int& C) { const int st = b / 1024, sb = b % 1024, swz = sb ^ (((sb >> 9) & 1) << 5); R = (st >> 1) * 16 + swz / 64; C = (st & 1) * 32 + (swz % 64) / 2; }
DI unsigned offb(unsigned row, unsigned ch) { return 256u * row + 16u * (ch ^ (((row & 3u) << 2) | ((row >> 2) & 3u))); }

DI f32x4 bufload4(__amdgpu_buffer_rsrc_t rs, unsigned voff, unsigned soff) {
#if defined(__HIP_DEVICE_COMPILE__)
  return __builtin_bit_cast(f32x4, __builtin_amdgcn_raw_buffer_load_b128(rs, voff, soff, 0));
#else
  return (f32x4){0.f, 0.f, 0.f, 0.f};
#endif
}
DI int tcol_p64(int lc) { return (lc & ~0x30) | ((lc & 0x10) << 1) | ((lc & 0x20) >> 1); }
DI int tcol_gu(int lc) { return ((lc & 0x30) << 1) | ((lc & 0x40) >> 2) | (lc & 15); }

#define G_WAIT_V(n) asm volatile("s_waitcnt vmcnt(" #n ")" ::: "memory")
#define G_WAIT_L0() asm volatile("s_waitcnt lgkmcnt(0)" ::: "memory")
#define G_BAR() __builtin_amdgcn_s_barrier()
#define G_SCHED() __builtin_amdgcn_sched_barrier(0)

template <class Cfg, int MODE = 0, bool TOPHALF = false>
DI void gemm256_unit(LDS_AS unsigned char* lds, const Cfg& cfg) {
  const int tid = OPAQUE_TID(cfg.p), wid = __builtin_amdgcn_readfirstlane(tid >> 6), lane = tid & 63, wr = wid >> 2, wc = wid & 3, fr = lane & 15, fq = lane >> 4;
  const int nt = cfg.nkt();
  constexpr bool act0 = true, act1 = !TOPHALF;
  unsigned voffA[2][2];
#pragma unroll
  for (int i = 0; i < 2; ++i) {
    int R, C; stage_rc(tid * 16 + i * 8192, R, C);
    voffA[0][i] = cfg.a_rowoff(R) + (unsigned)C * 2u;
    voffA[1][i] = cfg.a_rowoff(128 + R) + (unsigned)C * 2u;
  }
  const __amdgpu_buffer_rsrc_t rsA = __builtin_amdgcn_make_buffer_rsrc((void*)cfg.a_base(), 0, cfg.a_bytes(), 0x00020000);
  const __amdgpu_buffer_rsrc_t rsB = __builtin_amdgcn_make_buffer_rsrc((void*)cfg.b_base(), 0, cfg.b_bytes(), 0x00020000);
  const unsigned ldsw = (unsigned)__builtin_amdgcn_readfirstlane((int)(unsigned)(size_t)lds) + (unsigned)wid * 1024u;
#define G_STAGE_A(slot, half, kt) do { if (MODE == 3 || MODE == 4) break; _Pragma("unroll") for (int _i = 0; _i < 2; ++_i) { const unsigned _m0 = ldsw + (unsigned)((slot) + _i * 8192); const unsigned _so = (unsigned)(kt) * 128u; \
    asm volatile("s_mov_b32 m0, %0\n\ts_nop 4\n\tbuffer_load_dwordx4 %1, %2, %3 offen lds" :: "s"(_m0), "v"(voffA[half][_i]), "s"(rsA), "s"(_so) : "m0", "memory"); } } while (0)
  const int kk = tid >> 5, lc = (tid & 31) * 4;
  const int ldb = cfg.ldb();
  unsigned voffB[2];
  voffB[0] = (unsigned)(kk * ldb + cfg.b_gcol(0, lc)) * 4u;
  voffB[1] = (unsigned)(kk * ldb + cfg.b_gcol(1, lc)) * 4u;
  const int tc = Cfg::GU ? tcol_gu(lc) : tcol_p64(lc);
  const unsigned wofB = offb((unsigned)kk, (unsigned)(tc >> 3)) + ((tc & 4) ? 8u : 0u);
  const unsigned ldb64 = (unsigned)ldb * 256u;
  const unsigned ldb16 = (unsigned)ldb * 64u;
#define G_LOAD_B(dst, half, kt) do { if (MODE == 3 || MODE == 5) { _Pragma("unroll") for (int _i = 0; _i < 4; ++_i) asm volatile("" : "+v"(dst[_i])); break; } _Pragma("unroll") for (int _i = 0; _i < 4; ++_i) { const unsigned _so = (unsigned)(kt) * ldb64 + _i * ldb16; \
    asm volatile("s_nop 4\n\tbuffer_load_dwordx4 %0, %1, %2, %3 offen" : "=v"(dst[_i]) : "v"(voffB[half]), "s"(rsB), "s"(_so) : "memory"); } } while (0)
#define G_WAIT_B(n, r) asm volatile("s_waitcnt vmcnt(" #n ")" : "+v"(r[0]), "+v"(r[1]), "+v"(r[2]), "+v"(r[3]) :: "memory")
#define G_WRITE_B(slot, src) do { _Pragma("unroll") for (int _i = 0; _i < 4; ++_i) { u32x2 _pk; _pk.x = pack2(src[_i][0], src[_i][1]); _pk.y = pack2(src[_i][2], src[_i][3]); \
    *(LDS_AS u32x2*)(lds + (slot) + wofB + _i * 4096) = _pk; } } while (0)
  const int aoff = lds_byte(wr * 64 + fr, fq * 8);
  unsigned boff[2][2];
  {
    const unsigned q = (unsigned)(lane & 15) >> 2, pp = (unsigned)lane & 3u;
#pragma unroll
    for (int n = 0; n < 2; ++n)
#pragma unroll
      for (int t = 0; t < 2; ++t)
        boff[n][t] = offb(8u * fq + 4u * t + q, (unsigned)(4 * wc + 2 * n) + (pp >> 1)) + 8u * (pp & 1u);
  }
#define G_LDA(dst, slot) do { if (MODE == 6) { _Pragma("unroll") for (int m = 0; m < 4; ++m) _Pragma("unroll") for (int k = 0; k < 2; ++k) asm volatile("" : "+v"(dst[m][k])); break; } _Pragma("unroll") for (int m = 0; m < 4; ++m) _Pragma("unroll") for (int k = 0; k < 2; ++k) \
    dst[m][k] = *(const LDS_AS bf16x8*)(lds + (slot) + aoff + m * 2048 + k * 1024); } while (0)
#define G_LDB(dst, slot) do { if (MODE == 6) { _Pragma("unroll") for (int n = 0; n < 2; ++n) _Pragma("unroll") for (int k = 0; k < 2; ++k) asm volatile("" : "+v"(dst[n][k])); break; } _Pragma("unroll") for (int n = 0; n < 2; ++n) _Pragma("unroll") for (int k = 0; k < 2; ++k) { \
    const s16x4 _lo = __builtin_amdgcn_ds_read_tr16_b64_v4i16((LDS_AS s16x4*)(lds + (slot) + boff[n][0] + k * 8192)); \
    const s16x4 _hi = __builtin_amdgcn_ds_read_tr16_b64_v4i16((LDS_AS s16x4*)(lds + (slot) + boff[n][1] + k * 8192)); \
    dst[n][k] = __builtin_shufflevector(_lo, _hi, 0, 1, 2, 3, 4, 5, 6, 7); } } while (0)
#define G_MMA(ai, bj, At, Bf) do { if (!((ai) ? act1 : act0)) break; if (MODE == 2) { _Pragma("unroll") for (int m = 0; m < 4; ++m) _Pragma("unroll") for (int k = 0; k < 2; ++k) asm volatile("" :: "v"(At[m][k])); _Pragma("unroll") for (int n = 0; n < 2; ++n) _Pragma("unroll") for (int k = 0; k < 2; ++k) asm volatile("" :: "v"(Bf[n][k])); break; } __builtin_amdgcn_s_setprio(1); _Pragma("unroll") for (int m = 0; m < 4; ++m) _Pragma("unroll") for (int n = 0; n < 2; ++n) _Pragma("unroll") for (int k = 0; k < 2; ++k) \
    acc[ai][bj][m][n] = __builtin_amdgcn_mfma_f32_16x16x32_bf16(Bf[n][k], At[m][k], acc[ai][bj][m][n], 0, 0, 0); __builtin_amdgcn_s_setprio(0); } while (0)

#define G_MFMA4(ai, bj, At, Bf, m) do { if (!((ai) ? act1 : act0)) break; _Pragma("unroll") for (int n = 0; n < 2; ++n) _Pragma("unroll") for (int k = 0; k < 2; ++k) \
    acc[ai][bj][m][n] = __builtin_amdgcn_mfma_f32_16x16x32_bf16(Bf[n][k], At[m][k], acc[ai][bj][m][n], 0, 0, 0); } while (0)
#define G_WRITE_B2(slot, src, i0) do { if (MODE == 8) break; _Pragma("unroll") for (int _i = i0; _i < i0 + 2; ++_i) { u32x2 _pk; _pk.x = pack2(src[_i][0], src[_i][1]); _pk.y = pack2(src[_i][2], src[_i][3]); \
    *(LDS_AS u32x2*)(lds + (slot) + wofB + _i * 4096) = _pk; } } while (0)
#define G_LOAD_B2(dst, half, kt, i0) do { if (MODE == 3 || MODE == 5) { _Pragma("unroll") for (int _i = i0; _i < i0 + 2; ++_i) asm volatile("" : "+v"(dst[_i])); break; } \
    _Pragma("unroll") for (int _i = i0; _i < i0 + 2; ++_i) { const unsigned _so = (unsigned)(kt) * ldb64 + _i * ldb16; \
    asm volatile("s_nop 4\n\tbuffer_load_dwordx4 %0, %1, %2, %3 offen" : "=v"(dst[_i]) : "v"(voffB[half]), "s"(rsB), "s"(_so) : "memory"); } } while (0)
#define G_MMA_STAGE(ai, bj, At, Bf, slot, Rs, half, kt) do { if (MODE == 2) { G_MMA(ai, bj, At, Bf); G_WAIT_B(8, Rs); G_WRITE_B(slot, Rs); G_LOAD_B(Rs, half, kt); break; } \
    __builtin_amdgcn_s_setprio(1); \
    G_MFMA4(ai, bj, At, Bf, 0); G_SCHED(); G_WAIT_B(8, Rs); G_WRITE_B2(slot, Rs, 0); G_SCHED(); \
    G_MFMA4(ai, bj, At, Bf, 1); G_SCHED(); G_WRITE_B2(slot, Rs, 2); G_SCHED(); \
    G_MFMA4(ai, bj, At, Bf, 2); G_SCHED(); G_LOAD_B2(Rs, half, kt, 0); G_SCHED(); \
    G_MFMA4(ai, bj, At, Bf, 3); G_SCHED(); G_LOAD_B2(Rs, half, kt, 2); \
    __builtin_amdgcn_s_setprio(0); } while (0)
  f32x4 Ra[4], Rb[4];
  if (MODE == 3 || MODE == 5) { _Pragma("unroll") for (int i = 0; i < 4; ++i) { const float f = (float)((tid * 2654435761u + i * 40503u) & 0xffffu) * (1.f / 32768.f) - 1.f; Ra[i] = (f32x4){f, -f * 0.7f, f * 0.3f + 0.1f, 0.5f - f}; Rb[i] = (f32x4){0.2f - f, f * 0.9f, -f, f * 0.5f}; } }
  {
    G_STAGE_A(G_SA(0, 0), 0, 0); G_STAGE_A(G_SA(0, 1), 1, 0); G_STAGE_A(G_SA(1, 0), 0, 1);
    f32x4 X0[4], X1[4], X2[4];
    G_LOAD_B(X0, 1, 0); G_LOAD_B(X1, 0, 0); G_LOAD_B(X2, 1, 1); G_LOAD_B(Ra, 0, 1); G_LOAD_B(Rb, 1, (2 < nt ? 2 : 0));
    G_WAIT_B(8, X0); G_WAIT_B(8, X1); G_WAIT_B(8, X2);
    G_WRITE_B(G_SB(0, 1), X0); G_WRITE_B(G_SB(0, 0), X1); G_WRITE_B(G_SB(1, 1), X2);
    G_WAIT_B(0, Ra); G_WAIT_B(0, Rb);
    G_WAIT_L0();
    G_BAR();
  }
  f32x4 acc[2][2][4][2];
#pragma unroll
  for (int a = 0; a < 2; ++a)
#pragma unroll
    for (int b = 0; b < 2; ++b)
#pragma unroll
      for (int m = 0; m < 4; ++m)
#pragma unroll
        for (int n = 0; n < 2; ++n) acc[a][b][m][n] = (f32x4){0.f, 0.f, 0.f, 0.f};
  bf16x8 At[4][2], B0[2][2], B1[2][2];
  if (MODE == 6) { _Pragma("unroll") for (int m = 0; m < 4; ++m) _Pragma("unroll") for (int k = 0; k < 2; ++k) At[m][k] = (bf16x8){1, 2, 3, 4, 5, 6, 7, 8}; _Pragma("unroll") for (int n = 0; n < 2; ++n) _Pragma("unroll") for (int k = 0; k < 2; ++k) { B0[n][k] = (bf16x8){1, 2, 3, 4, 5, 6, 7, 8}; B1[n][k] = B0[n][k]; } }
  if (wr == 1 && MODE != 7) G_BAR();
#define G_LBAR() do { if (MODE != 7) G_BAR(); } while (0)
#pragma clang loop unroll(disable)
  for (int t = 0; t < nt; t += 2) {
    const int t1 = t + 1;
    const int t2 = (t + 2 < nt) ? t + 2 : 0;
    const int t3 = (t + 2 < nt) ? t + 3 : 1;
    const int t4 = (t + 4 < nt) ? t + 4 : (t + 4 - nt < nt ? t + 4 - nt : 0);
    G_LDB(B0, G_SB(0, 0)); G_LDA(At, G_SA(0, 0)); G_STAGE_A(G_SA(1, 1), 1, t1);
    G_LBAR(); G_WAIT_L0(); G_SCHED(); G_MMA(0, 0, At, B0); G_LBAR(); G_SCHED();
    G_LDB(B1, G_SB(0, 1));
    G_LBAR(); G_WAIT_L0(); G_SCHED(); G_MMA_STAGE(0, 1, At, B1, G_SB(1, 0), Ra, 0, t2); G_LBAR(); G_SCHED();
    G_LDA(At, G_SA(0, 1)); G_STAGE_A(G_SA(0, 0), 0, t2);
    G_LBAR(); G_WAIT_L0(); G_SCHED(); G_MMA(1, 1, At, B1); G_LBAR(); G_SCHED();
    G_LDB(B0, G_SB(0, 0));
    G_LBAR(); G_WAIT_L0(); G_SCHED(); G_MMA_STAGE(1, 0, At, B0, G_SB(0, 1), Rb, 1, t3); G_LBAR(); G_SCHED();
    G_LDB(B0, G_SB(1, 0)); G_LDA(At, G_SA(1, 0)); G_STAGE_A(G_SA(0, 1), 1, t2);
    G_LBAR(); G_WAIT_L0(); G_SCHED(); G_MMA(0, 0, At, B0); G_LBAR(); G_SCHED();
    G_LDB(B1, G_SB(1, 1));
    G_LBAR(); G_WAIT_L0(); G_SCHED(); G_MMA_STAGE(0, 1, At, B1, G_SB(0, 0), Ra, 0, t3); G_LBAR(); G_SCHED();
    G_LDA(At, G_SA(1, 1)); G_STAGE_A(G_SA(1, 0), 0, t3);
    G_LBAR(); G_WAIT_L0(); G_SCHED(); G_MMA(1, 1, At, B1); G_LBAR(); G_SCHED();
    G_LDB(B0, G_SB(1, 0));
    G_LBAR(); G_WAIT_L0(); G_SCHED(); G_MMA_STAGE(1, 0, At, B0, G_SB(1, 1), Rb, 1, t4); G_LBAR(); G_SCHED();
  }
  G_WAIT_B(0, Ra); G_WAIT_B(0, Rb); G_SCHED();
  if (wr == 0 && MODE != 7) G_BAR();
  {
    const int wid2 = wid, ln2 = lane_id_now(), wr2 = wid2 >> 2, wc2 = wid2 & 3, fr2 = ln2 & 15, fq2 = ln2 >> 4;
#pragma unroll
    for (int ai = 0; ai < 2; ++ai)
#pragma unroll
      for (int m = 0; m < 4; ++m)
#pragma unroll
        for (int bj = 0; bj < 2; ++bj)
          if (MODE == 0) cfg.epi(ai * 128 + wr2 * 64 + m * 16 + fr2, bj, wc2, fq2, acc[ai][bj][m][0], acc[ai][bj][m][1]);
          else asm volatile("" :: "v"(acc[ai][bj][m][0]), "v"(acc[ai][bj][m][1]));
  }
  G_BAR();
#undef G_STAGE_A
#undef G_LOAD_B
#undef G_WRITE_B
#undef G_LDA
#undef G_LDB
#undef G_MMA
#undef G_MFMA4
#undef G_WRITE_B2
#undef G_LOAD_B2
#undef G_MMA_STAGE
}

constexpr int F8_SA_BYTES = 16384, F8_SB_BYTES = 128 * 144;
constexpr int G256F8_LDS = 4 * F8_SA_BYTES + 4 * F8_SB_BYTES;
#define F_SA(b, h) (((b) * 2 + (h)) * F8_SA_BYTES)
#define F_SB(b, h) (4 * F8_SA_BYTES + ((b) * 2 + (h)) * F8_SB_BYTES)
typedef __attribute__((ext_vector_type(8))) int i32x8;
typedef __attribute__((ext_vector_type(4))) int i32x4;

template <class Cfg, bool TOPHALF = false>
DI void gemm256f8_unit(LDS_AS unsigned char* lds, const Cfg& cfg) {
  const int tid = OPAQUE_TID(cfg.p), wid = __builtin_amdgcn_readfirstlane(tid >> 6), lane = tid & 63, wr = wid >> 2, wc = wid & 3, fr = lane & 15, fq = lane >> 4;
  const int nt = cfg.nkt();
  constexpr bool act1 = !TOPHALF;
  unsigned voffA[2][2];
#pragma unroll
  for (int i = 0; i < 2; ++i) {
    const int r = 8 * (wid + 8 * i) + (lane >> 3);
    const unsigned cofs = 16u * (((unsigned)lane & 7u) ^ (((unsigned)lane >> 3) & 7u));
    voffA[0][i] = cfg.a_rowoff(r) + cofs;
    voffA[1][i] = cfg.a_rowoff(128 + r) + cofs;
  }
  const __amdgpu_buffer_rsrc_t rsA = __builtin_amdgcn_make_buffer_rsrc((void*)cfg.a_base(), 0, cfg.a_bytes(), 0x00020000);
  const __amdgpu_buffer_rsrc_t rsB = __builtin_amdgcn_make_buffer_rsrc((void*)cfg.b_base(), 0, cfg.b_bytes(), 0x00020000);
  const unsigned ldsw = (unsigned)__builtin_amdgcn_readfirstlane((int)(unsigned)(size_t)lds) + (unsigned)wid * 1024u;
#define F_STAGE_A(slot, half, kt) do { _Pragma("unroll") for (int _i = 0; _i < 2; ++_i) { const unsigned _m0 = ldsw + (unsigned)((slot) + _i * 8192); const unsigned _so = (unsigned)(kt) * 128u; \
    asm volatile("s_mov_b32 m0, %0\n\ts_nop 4\n\tbuffer_load_dwordx4 %1, %2, %3 offen lds" :: "s"(_m0), "v"(voffA[half][_i]), "s"(rsA), "s"(_so) : "m0", "memory"); } } while (0)
  const int kg = tid >> 5, lc = (tid & 31) * 4;
  const int ldb = cfg.ldb();
  unsigned voffB[2];
  voffB[0] = (unsigned)(4 * kg * ldb + cfg.b_gcol(0, lc)) * 4u;
  voffB[1] = (unsigned)(4 * kg * ldb + cfg.b_gcol(1, lc)) * 4u;
  const int tc = Cfg::GU ? tcol_gu(lc) : tcol_p64(lc);
  const unsigned wofB = (unsigned)tc * 144u + 4u * (unsigned)kg;
  const unsigned ldb128 = (unsigned)ldb * 512u;
  const unsigned ldb1 = (unsigned)ldb * 4u;
  const float bmul = cfg.bmul();
#define F_LOAD_B4(dst, half, kt, b) do { _Pragma("unroll") for (int _r = 0; _r < 4; ++_r) { const unsigned _so = (unsigned)(kt) * ldb128 + (unsigned)(64 * (b) + _r) * ldb1; \
    asm volatile("s_nop 4\n\tbuffer_load_dwordx4 %0, %1, %2, %3 offen" : "=v"(dst[4 * (b) + _r]) : "v"(voffB[half]), "s"(rsB), "s"(_so) : "memory"); } } while (0)
#define F_LOAD_B(dst, half, kt) do { F_LOAD_B4(dst, half, kt, 0); F_LOAD_B4(dst, half, kt, 1); } while (0)
#define F_WRITE_B4(slot, src, b) do { _Pragma("unroll") for (int _j = 0; _j < 4; ++_j) { int _pk = 0; \
    _pk = __builtin_amdgcn_cvt_pk_fp8_f32(src[4 * (b) + 0][_j] * bmul, src[4 * (b) + 1][_j] * bmul, _pk, false); \
    _pk = __builtin_amdgcn_cvt_pk_fp8_f32(src[4 * (b) + 2][_j] * bmul, src[4 * (b) + 3][_j] * bmul, _pk, true); \
    *(LDS_AS int*)(lds + (slot) + wofB + _j * 144 + (b) * 64) = _pk; } } while (0)
#define F_WRITE_B(slot, src) do { F_WRITE_B4(slot, src, 0); F_WRITE_B4(slot, src, 1); } while (0)
#define F_WAIT_B(n, r) asm volatile("s_waitcnt vmcnt(" #n ")" : "+v"(r[0]), "+v"(r[1]), "+v"(r[2]), "+v"(r[3]), "+v"(r[4]), "+v"(r[5]), "+v"(r[6]), "+v"(r[7]) :: "memory")
  unsigned aoff[2];
  aoff[0] = (unsigned)(64 * wr + fr) * 128u + 16u * ((2u * fq) ^ ((unsigned)fr & 7u));
  aoff[1] = (unsigned)(64 * wr + fr) * 128u + 16u * ((2u * fq + 1u) ^ ((unsigned)fr & 7u));
  const unsigned boff = (unsigned)(32 * wc + fr) * 144u + 32u * fq;
#define F_LDA(dst, slot) do { _Pragma("unroll") for (int m = 0; m < 4; ++m) { \
    const i32x4 _lo = *(const LDS_AS i32x4*)(lds + (slot) + aoff[0] + m * 2048); const i32x4 _hi = *(const LDS_AS i32x4*)(lds + (slot) + aoff[1] + m * 2048); \
    dst[m] = __builtin_shufflevector(_lo, _hi, 0, 1, 2, 3, 4, 5, 6, 7); } } while (0)
#define F_LDB(dst, slot) do { _Pragma("unroll") for (int n = 0; n < 2; ++n) { \
    const i32x4 _lo = *(const LDS_AS i32x4*)(lds + (slot) + boff + n * 2304); const i32x4 _hi = *(const LDS_AS i32x4*)(lds + (slot) + boff + n * 2304 + 16); \
    dst[n] = __builtin_shufflevector(_lo, _hi, 0, 1, 2, 3, 4, 5, 6, 7); } } while (0)
  const int scw = cfg.scale_w(), scx = cfg.scale_x();
#define F_MFMA2(ai, bj, At, Bf, m) do { if ((ai) && !act1) break; _Pragma("unroll") for (int n = 0; n < 2; ++n) \
    acc[ai][bj][m][n] = __builtin_amdgcn_mfma_scale_f32_16x16x128_f8f6f4(Bf[n], At[m], acc[ai][bj][m][n], 0, 0, 0, scw, 0, scx); } while (0)
#define F_MMA(ai, bj, At, Bf) do { __builtin_amdgcn_s_setprio(1); _Pragma("unroll") for (int m = 0; m < 4; ++m) F_MFMA2(ai, bj, At, Bf, m); __builtin_amdgcn_s_setprio(0); } while (0)
#define F_MMA_STAGE(ai, bj, At, Bf, slot, Rs, half, kt) do { __builtin_amdgcn_s_setprio(1); \
    F_MFMA2(ai, bj, At, Bf, 0); G_SCHED(); F_WAIT_B(2, Rs); F_WRITE_B4(slot, Rs, 0); G_SCHED(); \
    F_MFMA2(ai, bj, At, Bf, 1); G_SCHED(); F_WRITE_B4(slot, Rs, 1); G_SCHED(); \
    F_MFMA2(ai, bj, At, Bf, 2); G_SCHED(); F_LOAD_B4(Rs, half, kt, 0); G_SCHED(); \
    F_MFMA2(ai, bj, At, Bf, 3); G_SCHED(); F_LOAD_B4(Rs, half, kt, 1); \
    __builtin_amdgcn_s_setprio(0); } while (0)
  f32x4 R[8];
  {
    F_STAGE_A(F_SA(0, 0), 0, 0); F_STAGE_A(F_SA(0, 1), 1, 0); F_STAGE_A(F_SA(1, 0), 0, 1);
    f32x4 X0[8], X1[8], X2[8];
    F_LOAD_B(X0, 1, 0); F_LOAD_B(X1, 0, 0); F_LOAD_B(X2, 1, 1); F_LOAD_B(R, 0, 1);
    F_WAIT_B(8, X0); F_WAIT_B(8, X1); F_WAIT_B(8, X2);
    F_WRITE_B(F_SB(0, 1), X0); F_WRITE_B(F_SB(0, 0), X1); F_WRITE_B(F_SB(1, 1), X2);
    G_WAIT_L0();
    G_BAR();
  }
  f32x4 acc[2][2][4][2];
#pragma unroll
  for (int a = 0; a < 2; ++a)
#pragma unroll
    for (int b = 0; b < 2; ++b)
#pragma unroll
      for (int m = 0; m < 4; ++m)
#pragma unroll
        for (int n = 0; n < 2; ++n) acc[a][b][m][n] = (f32x4){0.f, 0.f, 0.f, 0.f};
  i32x8 At[4], B0[2], B1[2];
  if (wr == 1) G_BAR();
#pragma clang loop unroll(disable)
  for (int t = 0; t < nt; t += 2) {
    const int t1 = t + 1;
    const int t2 = (t + 2 < nt) ? t + 2 : 0;
    const int t3 = (t + 2 < nt) ? t + 3 : 1;
    F_LDB(B0, F_SB(0, 0)); F_LDA(At, F_SA(0, 0)); F_STAGE_A(F_SA(1, 1), 1, t1);
    G_BAR(); G_WAIT_L0(); G_SCHED(); F_MMA(0, 0, At, B0); G_BAR(); G_SCHED();
    F_LDB(B1, F_SB(0, 1));
    G_BAR(); G_WAIT_L0(); G_SCHED(); F_MMA_STAGE(0, 1, At, B1, F_SB(1, 0), R, 1, t2); G_BAR(); G_SCHED();
    F_LDA(At, F_SA(0, 1)); F_STAGE_A(F_SA(0, 0), 0, t2);
    G_BAR(); G_WAIT_L0(); G_SCHED(); F_MMA(1, 1, At, B1); G_BAR(); G_SCHED();
    F_LDB(B0, F_SB(0, 0));
    G_BAR(); G_WAIT_L0(); G_SCHED(); F_MMA_STAGE(1, 0, At, B0, F_SB(0, 1), R, 0, t2); G_BAR(); G_SCHED();
    F_LDB(B0, F_SB(1, 0)); F_LDA(At, F_SA(1, 0)); F_STAGE_A(F_SA(0, 1), 1, t2);
    G_BAR(); G_WAIT_L0(); G_SCHED(); F_MMA(0, 0, At, B0); G_BAR(); G_SCHED();
    F_LDB(B1, F_SB(1, 1));
    G_BAR(); G_WAIT_L0(); G_SCHED(); F_MMA_STAGE(0, 1, At, B1, F_SB(0, 0), R, 1, t3); G_BAR(); G_SCHED();
    F_LDA(At, F_SA(1, 1)); F_STAGE_A(F_SA(1, 0), 0, t3);
    G_BAR(); G_WAIT_L0(); G_SCHED(); F_MMA(1, 1, At, B1); G_BAR(); G_SCHED();
    F_LDB(B0, F_SB(1, 0));
    G_BAR(); G_WAIT_L0(); G_SCHED(); F_MMA_STAGE(1, 0, At, B0, F_SB(1, 1), R, 0, t3); G_BAR(); G_SCHED();
  }
  F_WAIT_B(0, R); G_SCHED();
  if (wr == 0) G_BAR();
  {
    const int wid2 = wid, ln2 = lane_id_now(), wr2 = wid2 >> 2, wc2 = wid2 & 3, fr2 = ln2 & 15, fq2 = ln2 >> 4;
#pragma unroll
    for (int ai = 0; ai < 2; ++ai)
#pragma unroll
      for (int m = 0; m < 4; ++m)
#pragma unroll
        for (int bj = 0; bj < 2; ++bj)
          cfg.epi(ai * 128 + wr2 * 64 + m * 16 + fr2, bj, wc2, fq2, acc[ai][bj][m][0], acc[ai][bj][m][1]);
  }
  G_BAR();
#undef F_STAGE_A
#undef F_LOAD_B4
#undef F_LOAD_B
#undef F_WRITE_B4
#undef F_WRITE_B
#undef F_WAIT_B
#undef F_LDA
#undef F_LDB
#undef F_MFMA2
#undef F_MMA
#undef F_MMA_STAGE
}

template <class Cfg>
DI void gemm256dma_unit(LDS_AS unsigned char* lds, const Cfg& cfg) {
  const int tid = OPAQUE_TID(cfg.p), wid = __builtin_amdgcn_readfirstlane(tid >> 6), lane = tid & 63, wr = wid >> 2, wc = wid & 3, fr = lane & 15, fq = lane >> 4;
  const int nt = cfg.nkt();
  unsigned voffA[2][2], voffB[2][2];
#pragma unroll
  for (int i = 0; i < 2; ++i) {
    int R, C; stage_rc(tid * 16 + i * 8192, R, C);
    voffA[0][i] = cfg.a_rowoff(R) + (unsigned)C * 2u;
    voffA[1][i] = cfg.a_rowoff(128 + R) + (unsigned)C * 2u;
    voffB[0][i] = cfg.bt_rowoff(0, R) + (unsigned)C * 2u;
    voffB[1][i] = cfg.bt_rowoff(1, R) + (unsigned)C * 2u;
  }
  const __amdgpu_buffer_rsrc_t rsA = __builtin_amdgcn_make_buffer_rsrc((void*)cfg.a_base(), 0, cfg.a_bytes(), 0x00020000);
  const __amdgpu_buffer_rsrc_t rsB = __builtin_amdgcn_make_buffer_rsrc((void*)cfg.bt_base(), 0, cfg.bt_bytes(), 0x00020000);
  const unsigned ldsw = (unsigned)__builtin_amdgcn_readfirstlane((int)(unsigned)(size_t)lds) + (unsigned)wid * 1024u;
#define D_STAGE(rs, voff, slot, half, kt) do { _Pragma("unroll") for (int _i = 0; _i < 2; ++_i) { const unsigned _m0 = ldsw + (unsigned)((slot) + _i * 8192); const unsigned _so = (unsigned)(kt) * 128u; \
    asm volatile("s_mov_b32 m0, %0\n\ts_nop 4\n\tbuffer_load_dwordx4 %1, %2, %3 offen lds" :: "s"(_m0), "v"(voff[half][_i]), "s"(rs), "s"(_so) : "m0", "memory"); } } while (0)
#define D_STAGE_A(slot, half, kt) D_STAGE(rsA, voffA, slot, half, kt)
#define D_STAGE_B(slot, half, kt) D_STAGE(rsB, voffB, slot, half, kt)
  const int aoff = lds_byte(wr * 64 + fr, fq * 8), boff = lds_byte(wc * 32 + fr, fq * 8);
#define D_LDA(dst, slot) do { _Pragma("unroll") for (int m = 0; m < 4; ++m) _Pragma("unroll") for (int k = 0; k < 2; ++k) \
    dst[m][k] = *(const LDS_AS bf16x8*)(lds + (slot) + aoff + m * 2048 + k * 1024); } while (0)
#define D_LDB(dst, slot) do { _Pragma("unroll") for (int n = 0; n < 2; ++n) _Pragma("unroll") for (int k = 0; k < 2; ++k) \
    dst[n][k] = *(const LDS_AS bf16x8*)(lds + (slot) + boff + n * 2048 + k * 1024); } while (0)
#define D_MMA(ai, bj, At, Bf) do { __builtin_amdgcn_s_setprio(1); _Pragma("unroll") for (int m = 0; m < 4; ++m) _Pragma("unroll") for (int n = 0; n < 2; ++n) _Pragma("unroll") for (int k = 0; k < 2; ++k) \
    acc[ai][bj][m][n] = __builtin_amdgcn_mfma_f32_16x16x32_bf16(Bf[n][k], At[m][k], acc[ai][bj][m][n], 0, 0, 0); __builtin_amdgcn_s_setprio(0); } while (0)
#define D_WAIT_L(n) asm volatile("s_waitcnt lgkmcnt(" #n ")" ::: "memory")
  f32x4 acc[2][2][4][2];
#pragma unroll
  for (int a = 0; a < 2; ++a)
#pragma unroll
    for (int b = 0; b < 2; ++b)
#pragma unroll
      for (int m = 0; m < 4; ++m)
#pragma unroll
        for (int n = 0; n < 2; ++n) acc[a][b][m][n] = (f32x4){0.f, 0.f, 0.f, 0.f};
  bf16x8 At[4][2], B0[2][2], B1[2][2];
  D_STAGE_B(G_SB(0, 0), 0, 0); D_STAGE_A(G_SA(0, 0), 0, 0); D_STAGE_B(G_SB(0, 1), 1, 0); D_STAGE_A(G_SA(0, 1), 1, 0);
  if (wr == 1) G_BAR();
  G_WAIT_V(4); G_BAR();
  D_STAGE_B(G_SB(1, 0), 0, 1); D_STAGE_A(G_SA(1, 0), 0, 1); D_STAGE_B(G_SB(1, 1), 1, 1);
  G_WAIT_V(6); G_BAR();
#pragma clang loop unroll(disable)
  for (int t = 0; t < nt; t += 2) {
    const int t1 = t + 1;
    const int t2 = (t + 2 < nt) ? t + 2 : 0;
    const int t3 = (t + 2 < nt) ? t + 3 : 1;
    D_LDB(B0, G_SB(0, 0)); G_SCHED(); D_LDA(At, G_SA(0, 0)); D_STAGE_A(G_SA(1, 1), 1, t1);
    D_WAIT_L(8); G_BAR(); D_WAIT_L(0); G_SCHED(); D_MMA(0, 0, At, B0); G_BAR(); G_SCHED();
    D_LDB(B1, G_SB(0, 1)); D_STAGE_B(G_SB(0, 0), 0, t2);
    G_BAR(); D_WAIT_L(0); G_SCHED(); D_MMA(0, 1, At, B1); G_BAR(); G_SCHED();
    D_LDA(At, G_SA(0, 1)); D_STAGE_A(G_SA(0, 0), 0, t2);
    G_BAR(); D_WAIT_L(0); G_SCHED(); D_MMA(1, 0, At, B0); G_BAR(); G_SCHED();
    D_STAGE_B(G_SB(0, 1), 1, t2);
    G_WAIT_V(6); G_BAR(); G_SCHED(); D_MMA(1, 1, At, B1); G_BAR(); G_SCHED();
    D_LDB(B0, G_SB(1, 0)); G_SCHED(); D_LDA(At, G_SA(1, 0)); D_STAGE_A(G_SA(0, 1), 1, t2);
    D_WAIT_L(8); G_BAR(); D_WAIT_L(0); G_SCHED(); D_MMA(0, 0, At, B0); G_BAR(); G_SCHED();
    D_LDB(B1, G_SB(1, 1)); D_STAGE_B(G_SB(1, 0), 0, t3);
    G_BAR(); D_WAIT_L(0); G_SCHED(); D_MMA(0, 1, At, B1); G_BAR(); G_SCHED();
    D_LDA(At, G_SA(1, 1)); D_STAGE_A(G_SA(1, 0), 0, t3);
    G_BAR(); D_WAIT_L(0); G_SCHED(); D_MMA(1, 0, At, B0); G_BAR(); G_SCHED();
    D_STAGE_B(G_SB(1, 1), 1, t3);
    G_WAIT_V(6); G_BAR(); G_SCHED(); D_MMA(1, 1, At, B1); G_BAR(); G_SCHED();
  }
  G_WAIT_V(0);
  if (wr == 0) G_BAR();
  {
    const int wid2 = wid, ln2 = lane_id_now(), wr2 = wid2 >> 2, wc2 = wid2 & 3, fr2 = ln2 & 15, fq2 = ln2 >> 4;
#pragma unroll
    for (int ai = 0; ai < 2; ++ai)
#pragma unroll
      for (int m = 0; m < 4; ++m)
#pragma unroll
        for (int bj = 0; bj < 2; ++bj)
          cfg.epi(ai * 128 + wr2 * 64 + m * 16 + fr2, bj, wc2, fq2, acc[ai][bj][m][0], acc[ai][bj][m][1]);
  }
  G_BAR();
#undef D_STAGE
#undef D_STAGE_A
#undef D_STAGE_B
#undef D_LDA
#undef D_LDB
#undef D_MMA
#undef D_WAIT_L
}

#ifndef F8_PEEL
#define F8_PEEL 0
#endif
#ifndef EPI_HOIST
#define EPI_HOIST 1
#endif
template <class Cfg>
DI void f8dma_issue_prologue(LDS_AS unsigned char* lds, const Cfg& cfg) {
  const int tid = OPAQUE_TID(cfg.p), wid = __builtin_amdgcn_readfirstlane(tid >> 6), lane = tid & 63;
  unsigned voffA[2][2], voffB0;
#pragma unroll
  for (int i = 0; i < 2; ++i) {
    const int r = 8 * (wid + 8 * i) + (lane >> 3);
    const unsigned cofs = 16u * (((unsigned)lane & 7u) ^ (((unsigned)lane >> 3) & 7u));
    voffA[0][i] = cfg.a_rowoff(r) + cofs;
    voffA[1][i] = cfg.a_rowoff(128 + r) + cofs;
    if (i == 0) voffB0 = cfg.bt_rowoff(0, r) + cofs;
  }
  const unsigned bt_half = cfg.bt_rowoff(1, 0) - cfg.bt_rowoff(0, 0), bt_piece = cfg.bt_rowoff(0, 64) - cfg.bt_rowoff(0, 0);
  const __amdgpu_buffer_rsrc_t rsA = __builtin_amdgcn_make_buffer_rsrc((void*)cfg.a_base(), 0, cfg.a_bytes(), 0x00020000);
  const __amdgpu_buffer_rsrc_t rsB = __builtin_amdgcn_make_buffer_rsrc((void*)cfg.bt_base(), 0, cfg.bt_bytes(), 0x00020000);
  const unsigned ldsw = (unsigned)__builtin_amdgcn_readfirstlane((int)(unsigned)(size_t)lds) + (unsigned)wid * 1024u;
#define P_STAGE_A(slot, half, kt) do { _Pragma("unroll") for (int _i = 0; _i < 2; ++_i) { const unsigned _m0 = ldsw + (unsigned)((slot) + _i * 8192); const unsigned _so = (unsigned)(kt) * 128u; \
    asm volatile("s_mov_b32 m0, %0\n\ts_nop 4\n\tbuffer_load_dwordx4 %1, %2, %3 offen lds" :: "s"(_m0), "v"(voffA[half][_i]), "s"(rsA), "s"(_so) : "m0", "memory"); } } while (0)
#define P_STAGE_B(slot, half, kt) do { _Pragma("unroll") for (int _i = 0; _i < 2; ++_i) { const unsigned _m0 = ldsw + (unsigned)((slot) + _i * 8192); const unsigned _so = (unsigned)(kt) * 128u + (half) * bt_half + _i * bt_piece; \
    asm volatile("s_mov_b32 m0, %0\n\ts_nop 4\n\tbuffer_load_dwordx4 %1, %2, %3 offen lds" :: "s"(_m0), "v"(voffB0), "s"(rsB), "s"(_so) : "m0", "memory"); } } while (0)
  P_STAGE_B(G_SB(0, 0), 0, 0); P_STAGE_A(G_SA(0, 0), 0, 0); P_STAGE_B(G_SB(0, 1), 1, 0); P_STAGE_A(G_SA(0, 1), 1, 0);
  P_STAGE_B(G_SB(1, 0), 0, 1); P_STAGE_A(G_SA(1, 0), 0, 1); P_STAGE_B(G_SB(1, 1), 1, 1);
#undef P_STAGE_A
#undef P_STAGE_B
}
constexpr int F8_STASH = G256F8_LDS + 1024;
template <class Cfg>
DI void f8dma_issue_prologue_st(LDS_AS unsigned char* lds, const Cfg& cfg) {
  const int tid = OPAQUE_TID(cfg.p), wid = __builtin_amdgcn_readfirstlane(tid >> 6), lane = tid & 63;
  const LDS_AS unsigned* stash = (const LDS_AS unsigned*)(lds + F8_STASH);
  unsigned voffA[2][2], voffB0;
  voffA[0][0] = stash[tid]; voffA[0][1] = stash[512 + tid]; voffA[1][0] = stash[1024 + tid]; voffA[1][1] = stash[1536 + tid];
  {
    const int r = 8 * wid + (lane >> 3);
    const unsigned cofs = 16u * (((unsigned)lane & 7u) ^ (((unsigned)lane >> 3) & 7u));
    voffB0 = cfg.bt_rowoff(0, r) + cofs;
  }
  const unsigned bt_half = cfg.bt_rowoff(1, 0) - cfg.bt_rowoff(0, 0), bt_piece = cfg.bt_rowoff(0, 64) - cfg.bt_rowoff(0, 0);
  const __amdgpu_buffer_rsrc_t rsA = __builtin_amdgcn_make_buffer_rsrc((void*)cfg.a_base(), 0, cfg.a_bytes(), 0x00020000);
  const __amdgpu_buffer_rsrc_t rsB = __builtin_amdgcn_make_buffer_rsrc((void*)cfg.bt_base(), 0, cfg.bt_bytes(), 0x00020000);
  const unsigned ldsw = (unsigned)__builtin_amdgcn_readfirstlane((int)(unsigned)(size_t)lds) + (unsigned)wid * 1024u;
#define P_STAGE_A(slot, half, kt) do { _Pragma("unroll") for (int _i = 0; _i < 2; ++_i) { const unsigned _m0 = ldsw + (unsigned)((slot) + _i * 8192); const unsigned _so = (unsigned)(kt) * 128u; \
    asm volatile("s_mov_b32 m0, %0\n\ts_nop 4\n\tbuffer_load_dwordx4 %1, %2, %3 offen lds" :: "s"(_m0), "v"(voffA[half][_i]), "s"(rsA), "s"(_so) : "m0", "memory"); } } while (0)
#define P_STAGE_B(slot, half, kt) do { _Pragma("unroll") for (int _i = 0; _i < 2; ++_i) { const unsigned _m0 = ldsw + (unsigned)((slot) + _i * 8192); const unsigned _so = (unsigned)(kt) * 128u + (half) * bt_half + _i * bt_piece; \
    asm volatile("s_mov_b32 m0, %0\n\ts_nop 4\n\tbuffer_load_dwordx4 %1, %2, %3 offen lds" :: "s"(_m0), "v"(voffB0), "s"(rsB), "s"(_so) : "m0", "memory"); } } while (0)
  P_STAGE_B(G_SB(0, 0), 0, 0); P_STAGE_A(G_SA(0, 0), 0, 0); P_STAGE_B(G_SB(0, 1), 1, 0); P_STAGE_A(G_SA(0, 1), 1, 0);
  P_STAGE_B(G_SB(1, 0), 0, 1); P_STAGE_A(G_SA(1, 0), 0, 1); P_STAGE_B(G_SB(1, 1), 1, 1);
#undef P_STAGE_A
#undef P_STAGE_B
}
template <class Cfg, bool TOPHALF = false, bool PRE = false, int PMODE = 0>
DI void gemm256f8dma_unit(LDS_AS unsigned char* lds, const Cfg& cfg, bool has_nxt, const Cfg& nxt) {
  const int tid = OPAQUE_TID(cfg.p), wid = __builtin_amdgcn_readfirstlane(tid >> 6), lane = tid & 63, wr = wid >> 2, wc = wid & 3, fr = lane & 15, fq = lane >> 4;
  const int nt = PMODE == 2 ? cfg.nkt() / 2 : cfg.nkt();
  unsigned voffA[2][2], voffB0;
  {
    LDS_AS unsigned* stash = (LDS_AS unsigned*)(lds + F8_STASH);
    if (PRE) { voffA[0][0] = stash[tid]; voffA[0][1] = stash[512 + tid]; voffA[1][0] = stash[1024 + tid]; voffA[1][1] = stash[1536 + tid]; }
#pragma unroll
    for (int i = 0; i < 2; ++i) {
      const int r = 8 * (wid + 8 * i) + (lane >> 3);
      const unsigned cofs = 16u * (((unsigned)lane & 7u) ^ (((unsigned)lane >> 3) & 7u));
      if (!PRE) { voffA[0][i] = cfg.a_rowoff(r) + cofs; voffA[1][i] = cfg.a_rowoff(128 + r) + cofs; }
      if (i == 0) voffB0 = cfg.bt_rowoff(0, r) + cofs;
    }
    if (has_nxt) {
#pragma unroll
      for (int i = 0; i < 2; ++i) {
        const int r = 8 * (wid + 8 * i) + (lane >> 3);
        const unsigned cofs = 16u * (((unsigned)lane & 7u) ^ (((unsigned)lane >> 3) & 7u));
        stash[i * 512 + tid] = nxt.a_rowoff(r) + cofs;
        stash[(2 + i) * 512 + tid] = nxt.a_rowoff(128 + r) + cofs;
      }
    }
  }
  const unsigned bt_half = cfg.bt_rowoff(1, 0) - cfg.bt_rowoff(0, 0), bt_piece = cfg.bt_rowoff(0, 64) - cfg.bt_rowoff(0, 0);
  const __amdgpu_buffer_rsrc_t rsA = __builtin_amdgcn_make_buffer_rsrc((void*)cfg.a_base(), 0, cfg.a_bytes(), 0x00020000);
  const __amdgpu_buffer_rsrc_t rsB = __builtin_amdgcn_make_buffer_rsrc((void*)cfg.bt_base(), 0, cfg.bt_bytes(), 0x00020000);
  const unsigned ldsw = (unsigned)__builtin_amdgcn_readfirstlane((int)(unsigned)(size_t)lds) + (unsigned)wid * 1024u;
#define D_STAGE(rs, voff, slot, half, kt) do { _Pragma("unroll") for (int _i = 0; _i < 2; ++_i) { const unsigned _m0 = ldsw + (unsigned)((slot) + _i * 8192); const unsigned _so = (unsigned)(kt) * 128u; \
    asm volatile("s_mov_b32 m0, %0\n\ts_nop 4\n\tbuffer_load_dwordx4 %1, %2, %3 offen lds" :: "s"(_m0), "v"(voff[half][_i]), "s"(rs), "s"(_so) : "m0", "memory"); } } while (0)
#define D_STAGE_A(slot, half, kt) D_STAGE(rsA, voffA, slot, half, kt)
#define D_STAGE_B(slot, half, kt) do { _Pragma("unroll") for (int _i = 0; _i < 2; ++_i) { const unsigned _m0 = ldsw + (unsigned)((slot) + _i * 8192); const unsigned _so = (unsigned)(kt) * 128u + (half) * bt_half + _i * bt_piece; \
    asm volatile("s_mov_b32 m0, %0\n\ts_nop 4\n\tbuffer_load_dwordx4 %1, %2, %3 offen lds" :: "s"(_m0), "v"(voffB0), "s"(rsB), "s"(_so) : "m0", "memory"); } } while (0)
  unsigned aoff[2], boff[2];
#pragma unroll
  for (int j = 0; j < 2; ++j) {
    aoff[j] = (unsigned)(64 * wr + fr) * 128u + 16u * ((2u * fq + j) ^ ((unsigned)fr & 7u));
    boff[j] = (unsigned)(32 * wc + fr) * 128u + 16u * ((2u * fq + j) ^ ((unsigned)fr & 7u));
  }
#define D_LDA(dst, slot) do { _Pragma("unroll") for (int m = 0; m < 4; ++m) { \
    const i32x4 _lo = *(const LDS_AS i32x4*)(lds + (slot) + aoff[0] + m * 2048); const i32x4 _hi = *(const LDS_AS i32x4*)(lds + (slot) + aoff[1] + m * 2048); \
    dst[m] = __builtin_shufflevector(_lo, _hi, 0, 1, 2, 3, 4, 5, 6, 7); } } while (0)
#define D_LDB(dst, slot) do { _Pragma("unroll") for (int n = 0; n < 2; ++n) { \
    const i32x4 _lo = *(const LDS_AS i32x4*)(lds + (slot) + boff[0] + n * 2048); const i32x4 _hi = *(const LDS_AS i32x4*)(lds + (slot) + boff[1] + n * 2048); \
    dst[n] = __builtin_shufflevector(_lo, _hi, 0, 1, 2, 3, 4, 5, 6, 7); } } while (0)
  const int scw = cfg.scale_w(), scx = cfg.scale_x();
#define D_MMA(ai, bj, At, Bf) do { if ((ai) && TOPHALF) break; __builtin_amdgcn_s_setprio(1); _Pragma("unroll") for (int m = 0; m < 4; ++m) _Pragma("unroll") for (int n = 0; n < 2; ++n) \
    acc[ai][bj][m][n] = __builtin_amdgcn_mfma_scale_f32_16x16x128_f8f6f4(Bf[n], At[m], acc[ai][bj][m][n], 0, 0, 0, scw, 0, scx); __builtin_amdgcn_s_setprio(0); } while (0)
#define D_PIN(ai, bj) do { if ((ai) && TOPHALF) break; asm volatile("" : "+v"(acc[ai][bj][0][0]), "+v"(acc[ai][bj][0][1]), "+v"(acc[ai][bj][1][0]), "+v"(acc[ai][bj][1][1]), \
    "+v"(acc[ai][bj][2][0]), "+v"(acc[ai][bj][2][1]), "+v"(acc[ai][bj][3][0]), "+v"(acc[ai][bj][3][1])); } while (0)
#define D_WAIT_L(n) asm volatile("s_waitcnt lgkmcnt(" #n ")" ::: "memory")
  f32x4 acc[2][2][4][2];
#pragma unroll
  for (int a = 0; a < 2; ++a)
#pragma unroll
    for (int b = 0; b < 2; ++b)
#pragma unroll
      for (int m = 0; m < 4; ++m)
#pragma unroll
        for (int n = 0; n < 2; ++n) acc[a][b][m][n] = (f32x4){0.f, 0.f, 0.f, 0.f};
  i32x8 At[4], B0[2], B1[2];
  if (!PRE) {
    D_STAGE_B(G_SB(0, 0), 0, 0); D_STAGE_A(G_SA(0, 0), 0, 0); D_STAGE_B(G_SB(0, 1), 1, 0); D_STAGE_A(G_SA(0, 1), 1, 0);
    D_STAGE_B(G_SB(1, 0), 0, 1); D_STAGE_A(G_SA(1, 0), 0, 1); D_STAGE_B(G_SB(1, 1), 1, 1);
  }
  if (!PRE) G_WAIT_V(0);
  G_BAR();
  if (wr == 1) G_BAR();
#pragma clang loop unroll(disable)
  for (int t = 0; t < (F8_PEEL ? nt - 2 : nt); t += 2) {
    const int t1 = t + 1;
    const int t2 = (F8_PEEL || t + 2 < nt) ? t + 2 : t;
    const int t3 = (F8_PEEL || t + 2 < nt) ? t + 3 : t + 1;
    D_LDB(B0, G_SB(0, 0)); G_SCHED(); D_LDA(At, G_SA(0, 0)); D_STAGE_A(G_SA(1, 1), 1, t1);
    D_WAIT_L(8); G_BAR(); D_WAIT_L(0); G_SCHED(); D_MMA(0, 0, At, B0); G_BAR(); G_SCHED();
    D_LDB(B1, G_SB(0, 1)); D_STAGE_B(G_SB(0, 0), 0, t2);
    G_BAR(); D_WAIT_L(0); G_SCHED(); D_MMA(0, 1, At, B1); G_BAR(); G_SCHED();
    D_LDA(At, G_SA(0, 1)); D_STAGE_A(G_SA(0, 0), 0, t2);
    G_BAR(); D_WAIT_L(0); G_SCHED(); D_MMA(1, 0, At, B0); G_BAR(); G_SCHED();
    D_STAGE_B(G_SB(0, 1), 1, t2);
    G_WAIT_V(6); G_BAR(); G_SCHED(); D_MMA(1, 1, At, B1); G_BAR(); G_SCHED();
    D_LDB(B0, G_SB(1, 0)); G_SCHED(); D_LDA(At, G_SA(1, 0)); D_STAGE_A(G_SA(0, 1), 1, t2);
    D_WAIT_L(8); G_BAR(); D_WAIT_L(0); G_SCHED(); D_MMA(0, 0, At, B0); G_BAR(); G_SCHED();
    D_LDB(B1, G_SB(1, 1)); D_STAGE_B(G_SB(1, 0), 0, t3);
    G_BAR(); D_WAIT_L(0); G_SCHED(); D_MMA(0, 1, At, B1); G_BAR(); G_SCHED();
    D_LDA(At, G_SA(1, 1)); D_STAGE_A(G_SA(1, 0), 0, t3);
    G_BAR(); D_WAIT_L(0); G_SCHED(); D_MMA(1, 0, At, B0); G_BAR(); G_SCHED();
    D_STAGE_B(G_SB(1, 1), 1, t3);
    G_WAIT_V(6); G_BAR(); G_SCHED(); D_MMA(1, 1, At, B1); G_BAR(); G_SCHED();
  }
  if (!F8_PEEL) G_WAIT_V(0);
  if (F8_PEEL) {
    D_LDB(B0, G_SB(0, 0)); G_SCHED(); D_LDA(At, G_SA(0, 0)); D_STAGE_A(G_SA(1, 1), 1, nt - 1);
    D_WAIT_L(8); G_BAR(); D_WAIT_L(0); G_SCHED(); D_MMA(0, 0, At, B0); D_PIN(0, 0); G_BAR(); G_SCHED();
    D_LDB(B1, G_SB(0, 1));
    G_BAR(); D_WAIT_L(0); G_SCHED(); D_MMA(0, 1, At, B1); D_PIN(0, 1); G_BAR(); G_SCHED();
    D_LDA(At, G_SA(0, 1));
    G_BAR(); D_WAIT_L(0); G_SCHED(); D_MMA(1, 0, At, B0); D_PIN(1, 0); G_BAR(); G_SCHED();
    G_WAIT_V(0); G_BAR(); G_SCHED(); D_MMA(1, 1, At, B1); D_PIN(1, 1); G_BAR(); G_SCHED();
    D_LDB(B0, G_SB(1, 0)); G_SCHED(); D_LDA(At, G_SA(1, 0));
    D_WAIT_L(8); G_BAR(); D_WAIT_L(0); G_SCHED(); D_MMA(0, 0, At, B0); D_PIN(0, 0); G_BAR(); G_SCHED();
    D_LDB(B1, G_SB(1, 1));
    G_BAR(); D_WAIT_L(0); G_SCHED(); D_MMA(0, 1, At, B1); D_PIN(0, 1); G_BAR(); G_SCHED();
    D_LDA(At, G_SA(1, 1));
    G_BAR(); D_WAIT_L(0); G_SCHED(); D_MMA(1, 0, At, B0); D_PIN(1, 0); G_BAR(); G_SCHED();
    G_BAR(); G_SCHED(); D_MMA(1, 1, At, B1); D_PIN(1, 1); G_BAR(); G_SCHED();
  }
  if (wr == 0) G_BAR();
  if (has_nxt) f8dma_issue_prologue_st(lds, nxt);
  {
    const int wid2 = wid, ln2 = lane_id_now(), wr2 = wid2 >> 2, wc2 = wid2 & 3, fr2 = ln2 & 15, fq2 = ln2 >> 4;
    if (PMODE == 0 && EPI_HOIST) {
      typename Cfg::RowTok tok[2][4];
#pragma unroll
      for (int ai = 0; ai < 2; ++ai)
#pragma unroll
        for (int m = 0; m < 4; ++m) tok[ai][m] = cfg.row_tok(ai * 128 + wr2 * 64 + m * 16 + fr2);
      typename Cfg::ColCtx cc[2];
#pragma unroll
      for (int bj = 0; bj < 2; ++bj) cc[bj] = cfg.col_ctx(bj, wc2, fq2);
      if (has_nxt) { G_WAIT_V(0); G_SCHED(); }
#pragma unroll
      for (int ai = 0; ai < 2; ++ai)
#pragma unroll
        for (int m = 0; m < 4; ++m)
#pragma unroll
          for (int bj = 0; bj < 2; ++bj) cfg.epi_t(tok[ai][m], cc[bj], acc[ai][bj][m][0], acc[ai][bj][m][1]);
    } else if (PMODE == 0) {
      if (has_nxt) G_WAIT_V(0);
#pragma unroll
      for (int ai = 0; ai < 2; ++ai)
#pragma unroll
        for (int m = 0; m < 4; ++m)
#pragma unroll
          for (int bj = 0; bj < 2; ++bj) cfg.epi(ai * 128 + wr2 * 64 + m * 16 + fr2, bj, wc2, fq2, acc[ai][bj][m][0], acc[ai][bj][m][1]);
    } else {
      if (has_nxt) G_WAIT_V(0);
#pragma unroll
      for (int ai = 0; ai < 2; ++ai)
#pragma unroll
        for (int m = 0; m < 4; ++m)
#pragma unroll
          for (int bj = 0; bj < 2; ++bj) asm volatile("" :: "v"(acc[ai][bj][m][0]), "v"(acc[ai][bj][m][1]));
    }
  }
  if (!has_nxt) G_BAR();
#undef D_STAGE
#undef D_STAGE_A
#undef D_STAGE_B
#undef D_LDA
#undef D_LDB
#undef D_MMA
#undef D_WAIT_L
#undef D_PIN
}

DI void convert_tile(const float* W, int ldw, bf16_t* Wt, int K, int kt, int ntile, float* tl, int tid) {
  {
    const int r = tid >> 4, c4 = (tid & 15) * 4;
#pragma unroll
    for (int i = 0; i < 2; ++i) {
      const float4 v = *(const float4*)(W + (size_t)(kt * 64 + r + 32 * i) * ldw + ntile * 64 + c4);
      float* d = tl + (r + 32 * i) * 65 + c4;
      d[0] = v.x; d[1] = v.y; d[2] = v.z; d[3] = v.w;
    }
  }
  __syncthreads();
  {
    const int n = tid >> 3, kc = (tid & 7) * 8;
    uint4 o;
    o.x = pack2(tl[(kc + 0) * 65 + n], tl[(kc + 1) * 65 + n]); o.y = pack2(tl[(kc + 2) * 65 + n], tl[(kc + 3) * 65 + n]);
    o.z = pack2(tl[(kc + 4) * 65 + n], tl[(kc + 5) * 65 + n]); o.w = pack2(tl[(kc + 6) * 65 + n], tl[(kc + 7) * 65 + n]);
    *(uint4*)(Wt + (size_t)(ntile * 64 + n) * K + kt * 64 + kc) = o;
  }
  __syncthreads();
}
DI void phase_convert(const Params& p, char* smem, int bid, int nb) {
  float* tl = (float*)smem;
  const int tid = OPAQUE_TID(p);
  constexpr int U0 = 32 * 61, U1 = U0 + 32 * 32, U2 = U1 + 8 * 24, U3 = U2 + 4 * 32;
  const int nmine = bid < U3 ? (U3 - bid + nb - 1) / nb : 0;
  const int r = tid >> 4, c4 = (tid & 15) * 4;
  const int n = tid >> 3, kc = (tid & 7) * 8;
  f32x4 a[4][2];
#define DC_DECODE(i) \
    const int _u0 = bid + (i) * nb; const bool _ok = _u0 < U3; const int _u = __builtin_amdgcn_readfirstlane(_ok ? _u0 : U3 - 1); \
    const int _w = _u < U0 ? 0 : (_u < U1 ? 1 : (_u < U2 ? 2 : 3)); \
    const int _v = _u - (_w == 0 ? 0 : (_w == 1 ? U0 : (_w == 2 ? U1 : U2))); \
    const int _nn = _w == 0 ? 61 : (_w == 2 ? 24 : 32); \
    const int _kt = _w == 0 ? (int)((unsigned)_v / 61u) : (_w == 2 ? (int)((unsigned)_v / 24u) : (_v >> 5)), _nt = _v - _kt * _nn;     \
    const unsigned long long _m0 = _w == 0 ? ~0ull : 0ull, _m1 = _w == 1 ? ~0ull : 0ull, _m2 = _w == 2 ? ~0ull : 0ull, _m3 = _w == 3 ? ~0ull : 0ull;     \
    const float* _W = (const float*)(((unsigned long long)p.w_in & _m0) | ((unsigned long long)p.w_o & _m1) | ((unsigned long long)p.w_q_b & _m2) | ((unsigned long long)p.w_kv_b & _m3)); \
    const int _ldw = _w == 0 ? INP : (_w == 2 ? 1536 : 2048); \
    bf16_t* _Wt = (bf16_t*)(((unsigned long long)p.wt_in & _m0) | ((unsigned long long)p.wt_o & _m1) | ((unsigned long long)p.wt_q & _m2) | ((unsigned long long)p.wt_kv & _m3)); \
    const int _K = _w == 2 ? 512 : (_w == 3 ? 256 : 2048);
#define DC_LOAD(slot, i) do { DC_DECODE(i) (void)_Wt; (void)_K; \
    _Pragma("unroll") for (int _q = 0; _q < 2; ++_q) { const float* _src = _W + (size_t)(_kt * 64 + r + 32 * _q) * _ldw + _nt * 64 + c4; \
      asm volatile("global_load_dwordx4 %0, %1, off" : "=v"(a[slot][_q]) : "v"(_src) : "memory"); } } while (0)
#define DC_TILE(slot, i, N) do { \
    float* _tl = tl + (((slot) & 1) ? 64 * 65 : 0); \
    asm volatile("s_waitcnt vmcnt(" #N ")" : "+v"(a[slot][0]), "+v"(a[slot][1]) :: "memory");        \
    _Pragma("unroll") for (int _q = 0; _q < 2; ++_q) { float* d = _tl + (r + 32 * _q) * 65 + c4; d[0] = a[slot][_q][0]; d[1] = a[slot][_q][1]; d[2] = a[slot][_q][2]; d[3] = a[slot][_q][3]; } \
    unsigned char* _dst; { DC_DECODE(i) (void)_W; (void)_ldw; \
      _dst = _ok ? (unsigned char*)(_Wt + (size_t)(_nt * 64 + n) * _K + _kt * 64 + kc) : p.cvdump + (size_t)n * 128 + kc * 2; } \
    asm volatile("s_waitcnt lgkmcnt(0)" ::: "memory");        \
    __builtin_amdgcn_sched_barrier(0); \
    DC_LOAD(slot, (i) + 4); \
    __syncthreads(); \
    uint4 o; \
    o.x = pack2(_tl[(kc + 0) * 65 + n], _tl[(kc + 1) * 65 + n]); o.y = pack2(_tl[(kc + 2) * 65 + n], _tl[(kc + 3) * 65 + n]); \
    o.z = pack2(_tl[(kc + 4) * 65 + n], _tl[(kc + 5) * 65 + n]); o.w = pack2(_tl[(kc + 6) * 65 + n], _tl[(kc + 7) * 65 + n]); \
    { u32x4 _o = {o.x, o.y, o.z, o.w}; asm volatile("global_store_dwordx4 %0, %1, off\n\ts_nop 1" :: "v"(_dst), "v"(_o) : "memory"); }   \
  } while (0)
  DC_LOAD(0, 0); DC_LOAD(1, 1); DC_LOAD(2, 2); DC_LOAD(3, 3);
#pragma unroll 1
  DC_TILE(0, 0, 6); DC_TILE(1, 1, 6); DC_TILE(2, 2, 6); DC_TILE(3, 3, 6);
  for (int i0 = 4; i0 < nmine; i0 += 4) { DC_TILE(0, i0, 6); DC_TILE(1, i0 + 1, 6); DC_TILE(2, i0 + 2, 6); DC_TILE(3, i0 + 3, 6); }
  asm volatile("s_waitcnt vmcnt(0)" : "+v"(a[0][0]), "+v"(a[0][1]), "+v"(a[1][0]), "+v"(a[1][1]), "+v"(a[2][0]), "+v"(a[2][1]), "+v"(a[3][0]), "+v"(a[3][1]) :: "memory");
#undef DC_TILE
#undef DC_LOAD
#undef DC_DECODE
  __syncthreads();
  for (int i = bid * NTHREADS + tid; i < 192 * 256; i += nb * NTHREADS) *(uint4*)(p.wt_in + (size_t)3904 * 2048 + (size_t)i * 8) = make_uint4(0u, 0u, 0u, 0u);
}


#define CVX_E(t) ((t) < 16384 ? ((t) >> 9) : (((t) - 16384) >> 10))
#define CVX_R(t) ((t) < 16384 ? (1024 + ((t) & 511)) : (((t) - 16384) & 1023))
DI void cvx_addr(const Params& p, int t, const float*& W, int& ldw, unsigned char*& Wq, int& kt, int& ntile) {
  const int e = CVX_E(t), r = CVX_R(t);
  if (r < 1024) { W = p.w_gate_up + (size_t)e * 2048 * 4096; ldw = 4096; Wq = p.wq1 + (size_t)e * 4096 * 2048; kt = r >> 6; ntile = r & 63; }
  else { const int q = r - 1024; W = p.w_down + (size_t)e * 2048 * 2048; ldw = 2048; Wq = p.wq2 + (size_t)e * 2048 * 2048; kt = q >> 5; ntile = q & 31; }
}
DI void cvx_load(const Params& p, int t, int r, int c4, float4 (&v)[4]) {
  if (t < 32 * 1536) {
    const float* W; int ldw, kt, ntile; unsigned char* Wq;
    cvx_addr(p, t, W, ldw, Wq, kt, ntile);
#pragma unroll
    for (int i = 0; i < 4; ++i) { const f32x4 q = __builtin_nontemporal_load((const f32x4*)(W + (size_t)(kt * 128 + r + 32 * i) * ldw + ntile * 64 + c4)); v[i] = make_float4(q[0], q[1], q[2], q[3]); }
  } else {
#pragma unroll
    for (int i = 0; i < 4; ++i) v[i] = make_float4(0.f, 0.f, 0.f, 0.f);
  }
}
DI void cvx_store(const Params& p, int t, int tid, int r, int c4, const float4 (&v)[4], float* tl) {
  if (t >= 32 * 1536) { __syncthreads(); return; }
  const float* W; int ldw, kt, ntile; unsigned char* Wq;
  cvx_addr(p, t, W, ldw, Wq, kt, ntile);
#pragma unroll
  for (int i = 0; i < 4; ++i) {
    float* d = tl + (r + 32 * i) * 65 + c4;
    d[0] = v[i].x * 512.f; d[1] = v[i].y * 512.f; d[2] = v[i].z * 512.f; d[3] = v[i].w * 512.f;
  }
  __syncthreads();
  {
    const int n = tid & 63, kc = (tid >> 6) * 16;
    uint4 o;
    o.x = (unsigned)pack4_fp8(tl[(kc + 0) * 65 + n], tl[(kc + 1) * 65 + n], tl[(kc + 2) * 65 + n], tl[(kc + 3) * 65 + n]);
    o.y = (unsigned)pack4_fp8(tl[(kc + 4) * 65 + n], tl[(kc + 5) * 65 + n], tl[(kc + 6) * 65 + n], tl[(kc + 7) * 65 + n]);
    o.z = (unsigned)pack4_fp8(tl[(kc + 8) * 65 + n], tl[(kc + 9) * 65 + n], tl[(kc + 10) * 65 + n], tl[(kc + 11) * 65 + n]);
    o.w = (unsigned)pack4_fp8(tl[(kc + 12) * 65 + n], tl[(kc + 13) * 65 + n], tl[(kc + 14) * 65 + n], tl[(kc + 15) * 65 + n]);
    *(uint4*)(Wq + (size_t)(ntile * 64 + n) * 2048 + kt * 128 + kc) = o;
  }
}
DI void convert_chunk(const Params& p, char* smem, int bid, int nb, int slot, const int CVX_SLOTS) {
  float* tl = (float*)smem;
  const int tid = OPAQUE_TID(p);
  const int r = tid >> 4, c4 = (tid & 15) * 4;
  constexpr int NT = 32 * 1536;
  const int nper = (NT + nb - 1) / nb;
  const int i0 = nper * slot / CVX_SLOTS, i1 = nper * (slot + 1) / CVX_SLOTS;
#define CVX_T(i) ((i) < i1 ? bid + (i) * nb : NT)
  float4 a0[4], a1[4], a2[4], a3[4];
  cvx_load(p, CVX_T(i0), r, c4, a0); cvx_load(p, CVX_T(i0 + 1), r, c4, a1); cvx_load(p, CVX_T(i0 + 2), r, c4, a2); cvx_load(p, CVX_T(i0 + 3), r, c4, a3);
#pragma unroll 1
  for (int i = i0; i < i1; i += 4) {
    float4 b0[4], b1[4], b2[4], b3[4];
    cvx_load(p, CVX_T(i + 4), r, c4, b0); cvx_load(p, CVX_T(i + 5), r, c4, b1); cvx_load(p, CVX_T(i + 6), r, c4, b2); cvx_load(p, CVX_T(i + 7), r, c4, b3);
    cvx_store(p, CVX_T(i), tid, r, c4, a0, tl);
    cvx_store(p, CVX_T(i + 1), tid, r, c4, a1, tl + 128 * 65);
    cvx_store(p, CVX_T(i + 2), tid, r, c4, a2, tl);
    cvx_store(p, CVX_T(i + 3), tid, r, c4, a3, tl + 128 * 65);
#pragma unroll
    for (int k = 0; k < 4; ++k) { a0[k] = b0[k]; a1[k] = b1[k]; a2[k] = b2[k]; a3[k] = b3[k]; }
  }
#undef CVX_T
  __syncthreads();
}

template <int NS, bool STREAM_ONLY = false>
DI void convert_experts_dma(const Params& p, LDS_AS unsigned char* lds, int bid, int nb) {
  const int tid = OPAQUE_TID(p), wid = __builtin_amdgcn_readfirstlane(tid >> 6), lane = tid & 63;
  constexpr int NT = 32 * 1536;
  const int nvalid = bid < NT / CVG ? CVG * ((NT / CVG - bid + nb - 1) / nb) : 0;
#define CVX_TILE_OF(i) ((bid + ((i) / CVG) * nb) * CVG + ((i) % CVG))
  const __amdgpu_buffer_rsrc_t rs1 = __builtin_amdgcn_make_buffer_rsrc((void*)p.w_gate_up, 0, 0x40000000u, 0x00020000);
  const __amdgpu_buffer_rsrc_t rs2 = __builtin_amdgcn_make_buffer_rsrc((void*)p.w_down, 0, 0x20000000u, 0x00020000);
  const __amdgpu_buffer_rsrc_t rs0 = __builtin_amdgcn_make_buffer_rsrc((void*)p.w_down, 0, 0u, 0x00020000);
  const unsigned vo1 = ((unsigned)lane >> 4) * 16384u + ((((unsigned)lane & 15u) ^ (unsigned)wid) << 4);
  const unsigned vo2 = ((unsigned)lane >> 4) * 8192u + ((((unsigned)lane & 15u) ^ (unsigned)wid) << 4);
  const unsigned ldsw = (unsigned)__builtin_amdgcn_readfirstlane((int)(unsigned)(size_t)lds) + (unsigned)wid * 4096u;
  const int n = 8 * wid + (lane >> 3), kc = lane & 7;
  const unsigned roff = (unsigned)kc * 4096u + ((((unsigned)n >> 2) ^ (unsigned)kc) << 4) + (((unsigned)n & 3u) << 2);
#define CVD_ISSUE(i, slot) do { \
    const int _t = __builtin_amdgcn_readfirstlane(CVX_TILE_OF(i)); const bool _ok = (i) < nvalid; \
    const int _e = CVX_E(_t), _r = CVX_R(_t); const bool _gu = _r < 1024; \
    const int _kt = _gu ? (_r >> 6) : ((_r - 1024) >> 5), _nt = _gu ? (_r & 63) : ((_r - 1024) & 31); \
    const unsigned _ldw = _gu ? 16384u : 8192u; \
    const unsigned _so = (unsigned)(_e * 2048 + _kt * 128 + wid * 16) * _ldw + (unsigned)_nt * 256u; \
    const unsigned _vo = _gu ? vo1 : vo2; \
    const unsigned _mb = ldsw + (unsigned)(slot) * 32768u; \
    if (!_ok) { _Pragma("unroll") for (int _q = 0; _q < 4; ++_q) asm volatile("s_mov_b32 m0, %0\n\ts_nop 4\n\tbuffer_load_dwordx4 %1, %2, %3 offen lds" :: "s"(_mb + _q * 1024u), "v"(_vo), "s"(rs0), "s"(0u) : "m0", "memory"); } \
    else if (_gu) { _Pragma("unroll") for (int _q = 0; _q < 4; ++_q) asm volatile("s_mov_b32 m0, %0\n\ts_nop 4\n\tbuffer_load_dwordx4 %1, %2, %3 offen lds" :: "s"(_mb + _q * 1024u), "v"(_vo), "s"(rs1), "s"(_so + _q * 4u * _ldw) : "m0", "memory"); } \
    else { _Pragma("unroll") for (int _q = 0; _q < 4; ++_q) asm volatile("s_mov_b32 m0, %0\n\ts_nop 4\n\tbuffer_load_dwordx4 %1, %2, %3 offen lds" :: "s"(_mb + _q * 1024u), "v"(_vo), "s"(rs2), "s"(_so + _q * 4u * _ldw) : "m0", "memory"); } \
  } while (0)
  CVD_ISSUE(0, 0); CVD_ISSUE(1, 1); CVD_ISSUE(2, 2);
  if (NS == 5) CVD_ISSUE(3, 3);
  int si = 0;
#pragma unroll 1
  for (int i = 0; i < nvalid; ++i) {
    if (NS == 4) asm volatile("s_waitcnt vmcnt(8)" ::: "memory");
    else asm volatile("s_waitcnt vmcnt(12)" ::: "memory");
    __builtin_amdgcn_s_barrier();
    __builtin_amdgcn_sched_barrier(0);
    const int sp = si == 0 ? NS - 1 : si - 1;
    CVD_ISSUE(i + NS - 1, sp);
    const int t = __builtin_amdgcn_readfirstlane(CVX_TILE_OF(i));
    const int e = CVX_E(t), r = CVX_R(t); const bool gu = r < 1024;
    const int kt = gu ? (r >> 6) : ((r - 1024) >> 5), ntile = gu ? (r & 63) : ((r - 1024) & 31);
    unsigned char* Wq = gu ? p.wq1 + (size_t)e * 4096 * 2048 : p.wq2 + (size_t)e * 2048 * 2048;
    if (!STREAM_ONLY) {
    const LDS_AS float* src = (const LDS_AS float*)(lds + (unsigned)si * 32768u + roff);
    float v[16];
#pragma unroll
    for (int j = 0; j < 16; ++j) v[j] = src[j * 64] * 512.f;
    uint4 o;
    o.x = (unsigned)pack4_fp8(v[0], v[1], v[2], v[3]); o.y = (unsigned)pack4_fp8(v[4], v[5], v[6], v[7]);
    o.z = (unsigned)pack4_fp8(v[8], v[9], v[10], v[11]); o.w = (unsigned)pack4_fp8(v[12], v[13], v[14], v[15]);
    *(uint4*)(Wq + (size_t)(ntile * 64 + n) * 2048 + kt * 128 + kc * 16) = o;
    }
    si = si == NS - 1 ? 0 : si + 1;
    __builtin_amdgcn_sched_barrier(0);
  }
#undef CVD_ISSUE
  asm volatile("s_waitcnt vmcnt(0)" ::: "memory");
  __syncthreads();
}

DI void convert_experts_wave(const Params& p, LDS_AS unsigned char* lds, int bid, int nb) {
  const int tid = OPAQUE_TID(p), wid = __builtin_amdgcn_readfirstlane(tid >> 6), lane = tid & 63;
  constexpr int NT = 32 * 1536;
  const int nvalid = bid < NT / CVG ? CVG * ((NT / CVG - bid + nb - 1) / nb) : 0;
  const __amdgpu_buffer_rsrc_t rs1 = __builtin_amdgcn_make_buffer_rsrc((void*)p.w_gate_up, 0, 0x40000000u, 0x00020000);
  const __amdgpu_buffer_rsrc_t rs2 = __builtin_amdgcn_make_buffer_rsrc((void*)p.w_down, 0, 0x20000000u, 0x00020000);
  const __amdgpu_buffer_rsrc_t rs0 = __builtin_amdgcn_make_buffer_rsrc((void*)p.w_down, 0, 0u, 0x00020000);
  const unsigned vo1 = ((unsigned)lane >> 4) * 16384u + (((unsigned)lane & 15u) << 4);
  const unsigned vo2 = ((unsigned)lane >> 4) * 8192u + (((unsigned)lane & 15u) << 4);
  const unsigned ldsw = (unsigned)__builtin_amdgcn_readfirstlane((int)(unsigned)(size_t)lds) + (unsigned)wid * 16384u;
  LDS_AS unsigned char* ring = lds + (unsigned)wid * 16384u + (unsigned)lane * 4u;
#define CVW_ISSUE(i) do { \
    const int _t = __builtin_amdgcn_readfirstlane(CVX_TILE_OF(i)); const bool _ok = (i) < nvalid; \
    const int _e = CVX_E(_t), _r = CVX_R(_t); const bool _gu = _r < 1024; \
    const int _kt = _gu ? (_r >> 6) : ((_r - 1024) >> 5), _nt = _gu ? (_r & 63) : ((_r - 1024) & 31); \
    const unsigned _ldw = _gu ? 16384u : 8192u; \
    const unsigned _so = (unsigned)(_e * 2048 + _kt * 128 + wid * 16) * _ldw + (unsigned)_nt * 256u; \
    const unsigned _vo = _gu ? vo1 : vo2; \
    const unsigned _mb = ldsw + (unsigned)((i) & 3) * 4096u; \
    if (!_ok) { _Pragma("unroll") for (int _q = 0; _q < 4; ++_q) asm volatile("s_mov_b32 m0, %0\n\ts_nop 4\n\tbuffer_load_dwordx4 %1, %2, %3 offen lds" :: "s"(_mb + _q * 1024u), "v"(_vo), "s"(rs0), "s"(0u) : "m0", "memory"); } \
    else if (_gu) { _Pragma("unroll") for (int _q = 0; _q < 4; ++_q) asm volatile("s_mov_b32 m0, %0\n\ts_nop 4\n\tbuffer_load_dwordx4 %1, %2, %3 offen lds" :: "s"(_mb + _q * 1024u), "v"(_vo), "s"(rs1), "s"(_so + _q * 4u * _ldw) : "m0", "memory"); } \
    else { _Pragma("unroll") for (int _q = 0; _q < 4; ++_q) asm volatile("s_mov_b32 m0, %0\n\ts_nop 4\n\tbuffer_load_dwordx4 %1, %2, %3 offen lds" :: "s"(_mb + _q * 1024u), "v"(_vo), "s"(rs2), "s"(_so + _q * 4u * _ldw) : "m0", "memory"); } \
  } while (0)
  CVW_ISSUE(0); CVW_ISSUE(1); CVW_ISSUE(2);
#pragma unroll 1
  for (int i = 0; i < nvalid; ++i) {
    if (i < 3) asm volatile("s_waitcnt vmcnt(8)" ::: "memory"); else asm volatile("s_waitcnt vmcnt(11)" ::: "memory");
    __builtin_amdgcn_sched_barrier(0);
    CVW_ISSUE(i + 3);
    const int t = __builtin_amdgcn_readfirstlane(CVX_TILE_OF(i));
    const int e = CVX_E(t), r = CVX_R(t); const bool gu = r < 1024;
    const int kt = gu ? (r >> 6) : ((r - 1024) >> 5), ntile = gu ? (r & 63) : ((r - 1024) & 31);
    unsigned char* Wq = gu ? p.wq1 + (size_t)e * 4096 * 2048 : p.wq2 + (size_t)e * 2048 * 2048;
    const LDS_AS float* src = (const LDS_AS float*)(ring + (unsigned)(i & 3) * 4096u);
    float v[16];
#pragma unroll
    for (int j = 0; j < 16; ++j) v[j] = src[j * 64] * 512.f;
    uint4 o;
    o.x = (unsigned)pack4_fp8(v[0], v[1], v[2], v[3]); o.y = (unsigned)pack4_fp8(v[4], v[5], v[6], v[7]);
    o.z = (unsigned)pack4_fp8(v[8], v[9], v[10], v[11]); o.w = (unsigned)pack4_fp8(v[12], v[13], v[14], v[15]);
    *(uint4*)(Wq + (size_t)(ntile * 64 + lane) * 2048 + kt * 128 + wid * 16) = o;
    __builtin_amdgcn_sched_barrier(0);
  }
#undef CVW_ISSUE
  asm volatile("s_waitcnt vmcnt(0)" ::: "memory");
  __syncthreads();
}
DI void convert_experts_reg(const Params& p, LDS_AS unsigned char* lds, int bid, int nb) {
  const int tid = OPAQUE_TID(p), wid = __builtin_amdgcn_readfirstlane(tid >> 6), lane = tid & 63;
  constexpr int NT = 32 * 1536;
  const int nvalid = bid < NT / CVG ? CVG * ((NT / CVG - bid + nb - 1) / nb) : 0;
  const int r = tid >> 4, c = tid & 15;
  const unsigned vo1 = (unsigned)r * 16384u + (unsigned)c * 16u, vo2 = (unsigned)r * 8192u + (unsigned)c * 16u;
  const unsigned woff = (unsigned)r * 256u;
  const int n = 8 * wid + (lane >> 3), kc = lane & 7;
  const unsigned roff = (unsigned)kc * 4096u + ((((unsigned)n >> 2) ^ (unsigned)kc) << 4) + (((unsigned)n & 3u) << 2);
  f32x4 a[8][4];
#define CVR_LOAD(u, i) do { \
    const int _i = (i); const bool _ok = _i < nvalid; const int _t = __builtin_amdgcn_readfirstlane(_ok ? CVX_TILE_OF(_i) : 0); \
    const int _e = CVX_E(_t), _r = CVX_R(_t); const bool _gu = _r < 1024; \
    const int _kt = _gu ? (_r >> 6) : ((_r - 1024) >> 5), _nt = _gu ? (_r & 63) : ((_r - 1024) & 31); \
    const unsigned _ldw = _gu ? 16384u : 8192u; \
    const unsigned _so = (unsigned)(_e * 2048 + _kt * 128) * _ldw + (unsigned)_nt * 256u; \
    const unsigned _vo = _ok ? (_gu ? vo1 : vo2) : 0xFFFFFFF0u;            \
    const __amdgpu_buffer_rsrc_t _rs = __builtin_amdgcn_make_buffer_rsrc((void*)(_gu ? p.w_gate_up : p.w_down), 0, 0x40000000u, 0x00020000); \
    _Pragma("unroll") for (int _q = 0; _q < 4; ++_q) \
      asm volatile("buffer_load_dwordx4 %0, %1, %2, %3 offen" : "=v"(a[u][_q]) : "v"(_vo), "s"(_rs), "s"(_so + (unsigned)_q * 32u * _ldw) : "memory"); \
  } while (0)
#define CVR_TILE(u, i, N) do { \
    const int _ii = (i); \
    LDS_AS unsigned char* buf = lds + (unsigned)((u) & 1) * 32768u; \
    asm volatile("s_waitcnt vmcnt(" #N ")" : "+v"(a[u][0]), "+v"(a[u][1]), "+v"(a[u][2]), "+v"(a[u][3]) :: "memory"); \
    _Pragma("unroll") for (int q = 0; q < 4; ++q) \
      *(LDS_AS f32x4*)(buf + woff + (unsigned)q * 8192u + ((((unsigned)c) ^ (((unsigned)r >> 4) + 2u * q)) << 4)) = a[u][q]; \
    const bool ok = _ii < nvalid; \
    const int t = __builtin_amdgcn_readfirstlane(ok ? CVX_TILE_OF(_ii) : 0); \
    const int e = CVX_E(t), rr = CVX_R(t); const bool gu = rr < 1024; \
    const int kt = gu ? (rr >> 6) : ((rr - 1024) >> 5), ntile = gu ? (rr & 63) : ((rr - 1024) & 31); \
    unsigned char* Wq = gu ? p.wq1 + (size_t)e * 4096 * 2048 : p.wq2 + (size_t)e * 2048 * 2048; \
    unsigned char* dst = ok ? Wq + (size_t)(ntile * 64 + n) * 2048 + kt * 128 + kc * 16 : p.cvdump + (size_t)n * 2048 + kc * 16; \
    asm volatile("s_waitcnt lgkmcnt(0)" ::: "memory"); \
    __builtin_amdgcn_sched_barrier(0); \
    CVR_LOAD(u, _ii + 8); \
    __builtin_amdgcn_s_barrier();                   \
    __builtin_amdgcn_sched_barrier(0); \
    const LDS_AS float* src = (const LDS_AS float*)(buf + roff); \
    float v[16]; \
    _Pragma("unroll") for (int j = 0; j < 16; ++j) v[j] = src[j * 64] * 512.f; \
    u32x4 o; \
    o[0] = (unsigned)pack4_fp8(v[0], v[1], v[2], v[3]); o[1] = (unsigned)pack4_fp8(v[4], v[5], v[6], v[7]); \
    o[2] = (unsigned)pack4_fp8(v[8], v[9], v[10], v[11]); o[3] = (unsigned)pack4_fp8(v[12], v[13], v[14], v[15]); \
    asm volatile("global_store_dwordx4 %0, %1, off\n\ts_nop 1" :: "v"(dst), "v"(o) : "memory"); \
    __builtin_amdgcn_sched_barrier(0); \
  } while (0)
  CVR_LOAD(0, 0); CVR_LOAD(1, 1); CVR_LOAD(2, 2); CVR_LOAD(3, 3); CVR_LOAD(4, 4); CVR_LOAD(5, 5); CVR_LOAD(6, 6); CVR_LOAD(7, 7);
  CVR_TILE(0, 0, 28); CVR_TILE(1, 1, 29); CVR_TILE(2, 2, 30); CVR_TILE(3, 3, 31); CVR_TILE(4, 4, 32); CVR_TILE(5, 5, 33); CVR_TILE(6, 6, 34); CVR_TILE(7, 7, 35);
#pragma unroll 1
  for (int i0 = 8; i0 < nvalid; i0 += 8) {
    CVR_TILE(0, i0, 36); CVR_TILE(1, i0 + 1, 36); CVR_TILE(2, i0 + 2, 36); CVR_TILE(3, i0 + 3, 36);
    CVR_TILE(4, i0 + 4, 36); CVR_TILE(5, i0 + 5, 36); CVR_TILE(6, i0 + 6, 36); CVR_TILE(7, i0 + 7, 36);
  }
  asm volatile("s_waitcnt vmcnt(0)" : "+v"(a[0][0]), "+v"(a[0][1]), "+v"(a[0][2]), "+v"(a[0][3]), "+v"(a[1][0]), "+v"(a[1][1]), "+v"(a[1][2]), "+v"(a[1][3]) :: "memory");
  asm volatile("" : "+v"(a[2][0]), "+v"(a[2][1]), "+v"(a[2][2]), "+v"(a[2][3]), "+v"(a[3][0]), "+v"(a[3][1]), "+v"(a[3][2]), "+v"(a[3][3]) :: "memory");
  asm volatile("" : "+v"(a[4][0]), "+v"(a[4][1]), "+v"(a[4][2]), "+v"(a[4][3]), "+v"(a[5][0]), "+v"(a[5][1]), "+v"(a[5][2]), "+v"(a[5][3]) :: "memory");
  asm volatile("" : "+v"(a[6][0]), "+v"(a[6][1]), "+v"(a[6][2]), "+v"(a[6][3]), "+v"(a[7][0]), "+v"(a[7][1]), "+v"(a[7][2]), "+v"(a[7][3]) :: "memory");
#undef CVR_LOAD
#undef CVR_TILE
  __syncthreads();
}


#if DENSE_DMA
#define DENSE_UNIT(lds, cfg) gemm256dma_unit(lds, cfg)
#else
#define DENSE_UNIT(lds, cfg) gemm256_unit(lds, cfg)
#endif
DI void st_bf16x4(bf16_t* dst, const f32x4& v) { u32x2 pk; pk.x = pack2(v[0], v[1]); pk.y = pack2(v[2], v[3]); *(u32x2*)dst = pk; }
DI int tile_gc(int pn, int bj, int wc, int fq) { return pn * 256 + 128 * bj + 64 * (wc >> 1) + 16 * (wc & 1) + 4 * fq; }

struct CfgInProj {
  const Params& p; int pm, pn;
  static constexpr bool GU = false;
  DI int vrows() const { return 256; }
  DI const void* bt_base() const { return p.wt_in; }
  DI unsigned bt_bytes() const { return 4096u * 4096u; }
  DI unsigned bt_rowoff(int h, int R) const { return (unsigned)(pn * 256 + 128 * h + tcol_p64(R)) * 4096u; }
  DI int nkt() const { return 32; }
  DI const void* a_base() const { return p.h0b; }
  DI unsigned a_bytes() const { return (unsigned)NTOK * 4096u; }
  DI unsigned a_rowoff(int r) const { return (unsigned)(pm * 256 + r) * 4096u; }
  DI const float* b_base() const { return p.w_in; }
  DI unsigned b_bytes() const { return 2048u * (unsigned)INP * 4u; }
  DI int ldb() const { return INP; }
  DI int b_gcol(int h, int lc) const { return pn * 256 + 128 * h + lc; }
  DI void epi(int r, int bj, int wc, int fq, const f32x4& v0, const f32x4& v1) const {
    const int t = pm * 256 + r; const int gc = tile_gc(pn, bj, wc, fq);
    if (gc < 3072) { st_bf16x4(p.qkv + (size_t)t * 3072 + gc, v0); st_bf16x4(p.qkv + (size_t)t * 3072 + gc + 32, v1); }
    else if (gc < 3584) { st_bf16x4(p.qlat + (size_t)t * 512 + gc - 3072, v0); st_bf16x4(p.qlat + (size_t)t * 512 + gc - 3072 + 32, v1); }
    else if (gc < 3840) { st_bf16x4(p.kvlat + (size_t)t * 256 + gc - 3584, v0); st_bf16x4(p.kvlat + (size_t)t * 256 + gc - 3584 + 32, v1); }
    else if (gc < 3872) {
      const int i0 = gc - 3840; const int ps = p.pos[t];
      f32x4 a, b;
#pragma unroll
      for (int e = 0; e < 4; ++e) { float sn, cs; rope_sc(ps, i0 + e, sn, cs); a[e] = v0[e] * cs - v1[e] * sn; b[e] = v1[e] * cs + v0[e] * sn; }
      st_bf16x4(p.krope + (size_t)t * 64 + i0, a); st_bf16x4(p.krope + (size_t)t * 64 + i0 + 32, b);
    }
  }
};
DI void phase_in_proj(const Params& p, LDS_AS unsigned char* lds, char* smem, int bid, int nb) {
  for (int u = bid; u < 32 * 16; u += nb) {
    const int uu = __builtin_amdgcn_readfirstlane(u);
    CfgInProj cfg{p, uu >> 4, uu & 15};
    DENSE_UNIT(lds, cfg);
  }
}

DI void phase_norm_latents(const Params& p, int bid, int nb) {
  const int tid_ = OPAQUE_TID(p), lane = tid_ & 63, wv = tid_ >> 6;
  for (int t = bid * NWAVES + wv; t < NTOK; t += nb * NWAVES) {
    const uint4 a = *(const uint4*)(p.qlat + (size_t)t * 512 + lane * 8);
    float v[8] = {bflo(a.x), bfhi(a.x), bflo(a.y), bfhi(a.y), bflo(a.z), bfhi(a.z), bflo(a.w), bfhi(a.w)};
    float s = 0.f;
#pragma unroll
    for (int i = 0; i < 8; ++i) s += v[i] * v[i];
    s = wave_sum(s);
    const float rs = rsqrtf(s * (1.f / 512.f) + RMS_EPS);
    const float4 g0 = *(const float4*)(p.q_a_norm + lane * 8), g1 = *(const float4*)(p.q_a_norm + lane * 8 + 4);
    uint4 o;
    o.x = pack2(v[0] * rs * g0.x, v[1] * rs * g0.y); o.y = pack2(v[2] * rs * g0.z, v[3] * rs * g0.w);
    o.z = pack2(v[4] * rs * g1.x, v[5] * rs * g1.y); o.w = pack2(v[6] * rs * g1.z, v[7] * rs * g1.w);
    *(uint4*)(p.qn + (size_t)t * 512 + lane * 8) = o;
    const uint2 b = *(const uint2*)(p.kvlat + (size_t)t * 256 + lane * 4);
    float w[4] = {bflo(b.x), bfhi(b.x), bflo(b.y), bfhi(b.y)};
    float s2 = w[0] * w[0] + w[1] * w[1] + w[2] * w[2] + w[3] * w[3];
    s2 = wave_sum(s2);
    const float rs2 = rsqrtf(s2 * (1.f / 256.f) + RMS_EPS);
    const float4 g2 = *(const float4*)(p.kv_a_norm + lane * 4);
    uint2 o2;
    o2.x = pack2(w[0] * rs2 * g2.x, w[1] * rs2 * g2.y); o2.y = pack2(w[2] * rs2 * g2.z, w[3] * rs2 * g2.w);
    *(uint2*)(p.kvn + (size_t)t * 256 + lane * 4) = o2;
  }
}

struct CfgMlaQ {
  const Params& p; int pm, pn;
  static constexpr bool GU = false;
  DI int vrows() const { return 256; }
  DI const void* bt_base() const { return p.wt_q; }
  DI unsigned bt_bytes() const { return 1536u * 1024u; }
  DI unsigned bt_rowoff(int h, int R) const { return (unsigned)(pn * 256 + 128 * h + tcol_p64(R)) * 1024u; }
  DI int nkt() const { return 8; }
  DI const void* a_base() const { return p.qn; }
  DI unsigned a_bytes() const { return (unsigned)NTOK * 1024u; }
  DI unsigned a_rowoff(int r) const { return (unsigned)(pm * 256 + r) * 1024u; }
  DI const float* b_base() const { return p.w_q_b; }
  DI unsigned b_bytes() const { return 512u * 1536u * 4u; }
  DI int ldb() const { return 1536; }
  DI int b_gcol(int h, int lc) const { return pn * 256 + 128 * h + lc; }
  DI void epi(int r, int bj, int wc, int fq, const f32x4& v0, const f32x4& v1) const {
    const int t = pm * 256 + r; const int gc = tile_gc(pn, bj, wc, fq);
    f32x4 a = v0, b = v1;
    if (((gc >> 6) % 3) == 2) {
      const int i0 = gc & 31; const int ps = p.pos[t];
#pragma unroll
      for (int e = 0; e < 4; ++e) { float sn, cs; rope_sc(ps, i0 + e, sn, cs); a[e] = v0[e] * cs - v1[e] * sn; b[e] = v1[e] * cs + v0[e] * sn; }
    }
    st_bf16x4(p.mq + (size_t)t * 1536 + gc, a); st_bf16x4(p.mq + (size_t)t * 1536 + gc + 32, b);
  }
};
struct CfgMlaKV {
  const Params& p; int pm, pn;
  static constexpr bool GU = false;
  DI int vrows() const { return 256; }
  DI const void* bt_base() const { return p.wt_kv; }
  DI unsigned bt_bytes() const { return 2048u * 512u; }
  DI unsigned bt_rowoff(int h, int R) const { return (unsigned)(pn * 256 + 128 * h + tcol_p64(R)) * 512u; }
  DI int nkt() const { return 4; }
  DI const void* a_base() const { return p.kvn; }
  DI unsigned a_bytes() const { return (unsigned)NTOK * 512u; }
  DI unsigned a_rowoff(int r) const { return (unsigned)(pm * 256 + r) * 512u; }
  DI const float* b_base() const { return p.w_kv_b; }
  DI unsigned b_bytes() const { return 256u * 2048u * 4u; }
  DI int ldb() const { return 2048; }
  DI int b_gcol(int h, int lc) const { return pn * 256 + 128 * h + lc; }
  DI void epi(int r, int bj, int wc, int fq, const f32x4& v0, const f32x4& v1) const {
    const int t = pm * 256 + r; const int gc = tile_gc(pn, bj, wc, fq);
    st_bf16x4(p.mkv + (size_t)t * 2048 + gc, v0); st_bf16x4(p.mkv + (size_t)t * 2048 + gc + 32, v1);
  }
};
DI void phase_mla_proj(const Params& p, LDS_AS unsigned char* lds, char* smem, int bid, int nb) {
  for (int u = bid; u < 32 * 6; u += nb) {
    const int uu = __builtin_amdgcn_readfirstlane(u);
    CfgMlaQ cfg{p, uu / 6, uu % 6}; DENSE_UNIT(lds, cfg);
  }
  for (int u = nb - 1 - bid; u < 32 * 8; u += nb) {
    const int uu = __builtin_amdgcn_readfirstlane(u);
    CfgMlaKV cfg{p, uu >> 3, uu & 7}; DENSE_UNIT(lds, cfg);
  }
}

struct CfgWo {
  const Params& p; int pm, pn;
  static constexpr bool GU = false;
  DI int vrows() const { return 256; }
  DI const void* bt_base() const { return p.wt_o; }
  DI unsigned bt_bytes() const { return 2048u * 4096u; }
  DI unsigned bt_rowoff(int h, int R) const { return (unsigned)(pn * 256 + 128 * h + tcol_p64(R)) * 4096u; }
  DI int nkt() const { return 32; }
  DI const void* a_base() const { return p.on; }
  DI unsigned a_bytes() const { return (unsigned)NTOK * 4096u; }
  DI unsigned a_rowoff(int r) const { return (unsigned)(pm * 256 + r) * 4096u; }
  DI const float* b_base() const { return p.w_o; }
  DI unsigned b_bytes() const { return 2048u * 2048u * 4u; }
  DI int ldb() const { return 2048; }
  DI int b_gcol(int h, int lc) const { return pn * 256 + 128 * h + lc; }
  DI void epi(int r, int bj, int wc, int fq, const f32x4& v0, const f32x4& v1) const {
    const size_t o = (size_t)(pm * 256 + r) * 2048 + tile_gc(pn, bj, wc, fq);
    const u32x2 r0 = *(const u32x2*)(p.h0b + o), r1 = *(const u32x2*)(p.h0b + o + 32);
    const f32x4 h0 = {bflo(r0.x), bfhi(r0.x), bflo(r0.y), bfhi(r0.y)}, h1 = {bflo(r1.x), bfhi(r1.x), bflo(r1.y), bfhi(r1.y)};
    st_bf16x4(p.z1b + o, h0 * DN_ALPHA + v0);
    st_bf16x4(p.z1b + o + 32, h1 * DN_ALPHA + v1);
  }
};
template <int MODE = 0>
DI void phase_wo(const Params& p, LDS_AS unsigned char* lds, char* smem, int bid, int nb) {
  for (int u = bid; u < 32 * 8; u += nb) {
    const int uu = __builtin_amdgcn_readfirstlane(u);
    CfgWo cfg{p, uu >> 3, uu & 7};
    if (MODE == 0) DENSE_UNIT(lds, cfg); else gemm256_unit<CfgWo, MODE>(lds, cfg);
  }
}

struct MoeSched { int base[33]; int mt[32]; int cnt[32]; };
DI void moe_sched_build(const Params& p, MoeSched* s, int ntn, bool rev) {
  if (threadIdx.x == 0) {
    int acc = 0;
    for (int e = 0; e < 32; ++e) { const int c = p.cnt[(rev ? 31 - e : e) * 32]; const int m = (c + 255) >> 8; s->cnt[e] = c; s->mt[e] = m; s->base[e] = acc; acc += m * ntn; }
    s->base[32] = acc;
  }
  __syncthreads();
}
struct CfgMoe1 {
  const Params& p; int e, m0, tn, cnt;
  static constexpr bool GU = true;
  DI int vrows() const { return cnt - m0; }
  DI int nkt() const { return 32; }
  DI const void* a_base() const { return p.h1b; }
  DI unsigned a_bytes() const { return (unsigned)NTOK * 4096u; }
  DI unsigned a_rowoff(int r) const {
    int rr = m0 + r; rr = rr < cnt ? rr : cnt - 1;
    return (unsigned)(p.rowlist[e * 8192 + rr] >> 2) * 4096u;
  }
  DI const float* b_base() const { return p.w_gate_up + (size_t)e * 2048 * 4096; }
  DI unsigned b_bytes() const { return 2048u * 4096u * 4u; }
  DI int ldb() const { return 4096; }
  DI int b_gcol(int h, int lc) const { return (lc < 64 ? 0 : 2048 - 64) + tn * 128 + 64 * h + lc; }
  DI void epi(int r, int bj, int wc, int fq, const f32x4& v0, const f32x4& v1) const {
    const int rr = m0 + r;
    if (rr >= cnt) return;
    const int a = p.rowlist[e * 8192 + rr];
    const int j0 = tn * 128 + 64 * bj + 16 * wc + 4 * fq;
    const f32x4 bg = *(const f32x4*)(p.b_gate_up + e * 4096 + j0), bu = *(const f32x4*)(p.b_gate_up + e * 4096 + 2048 + j0);
    f32x4 o;
#pragma unroll
    for (int i = 0; i < 4; ++i) {
      const float g = fminf(v0[i] + bg[i], 7.f);
      const float up = fminf(fmaxf(v1[i] + bu[i], -7.f), 7.f);
      const float sg = 1.f / (1.f + __expf(-1.702f * g));
      o[i] = (up + 1.f) * (g * sg);
    }
    st_bf16x4(p.act + (size_t)a * 2048 + j0, o);
  }
};
struct CfgMoe2 {
  const Params& p; int e, m0, tn, cnt;
  static constexpr bool GU = false;
  DI int vrows() const { return cnt - m0; }
  DI int nkt() const { return 32; }
  DI const void* a_base() const { return p.act; }
  DI unsigned a_bytes() const { return (unsigned)NTOK * 4u * 4096u; }
  DI unsigned a_rowoff(int r) const {
    int rr = m0 + r; rr = rr < cnt ? rr : cnt - 1;
    return (unsigned)p.rowlist[e * 8192 + rr] * 4096u;
  }
  DI const float* b_base() const { return p.w_down + (size_t)e * 2048 * 2048; }
  DI unsigned b_bytes() const { return 2048u * 2048u * 4u; }
  DI int ldb() const { return 2048; }
  DI int b_gcol(int h, int lc) const { return tn * 256 + 128 * h + lc; }
  DI void epi(int r, int bj, int wc, int fq, const f32x4& v0, const f32x4& v1) const {
    const int rr = m0 + r;
    if (rr >= cnt) return;
    const int a = p.rowlist[e * 8192 + rr];
    const int gc = tile_gc(tn, bj, wc, fq);
    const float gt = p.gate[a];
    const f32x4 b0 = *(const f32x4*)(p.b_down + e * 2048 + gc), b1 = *(const f32x4*)(p.b_down + e * 2048 + gc + 32);
    st_bf16x4(p.yb + (size_t)a * 2048 + gc, (v0 + b0) * gt);
    st_bf16x4(p.yb + (size_t)a * 2048 + gc + 32, (v1 + b1) * gt);
  }
};
template <int MOE_HOT>
struct CfgMoe1F8T {
  const Params& p; int e, m0, tn, cnt;
  static constexpr bool GU = true;
#if 0
#elif 1
  DI const void* bt_base() const { return p.wq1 + (size_t)(MOE_HOT == 1 ? 0 : e) * 4096 * 2048; }
  DI unsigned bt_rowoff(int h, int R) const { return (unsigned)((((R >> 4) & 1) ? 2048 : 0) + (MOE_HOT == 1 ? 0 : tn) * 128 + 64 * h + 16 * (R >> 5) + (R & 15)) * 2048u; }
#elif 0
  DI const void* bt_base() const { return p.wq1 + (size_t)(e & 0) * 4096 * 2048; }
  DI unsigned bt_rowoff(int h, int R) const { return (unsigned)((((R >> 4) & 1) ? 2048 : 0) + (tn & 0) * 128 + 64 * h + 16 * (R >> 5) + (R & 15)) * 2048u; }
#else
  DI const void* bt_base() const { return p.wq1 + (size_t)e * 4096 * 2048; }
  DI unsigned bt_rowoff(int h, int R) const { return (unsigned)((((R >> 4) & 1) ? 2048 : 0) + tn * 128 + 64 * h + 16 * (R >> 5) + (R & 15)) * 2048u; }
#endif
  DI unsigned bt_bytes() const { return 4096u * 2048u; }
  DI int nkt() const { return 16; }
  DI float bmul() const { return 512.f; }
  DI int scale_w() const { return 0x76767676; }
  DI int scale_x() const { return 0x7B7B7B7B; }
  DI const void* a_base() const { return p.h1q; }
  DI unsigned a_bytes() const { return (unsigned)NTOK * 2048u; }
  DI unsigned a_rowoff(int r) const {
    int rr = m0 + r; rr = rr < cnt ? rr : cnt - 1;
    if (MOE_HOT == 2) return (unsigned)r * 2048u + 0u * (unsigned)p.rowlist[e * 8192 + rr];
    return (unsigned)(p.rowlist[e * 8192 + rr] >> 2) * 2048u;
  }
  DI const float* b_base() const { return p.w_gate_up + (size_t)e * 2048 * 4096; }
  DI unsigned b_bytes() const { return 2048u * 4096u * 4u; }
  DI int ldb() const { return 4096; }
  DI int b_gcol(int h, int lc) const { return (lc < 64 ? 0 : 2048 - 64) + tn * 128 + 64 * h + lc; }
  typedef int RowTok;
  struct ColCtx { int j0; f32x4 bg, bu; };
  DI RowTok row_tok(int r) const { const int rr = m0 + r; const int a = p.rowlist[e * 8192 + (rr < cnt ? rr : cnt - 1)]; return rr < cnt ? a : -1; }
  DI ColCtx col_ctx(int bj, int wc, int fq) const {
    ColCtx c; c.j0 = tn * 128 + 64 * bj + 16 * wc + 4 * fq;
    c.bg = *(const f32x4*)(p.b_gate_up + e * 4096 + c.j0); c.bu = *(const f32x4*)(p.b_gate_up + e * 4096 + 2048 + c.j0);
    return c;
  }
  DI void epi_t(RowTok a, const ColCtx& c, const f32x4& v0, const f32x4& v1) const {
    if (a < 0) return;
    float o[4];
#pragma unroll
    for (int i = 0; i < 4; ++i) {
      const float g = fminf(v0[i] + c.bg[i], 7.f);
      const float up = __builtin_amdgcn_fmed3f(v1[i] + c.bu[i], -7.f, 7.f);
      const float sg = __builtin_amdgcn_rcpf(1.f + __builtin_amdgcn_exp2f(g * (-1.702f * 1.44269504088896f)));
      o[i] = fmaf(up, 4.f, 4.f) * (g * sg);
    }
    *(int*)(p.actq + (size_t)a * 2048 + c.j0) = pack4_fp8(o[0], o[1], o[2], o[3]);
  }
  DI void epi(int r, int bj, int wc, int fq, const f32x4& v0, const f32x4& v1) const {
    const int rr = m0 + r;
    if (rr >= cnt) return;
    const int a = p.rowlist[e * 8192 + rr];
    const int j0 = tn * 128 + 64 * bj + 16 * wc + 4 * fq;
    const f32x4 bg = *(const f32x4*)(p.b_gate_up + e * 4096 + j0), bu = *(const f32x4*)(p.b_gate_up + e * 4096 + 2048 + j0);
    float o[4];
#pragma unroll
    for (int i = 0; i < 4; ++i) {
      const float g = fminf(v0[i] + bg[i], 7.f);
      const float up = fminf(fmaxf(v1[i] + bu[i], -7.f), 7.f);
      const float sg = 1.f / (1.f + __expf(-1.702f * g));
      o[i] = fminf(fmaxf((up + 1.f) * (g * sg) * 4.f, -440.f), 440.f);
    }
    *(int*)(p.actq + (size_t)a * 2048 + j0) = pack4_fp8(o[0], o[1], o[2], o[3]);
  }
};
typedef CfgMoe1F8T<0> CfgMoe1F8;
struct CfgMoe2F8 {
  const Params& p; int e, m0, tn, cnt;
  static constexpr bool GU = false;
  DI const void* bt_base() const { return p.wq2 + (size_t)e * 2048 * 2048; }
  DI unsigned bt_bytes() const { return 2048u * 2048u; }
  DI unsigned bt_rowoff(int h, int R) const { return (unsigned)(tn * 256 + 128 * h + tcol_p64(R)) * 2048u; }
  DI int nkt() const { return 16; }
  DI float bmul() const { return 512.f; }
  DI int scale_w() const { return 0x76767676; }
  DI int scale_x() const { return 0x7D7D7D7D; }
  DI const void* a_base() const { return p.actq; }
  DI unsigned a_bytes() const { return (unsigned)NTOK * 4u * 2048u; }
  DI unsigned a_rowoff(int r) const {
    int rr = m0 + r; rr = rr < cnt ? rr : cnt - 1;
    return (unsigned)p.rowlist[e * 8192 + rr] * 2048u;
  }
  DI const float* b_base() const { return p.w_down + (size_t)e * 2048 * 2048; }
  DI unsigned b_bytes() const { return 2048u * 2048u * 4u; }
  DI int ldb() const { return 2048; }
  DI int b_gcol(int h, int lc) const { return tn * 256 + 128 * h + lc; }
  struct RowTok { int a; float gt; };
  struct ColCtx { int gc; f32x4 b0, b1; };
  DI RowTok row_tok(int r) const {
    const int rr = m0 + r; const int a = p.rowlist[e * 8192 + (rr < cnt ? rr : cnt - 1)];
    RowTok t; t.a = rr < cnt ? a : -1; t.gt = p.gate[a]; return t;
  }
  DI ColCtx col_ctx(int bj, int wc, int fq) const {
    ColCtx c; c.gc = tile_gc(tn, bj, wc, fq);
    c.b0 = *(const f32x4*)(p.b_down + e * 2048 + c.gc); c.b1 = *(const f32x4*)(p.b_down + e * 2048 + c.gc + 32);
    return c;
  }
  DI void epi_t(const RowTok& t, const ColCtx& c, const f32x4& v0, const f32x4& v1) const {
    if (t.a < 0) return;
    st_bf16x4(p.yb + (size_t)t.a * 2048 + c.gc, (v0 + c.b0) * t.gt);
    st_bf16x4(p.yb + (size_t)t.a * 2048 + c.gc + 32, (v1 + c.b1) * t.gt);
  }
  DI void epi(int r, int bj, int wc, int fq, const f32x4& v0, const f32x4& v1) const {
    const int rr = m0 + r;
    if (rr >= cnt) return;
    const int a = p.rowlist[e * 8192 + rr];
    const int gc = tile_gc(tn, bj, wc, fq);
    const float gt = p.gate[a];
    const f32x4 b0 = *(const f32x4*)(p.b_down + e * 2048 + gc), b1 = *(const f32x4*)(p.b_down + e * 2048 + gc + 32);
    st_bf16x4(p.yb + (size_t)a * 2048 + gc, (v0 + b0) * gt);
    st_bf16x4(p.yb + (size_t)a * 2048 + gc + 32, (v1 + b1) * gt);
  }
};
template <int WHICH, int PMODE = 0>
DI void phase_moe(const Params& p, LDS_AS unsigned char* lds, int bid, int nb) {
  constexpr int NTN = WHICH == 1 ? 16 : 8;
  MoeSched* sch = (MoeSched*)((char*)lds + G256F8_LDS);
  moe_sched_build(p, sch, NTN, WHICH == 1);
  const int total = sch->base[32];
  const int slot = (bid & 7) * (nb >> 3) + (bid >> 3);
  int ehint = 0;
  auto decode = [&](int u, int& ee, int& m0, int& tn, int& cn) {
    int e = ehint;
    while (u >= sch->base[e + 1]) ++e;
    ehint = e;
    const int loc = u - sch->base[e];
    const int mt = sch->mt[e];
    ee = __builtin_amdgcn_readfirstlane(WHICH == 1 ? 31 - e : e); tn = __builtin_amdgcn_readfirstlane(loc / mt); m0 = __builtin_amdgcn_readfirstlane(loc % mt) * 256;
    cn = __builtin_amdgcn_readfirstlane(sch->cnt[e]);
  };
#if MOE_FP8 == 2
  typedef typename std::conditional<WHICH == 1, CfgMoe1F8T<(PMODE == 3 ? 1 : (PMODE == 4 ? 2 : 0))>, CfgMoe2F8>::type CfgT;
  int u = slot;
  if (u < total) {
    int ee, m0, tn, cn; decode(u, ee, m0, tn, cn);
    CfgT cur{p, ee, m0, tn, cn};
    bool pre = false;
#pragma unroll 1
    for (;;) {
      const int un = u + nb;
      const bool has_next = un < total;
      int e2 = 0, m2 = 0, t2 = 0, c2 = 1;
      if (has_next) decode(un, e2, m2, t2, c2);
      const CfgT nxtc{p, e2, m2, t2, c2};
      const bool tophalf = cur.cnt - cur.m0 <= 128;
      if (pre) { if (tophalf) gemm256f8dma_unit<CfgT, true, true, PMODE>(lds, cur, has_next, nxtc); else gemm256f8dma_unit<CfgT, false, true, PMODE>(lds, cur, has_next, nxtc); }
      else { if (tophalf) gemm256f8dma_unit<CfgT, true, false, PMODE>(lds, cur, has_next, nxtc); else gemm256f8dma_unit<CfgT, false, false, PMODE>(lds, cur, has_next, nxtc); }
      if (!has_next) break;
      cur.e = e2; cur.m0 = m2; cur.tn = t2; cur.cnt = c2; u = un; pre = true;
    }
  }
#else
  for (int u = slot; u < total; u += nb) {
    int ee, m0, tn, cn; decode(u, ee, m0, tn, cn);
    const bool tophalf = cn - m0 <= 128;
#if MOE_FP8
    if (WHICH == 1) { CfgMoe1F8 cfg{p, ee, m0, tn, cn}; if (tophalf) gemm256f8_unit<CfgMoe1F8, true>(lds, cfg); else gemm256f8_unit<CfgMoe1F8, false>(lds, cfg); }
    else { CfgMoe2F8 cfg{p, ee, m0, tn, cn}; if (tophalf) gemm256f8_unit<CfgMoe2F8, true>(lds, cfg); else gemm256f8_unit<CfgMoe2F8, false>(lds, cfg); }
#else
    if (WHICH == 1) { CfgMoe1 cfg{p, ee, m0, tn, cn}; if (tophalf) gemm256_unit<CfgMoe1, 0, true>(lds, cfg); else gemm256_unit<CfgMoe1, 0, false>(lds, cfg); }
    else { CfgMoe2 cfg{p, ee, m0, tn, cn}; if (tophalf) gemm256_unit<CfgMoe2, 0, true>(lds, cfg); else gemm256_unit<CfgMoe2, 0, false>(lds, cfg); }
#endif
  }
#endif
}

DI bf16x8 pack_frag(const f32x16& x, int s) {
  uint4 r;
  r.x = pack2(x[8 * s + 0], x[8 * s + 1]); r.y = pack2(x[8 * s + 2], x[8 * s + 3]);
  r.z = pack2(x[8 * s + 4], x[8 * s + 5]); r.w = pack2(x[8 * s + 6], x[8 * s + 7]);
  return __builtin_bit_cast(bf16x8, r);
}
DI void xhalf(float x, float& lo, float& hi) {
  auto r = __builtin_amdgcn_permlane32_swap(__float_as_uint(x), __float_as_uint(x), false, false);
  lo = __uint_as_float(r[0]); hi = __uint_as_float(r[1]);
}
constexpr int AT_SBK = 0, AT_SBV = 8192, AT_MLK = 16384, AT_MLR = 24576, AT_MLV = 28672, AT_BUF = 36864;
constexpr int AT_LDS = 3 * AT_BUF;

DI void pv_accum2(LDS_AS unsigned char* vimg, int lane, const bf16x8& wf0, const bf16x8& wf1, f32x16 (&o)[4]) {
  const unsigned hh = (unsigned)lane >> 5, q = ((unsigned)lane & 15u) >> 2, pp = (unsigned)lane & 3u, blk = ((unsigned)lane >> 4) & 1u;
#pragma unroll
  for (int d = 0; d < 4; ++d) {
    bf16x8 v[2];
#pragma unroll
    for (int s = 0; s < 2; ++s) {
      const unsigned a0 = offb(16u * s + 4u * hh + q, 4u * d + 2u * blk + (pp >> 1)) + 8u * (pp & 1u);
      const unsigned a1 = offb(16u * s + 8u + 4u * hh + q, 4u * d + 2u * blk + (pp >> 1)) + 8u * (pp & 1u);
      const s16x4 lo = __builtin_amdgcn_ds_read_tr16_b64_v4i16((LDS_AS s16x4*)(vimg + a0));
      const s16x4 hi = __builtin_amdgcn_ds_read_tr16_b64_v4i16((LDS_AS s16x4*)(vimg + a1));
      v[s] = __builtin_shufflevector(lo, hi, 0, 1, 2, 3, 4, 5, 6, 7);
    }
    o[d] = MFMA32(v[0], wf0, o[d]);
    o[d] = MFMA32(v[1], wf1, o[d]);
  }
}

template <bool DIAG>
DI void sb_weights(const f32x16& z, f32x16& w, float& csum, int l31, int hh) {
  const float c2 = 0.12751743074602268f;
  float sp[16], ls[16];
#pragma unroll
  for (int i = 0; i < 16; ++i) {
    const float t = z[i] * c2;
    const float u = __builtin_amdgcn_exp2f(-fabsf(t));
    const float spv = fmaxf(t, 0.f) + __builtin_amdgcn_logf(1.f + u);
    ls[i] = t - spv;
    sp[i] = (!DIAG || (crow(i, hh) < l31)) ? spv : 0.f;
  }
  float R[4], Rp[4];
#pragma unroll
  for (int g = 0; g < 4; ++g) { R[g] = (sp[4 * g] + sp[4 * g + 1]) + (sp[4 * g + 2] + sp[4 * g + 3]); float lo, hi; xhalf(R[g], lo, hi); Rp[g] = hh ? lo : hi; }
  float later = 0.f;
#pragma unroll
  for (int g = 3; g >= 0; --g) {
    const float base = csum + later + (hh == 0 ? Rp[g] : 0.f);
    float sfx = 0.f;
#pragma unroll
    for (int e = 3; e >= 0; --e) {
      const int i = 4 * g + e;
      const float wv = __builtin_amdgcn_exp2f(ls[i] - (base + sfx));
      w[i] = (!DIAG || (crow(i, hh) < l31)) ? wv : 0.f;
      sfx += sp[i];
    }
    later += R[g] + Rp[g];
  }
  csum += later;
}

struct AttnCtx {
  __amdgpu_buffer_rsrc_t rsQKV, rsMKV, rsKR;
  unsigned ldsb; int wv, lane;
  unsigned voff_sbk, voff_sbv, voff_mlk, voff_mlv, voff_r;
  int b, hd;
};
#define AT_DMA(rs, voff, soff, m0v) asm volatile("s_mov_b32 m0, %0\n\ts_nop 4\n\tbuffer_load_dwordx4 %1, %2, %3 offen lds" :: "s"(m0v), "v"(voff), "s"(rs), "s"(soff) : "m0", "memory")
DI void attn_issue(const AttnCtx& c, int kb, int bufsel) {
  const unsigned tok = (unsigned)(c.b * SEQ + kb * 32);
  const unsigned bb = c.ldsb + (unsigned)bufsel * AT_BUF + (unsigned)c.wv * 1024u;
  AT_DMA(c.rsQKV, c.voff_sbk, tok * 6144u, bb + AT_SBK); AT_DMA(c.rsQKV, c.voff_sbv, tok * 6144u, bb + AT_SBV);
  AT_DMA(c.rsMKV, c.voff_mlk, tok * 4096u, bb + AT_MLK); AT_DMA(c.rsMKV, c.voff_mlv, tok * 4096u, bb + AT_MLV);
  if (c.wv < 4) AT_DMA(c.rsKR, c.voff_r, tok * 128u, bb + AT_MLR);
}
DI void attn_step_end() { asm volatile("s_waitcnt vmcnt(0)" ::: "memory"); __builtin_amdgcn_s_barrier(); }
DI void attn_step_end_sb() { asm volatile("s_waitcnt vmcnt(5)" ::: "memory"); __builtin_amdgcn_s_barrier(); }
DI void attn_step_end_ml() { asm volatile("s_waitcnt vmcnt(4)" ::: "memory"); __builtin_amdgcn_s_barrier(); }

DI void attn_sb_item(const Params& p, LDS_AS unsigned char* lds, const AttnCtx& c, int qb, int nsteps) {
  const int lane = c.lane, l31 = lane & 31, hh = lane >> 5;
  const size_t tokbase = (size_t)c.b * SEQ;
  bf16x8 qf[8];
  {
    const bf16_t* qp = p.qkv + (tokbase + qb * 32 + l31) * 3072 + c.hd * 128 + 8 * hh;
#pragma unroll
    for (int s = 0; s < 8; ++s) qf[s] = *(const bf16x8*)(qp + 16 * s);
  }
  f32x16 o[4];
#pragma unroll
  for (int d = 0; d < 4; ++d)
#pragma unroll
    for (int i = 0; i < 16; ++i) o[d][i] = 0.f;
  float csum = 0.f;
  attn_issue(c, nsteps - 1, 0);
  attn_issue(c, nsteps - 2, 1);
  attn_step_end_sb();
  int s = 0, rb = 0;
  const int nskip = nsteps - 1 - qb;
#pragma unroll 1
  for (; s < nskip; ++s) { if (s + 2 < nsteps) { attn_issue(c, nsteps - 3 - s, rb == 0 ? 2 : rb - 1); attn_step_end_sb(); } else attn_step_end(); rb = rb == 2 ? 0 : rb + 1; }
#pragma unroll 1
  for (; s < nsteps; ++s) {
    const int kb = nsteps - 1 - s;
    if (s + 2 < nsteps) { attn_issue(c, kb - 2, rb == 0 ? 2 : rb - 1); }
    LDS_AS unsigned char* Bf = lds + rb * AT_BUF;
    bf16x8 kf[8];
#pragma unroll
    for (int ks = 0; ks < 8; ++ks) kf[ks] = *(const LDS_AS bf16x8*)(Bf + AT_SBK + offb((unsigned)l31, (unsigned)(2 * ks + hh)));
    __builtin_amdgcn_sched_barrier(0);
    f32x16 z;
#pragma unroll
    for (int i = 0; i < 16; ++i) z[i] = 0.f;
#pragma unroll
    for (int ks = 0; ks < 8; ++ks) z = MFMA32(kf[ks], qf[ks], z);
    f32x16 w;
    if (kb == qb) sb_weights<true>(z, w, csum, l31, hh); else sb_weights<false>(z, w, csum, l31, hh);
    const bf16x8 wf0 = pack_frag(w, 0), wf1 = pack_frag(w, 1);
    pv_accum2(Bf + AT_SBV, lane, wf0, wf1, o);
    if (s + 2 < nsteps) attn_step_end_sb(); else attn_step_end();
    rb = rb == 2 ? 0 : rb + 1;
  }
  bf16_t* op = p.oA + (tokbase + qb * 32 + l31) * 1024 + c.hd * 128;
#pragma unroll
  for (int d = 0; d < 4; ++d)
#pragma unroll
    for (int g = 0; g < 4; ++g) {
      uint2 pk; pk.x = pack2(o[d][4 * g], o[d][4 * g + 1]); pk.y = pack2(o[d][4 * g + 2], o[d][4 * g + 3]);
      *(uint2*)(op + d * 32 + 8 * g + 4 * hh) = pk;
    }
}

DI void attn_mla_item(const Params& p, LDS_AS unsigned char* lds, const AttnCtx& c, int qb, int nsteps) {
  const int lane = c.lane, l31 = lane & 31, hh = lane >> 5;
  const size_t tokbase = (size_t)c.b * SEQ;
  bf16x8 qf[12];
  {
    const bf16_t* qp = p.mq + (tokbase + qb * 32 + l31) * 1536 + c.hd * 192 + 8 * hh;
#pragma unroll
    for (int s = 0; s < 12; ++s) qf[s] = *(const bf16x8*)(qp + 16 * s);
  }
  f32x16 o[4];
#pragma unroll
  for (int d = 0; d < 4; ++d)
#pragma unroll
    for (int i = 0; i < 16; ++i) o[d][i] = 0.f;
  float mrun = -1e30f, lrun = 0.f;
  attn_issue(c, nsteps - 1, 0);
  attn_issue(c, nsteps - 2, 1);
  attn_step_end_ml();
  int s = 0, rb = 0;
  const int nskip = nsteps - ((qb >> 1) + 1) * 2;
#pragma unroll 1
  for (; s < nskip; ++s) { if (s + 2 < nsteps) { attn_issue(c, nsteps - 3 - s, rb == 0 ? 2 : rb - 1); attn_step_end_ml(); } else attn_step_end(); rb = rb == 2 ? 0 : rb + 1; }
#pragma unroll 1
  for (; s < nsteps; ++s) {
    const int kb = nsteps - 1 - s;
    if (s + 2 < nsteps) { attn_issue(c, kb - 2, rb == 0 ? 2 : rb - 1); }
    LDS_AS unsigned char* Bf = lds + rb * AT_BUF;
    bf16x8 kf[12];
#pragma unroll
    for (int ks = 0; ks < 8; ++ks) kf[ks] = *(const LDS_AS bf16x8*)(Bf + AT_MLK + offb((unsigned)l31, (unsigned)(2 * ks + hh)));
#pragma unroll
    for (int ks = 0; ks < 4; ++ks) kf[8 + ks] = *(const LDS_AS bf16x8*)(Bf + AT_MLR + 128u * (unsigned)l31 + 16u * ((unsigned)(2 * ks + hh) ^ ((unsigned)l31 & 7u)));
    __builtin_amdgcn_sched_barrier(0);
    f32x16 z;
#pragma unroll
    for (int i = 0; i < 16; ++i) z[i] = 0.f;
#pragma unroll
    for (int ks = 0; ks < 12; ++ks) z = MFMA32(kf[ks], qf[ks], z);
    const float c2 = 0.10411754584378834f;
    float mx = fmaxf(fmaxf(z[0], z[1]), fmaxf(z[2], z[3]));
#pragma unroll
    for (int i = 4; i < 16; i += 2) mx = fmaxf(mx, fmaxf(z[i], z[i + 1]));
    { float lo, hi; xhalf(mx, lo, hi); mx = fmaxf(lo, hi) * c2; }
    if (__builtin_amdgcn_ballot_w64(mx - mrun > 8.f) != 0ull) {
      const float mnew = fmaxf(mrun, mx);
      const float alpha = __builtin_amdgcn_exp2f(mrun - mnew);
      lrun *= alpha; mrun = mnew;
#pragma unroll
      for (int d = 0; d < 4; ++d)
#pragma unroll
        for (int i = 0; i < 16; ++i) o[d][i] *= alpha;
    }
    float ls = 0.f;
#pragma unroll
    for (int i = 0; i < 16; ++i) { z[i] = __builtin_amdgcn_exp2f(fmaf(z[i], c2, -mrun)); ls += z[i]; }
    { float lo, hi; xhalf(ls, lo, hi); ls = lo + hi; }
    lrun += ls;
    const bf16x8 wf0 = pack_frag(z, 0), wf1 = pack_frag(z, 1);
    pv_accum2(Bf + AT_MLV, lane, wf0, wf1, o);
    if (s + 2 < nsteps) attn_step_end_ml(); else attn_step_end();
    rb = rb == 2 ? 0 : rb + 1;
  }
  const float inv = 1.f / lrun;
  bf16_t* op = p.oB + (tokbase + qb * 32 + l31) * 1024 + c.hd * 128;
#pragma unroll
  for (int d = 0; d < 4; ++d)
#pragma unroll
    for (int g = 0; g < 4; ++g) {
      uint2 pk; pk.x = pack2(o[d][4 * g] * inv, o[d][4 * g + 1] * inv); pk.y = pack2(o[d][4 * g + 2] * inv, o[d][4 * g + 3] * inv);
      *(uint2*)(op + d * 32 + 8 * g + 4 * hh) = pk;
    }
}

DI void phase_attn(const Params& p, LDS_AS unsigned char* lds, char* smem, int bid, int nb) {
  const int tid = OPAQUE_TID(p);
  AttnCtx c;
  c.wv = __builtin_amdgcn_readfirstlane(tid >> 6); c.lane = tid & 63;
  const int w4 = c.wv & 3;
  c.ldsb = (unsigned)__builtin_amdgcn_readfirstlane((int)(unsigned)(size_t)lds);
  c.rsQKV = __builtin_amdgcn_make_buffer_rsrc((void*)p.qkv, 0, (unsigned)NTOK * 6144u, 0x00020000);
  c.rsMKV = __builtin_amdgcn_make_buffer_rsrc((void*)p.mkv, 0, (unsigned)NTOK * 4096u, 0x00020000);
  c.rsKR = __builtin_amdgcn_make_buffer_rsrc((void*)p.krope, 0, (unsigned)NTOK * 128u, 0x00020000);
  const unsigned drow = 4u * c.wv + ((unsigned)c.lane >> 4), dchp = (unsigned)c.lane & 15u;
  const unsigned dch = dchp ^ (((drow & 3u) << 2) | ((drow >> 2) & 3u));
  const unsigned rrow = 8u * w4 + ((unsigned)c.lane >> 3), rch = ((unsigned)c.lane & 7u) ^ (rrow & 7u);
#pragma unroll 1
  for (int rnd = 0; rnd * nb < 512; ++rnd) {
    const int s = __builtin_amdgcn_readfirstlane(rnd * nb + ((rnd & 1) ? nb - 1 - bid : bid));
    if (s >= 512) break;
    const int q8 = ((rnd & 1) && (nb & 7) == 0) ? 7 - (s & 7) : (s & 7);
    const int bh = q8 * 4 + ((s >> 3) & 3), ch = 15 - (s >> 5);
    c.b = bh >> 3; c.hd = bh & 7;
    c.voff_sbk = drow * 6144u + (unsigned)(1024 + c.hd * 128) * 2u + dch * 16u;
    c.voff_sbv = drow * 6144u + (unsigned)(2048 + c.hd * 128) * 2u + dch * 16u;
    c.voff_mlk = drow * 4096u + (unsigned)(c.hd * 256) * 2u + dch * 16u;
    c.voff_mlv = drow * 4096u + (unsigned)(c.hd * 256 + 128) * 2u + dch * 16u;
    c.voff_r = rrow * 128u + rch * 16u;
    if (c.wv < 4) attn_sb_item(p, lds, c, 4 * ch + w4, 4 * ch + 4);
    else attn_mla_item(p, lds, c, 4 * ch + w4, 4 * ch + 4);
  }
}
#undef AT_DMA

DI void phase_attn_norm(const Params& p, int bid, int nb) {
  const int tid_ = OPAQUE_TID(p), lane = tid_ & 63, wv = tid_ >> 6;
  for (int t = bid * NWAVES + wv; t < NTOK; t += nb * NWAVES) {
#pragma unroll
    for (int grp = 0; grp < 2; ++grp) {
      const bf16_t* src = (grp ? p.oB : p.oA) + (size_t)t * 1024 + lane * 16;
      const float* g = (grp ? p.mla_out_norm : p.sb_out_norm) + lane * 16;
      const uint4 a0 = *(const uint4*)src, a1 = *(const uint4*)(src + 8);
      float v[16] = {bflo(a0.x), bfhi(a0.x), bflo(a0.y), bfhi(a0.y), bflo(a0.z), bfhi(a0.z), bflo(a0.w), bfhi(a0.w),
                     bflo(a1.x), bfhi(a1.x), bflo(a1.y), bfhi(a1.y), bflo(a1.z), bfhi(a1.z), bflo(a1.w), bfhi(a1.w)};
      float s = 0.f;
#pragma unroll
      for (int i = 0; i < 16; ++i) s += v[i] * v[i];
      s = wave_sum(s);
      const float rs = rsqrtf(s * (1.f / 1024.f) + RMS_EPS);
      uint4 o0, o1;
      o0.x = pack2(v[0] * rs * g[0], v[1] * rs * g[1]); o0.y = pack2(v[2] * rs * g[2], v[3] * rs * g[3]);
      o0.z = pack2(v[4] * rs * g[4], v[5] * rs * g[5]); o0.w = pack2(v[6] * rs * g[6], v[7] * rs * g[7]);
      o1.x = pack2(v[8] * rs * g[8], v[9] * rs * g[9]); o1.y = pack2(v[10] * rs * g[10], v[11] * rs * g[11]);
      o1.z = pack2(v[12] * rs * g[12], v[13] * rs * g[13]); o1.w = pack2(v[14] * rs * g[14], v[15] * rs * g[15]);
      bf16_t* dst = p.on + (size_t)t * 2048 + grp * 1024 + lane * 16;
      *(uint4*)dst = o0; *(uint4*)(dst + 8) = o1;
    }
  }
}

template <bool DRY = false>
DI void phase_ln_router(const Params& p, char* smem, int bid, int nb) {
  float* hs = (float*)smem;
  float* red = hs + 8 * 2048;
  float* lg = red + 32 * 8 * 32;
  int* lcnt = (int*)(lg + 8 * 32);
  int* lbase = lcnt + 32;
  int* lasg = lbase + 32;
  int* lnum = lasg + 1024;
  const int tid = OPAQUE_TID(p), lane = tid & 63, wv = tid >> 6;
  const int e = tid & 15, ks = tid >> 4;
  f32x2_t wr[64];
#pragma unroll
  for (int i = 0; i < 64; ++i) { wr[i][0] = p.w_router[(size_t)(ks * 64 + i) * 32 + e]; wr[i][1] = p.w_router[(size_t)(ks * 64 + i) * 32 + e + 16]; }
  if (tid < 32) lcnt[tid] = 0;
  if (tid == 32) lnum[0] = 0;
  __syncthreads();
  u32x2 za[8];
  {
    const int tf = bid * 8 + wv;
    const bf16_t* zr = p.z1b + (size_t)(tf < NTOK ? tf : 0) * DM;
#pragma unroll
    for (int i = 0; i < 8; ++i) za[i] = *(const u32x2*)(zr + (i * 64 + lane) * 4);
  }
  for (int t0 = bid * 8; t0 < NTOK; t0 += nb * 8) {
    const int t = t0 + wv;
    {
      float v[32];
#pragma unroll
      for (int i = 0; i < 8; ++i) {
        const u32x2 a = za[i];
        v[4 * i] = bflo(a.x); v[4 * i + 1] = bfhi(a.x); v[4 * i + 2] = bflo(a.y); v[4 * i + 3] = bfhi(a.y);
      }
      {
        const int tn2 = t + nb * 8;
        const bf16_t* zr = p.z1b + (size_t)(tn2 < NTOK ? tn2 : t) * DM;
#pragma unroll
        for (int i = 0; i < 8; ++i) za[i] = *(const u32x2*)(zr + (i * 64 + lane) * 4);
      }
      float s = 0.f;
#pragma unroll
      for (int i = 0; i < 32; ++i) s += v[i];
      s = wave_sum(s);
      const float mu = s * (1.f / 2048.f);
      float q = 0.f;
#pragma unroll
      for (int i = 0; i < 32; ++i) { const float d = v[i] - mu; q += d * d; }
      q = wave_sum(q);
      const float rs = rsqrtf(q * (1.f / 2048.f) + LN_EPS);
#pragma unroll
      for (int i = 0; i < 8; ++i) {
        const int c = (i * 64 + lane) * 4;
        const float4 gg = *(const float4*)(p.ln_mix_g + c);
        const float4 bb = *(const float4*)(p.ln_mix_b + c);
        float4 o;
        o.x = (v[4 * i + 0] - mu) * rs * gg.x + bb.x;
        o.y = (v[4 * i + 1] - mu) * rs * gg.y + bb.y;
        o.z = (v[4 * i + 2] - mu) * rs * gg.z + bb.z;
        o.w = (v[4 * i + 3] - mu) * rs * gg.w + bb.w;
        { uint2 pk; pk.x = pack2(o.x, o.y); pk.y = pack2(o.z, o.w); *(uint2*)(p.h1b + (size_t)t * DM + c) = pk; }
#if MOE_FP8
        {
          int pq = 0;
          pq = __builtin_amdgcn_cvt_pk_fp8_f32(fminf(fmaxf(o.x * 16.f, -440.f), 440.f), fminf(fmaxf(o.y * 16.f, -440.f), 440.f), pq, false);
          pq = __builtin_amdgcn_cvt_pk_fp8_f32(fminf(fmaxf(o.z * 16.f, -440.f), 440.f), fminf(fmaxf(o.w * 16.f, -440.f), 440.f), pq, true);
          *(int*)(p.h1q + (size_t)t * DM + c) = pq;
        }
#endif
        *(float4*)(hs + wv * 2048 + c) = o;
      }
    }
    __syncthreads();
    {
      f32x2_t acc[8];
#pragma unroll
      for (int j = 0; j < 8; ++j) acc[j] = (f32x2_t){0.f, 0.f};
#pragma unroll
      for (int j = 0; j < 8; ++j) {
#pragma unroll
        for (int i4 = 0; i4 < 16; ++i4) {
          const float4 h = *(const float4*)(hs + j * 2048 + ks * 64 + 4 * i4);
          acc[j] = __builtin_elementwise_fma((f32x2_t){h.x, h.x}, wr[4 * i4], acc[j]); acc[j] = __builtin_elementwise_fma((f32x2_t){h.y, h.y}, wr[4 * i4 + 1], acc[j]);
          acc[j] = __builtin_elementwise_fma((f32x2_t){h.z, h.z}, wr[4 * i4 + 2], acc[j]); acc[j] = __builtin_elementwise_fma((f32x2_t){h.w, h.w}, wr[4 * i4 + 3], acc[j]);
          if ((i4 & 7) == 7) __builtin_amdgcn_sched_barrier(0);
        }
      }
#pragma unroll
      for (int j = 0; j < 8; ++j) { red[(ks * 8 + j) * 32 + e] = acc[j][0]; red[(ks * 8 + j) * 32 + e + 16] = acc[j][1]; }
    }
    __syncthreads();
    if (tid < 256) {
      const int e2 = tid & 31, j = tid >> 5;
      float s = 0.f;
#pragma unroll
      for (int k2 = 0; k2 < 32; ++k2) s += red[(k2 * 8 + j) * 32 + e2];
      lg[j * 32 + e2] = s + p.b_router[e2];
    }
    __syncthreads();
    {
      float val = (lane < 32) ? lg[wv * 32 + lane] : -3.0e38f;
      float tv[4]; int ti[4];
#pragma unroll
      for (int k = 0; k < 4; ++k) {
        const float m = wave_max(val);
        const unsigned long long bal = __ballot(val == m);
        const int idx = __ffsll((long long)bal) - 1;
        tv[k] = m; ti[k] = idx;
        if (lane == idx) val = -3.0e38f;
      }
      const float e1 = __expf(tv[1] - tv[0]), e2 = __expf(tv[2] - tv[0]), e3 = __expf(tv[3] - tv[0]);
      const float inv = 1.f / (1.f + e1 + e2 + e3);
      if (lane < 4) {
        const float gk = (lane == 0 ? 1.f : lane == 1 ? e1 : lane == 2 ? e2 : e3) * inv;
        const int ek = lane == 0 ? ti[0] : lane == 1 ? ti[1] : lane == 2 ? ti[2] : ti[3];
        const int rank = atomicAdd(lcnt + ek, 1);
        const int slot = atomicAdd(lnum, 1);
        if (slot < 1024) lasg[slot] = ((t * 4 + lane) << 16) | (ek << 11) | rank;
        p.gate[t * 4 + lane] = gk;
      }
    }
    __syncthreads();
  }
  if (DRY) return;
  if (tid < 32) lbase[tid] = atomicAdd(p.cnt + tid * 32, lcnt[tid]);
  __syncthreads();
  {
    const int n = lnum[0] < 1024 ? lnum[0] : 1024;
    for (int i = tid; i < n; i += NTHREADS) {
      const int v = lasg[i], a = (int)((unsigned)v >> 16), ek = (v >> 11) & 31, rank = v & 2047;
      p.rowlist[ek * 8192 + lbase[ek] + rank] = a;
    }
  }
  __syncthreads();
}

DI void phase_final(const Params& p, int bid, int nb) {
  const int tid_ = OPAQUE_TID(p), lane = tid_ & 63, wv = tid_ >> 6;
  for (int t = bid * NWAVES + wv; t < NTOK; t += nb * NWAVES) {
    float v[32];
    const bf16_t* hr = p.h1b + (size_t)t * DM;
#pragma unroll
    for (int i = 0; i < 8; ++i) {
      const int c = (i * 64 + lane) * 4;
      const uint2 ab = *(const uint2*)(hr + c);
      float4 a; a.x = bflo(ab.x); a.y = bfhi(ab.x); a.z = bflo(ab.y); a.w = bfhi(ab.y);
      float s0 = 0.f, s1 = 0.f, s2 = 0.f, s3 = 0.f;
#pragma unroll
      for (int k = 0; k < 4; ++k) {
        const uint2 y = *(const uint2*)(p.yb + (size_t)(t * 4 + k) * 2048 + c);
        s0 += bflo(y.x); s1 += bfhi(y.x); s2 += bflo(y.y); s3 += bfhi(y.y);
      }
      v[4 * i] = DN_ALPHA * a.x + s0; v[4 * i + 1] = DN_ALPHA * a.y + s1;
      v[4 * i + 2] = DN_ALPHA * a.z + s2; v[4 * i + 3] = DN_ALPHA * a.w + s3;
    }
    ln_row_store(v, lane, p.ln_ffn_g, p.ln_ffn_b, p.out + (size_t)t * DM, nullptr);
  }
}

constexpr int MK_LDS = 163840;
extern __shared__ __attribute__((aligned(16))) char dyn_smem[];

__global__ void __launch_bounds__(NTHREADS, 2) k_forward(Params p_in) {
  Params p = p_in;
  p.wid0 = __builtin_amdgcn_readfirstlane((int)(threadIdx.x >> 6));
  if (threadIdx.x == 0) *(uint4*)dyn_smem = make_uint4(0u, 0u, 0u, 0u);
  __syncthreads();
  char* smem = dyn_smem + 16;
  LDS_AS unsigned char* lds = (LDS_AS unsigned char*)(dyn_smem + 16);
  const int bid = blockIdx.x, nb = gridDim.x;
  const bool roles = (nb & 7) == 0 && nb >= 64;
  int ncv = 0, cv_before = 0;
  bool is_cv = false;
  if (roles) {
    const int j = bid >> 3;
    for (int i = 0; i < (nb >> 3); ++i) { const bool c = ((i * 5) & 15) < CV_PER_16; ncv += c ? 8 : 0; cv_before += (c && i < j) ? 8 : 0; if (i == j) is_cv = c; }
  }
  int cvid = cv_before + (bid & 7);
  const int extra = (roles && ((((nb >> 3) - 1) * 5) & 15) >= CV_PER_16) ? CV_EXTRA : 0;
  if (extra > 0 && bid >= nb - extra) { is_cv = true; cvid = ncv + (bid - (nb - extra)); }
  ncv += extra;
  const int nc = nb - ncv;
  const int cbid = (bid & ~7) - cv_before + (bid & 7);
  const int nca = roles ? (nc & ~7) : nc;
  XcdBarrier bar = xcd_barrier_post(p.bar, (volatile LAS unsigned*)dyn_smem, (unsigned)nb);
#if JOIN_LATE
  phase_ln_in(p, bid, nb);
  phase_convert(p, smem, bid, nb);
  xcd_barrier(bar);
#endif
  if (is_cv) {
    {
      volatile LAS unsigned* stw = (volatile LAS unsigned*)dyn_smem;
      const unsigned s0 = stw[0], s1 = stw[1];
      __syncthreads();
      convert_experts_dma<5>(p, (LDS_AS unsigned char*)dyn_smem, cvid, ncv);
#if CV_REPEAT == 2
      convert_experts_dma<5>(p, (LDS_AS unsigned char*)dyn_smem, cvid, ncv);
#elif CV_REPEAT == 3
      convert_experts_dma<5, true>(p, (LDS_AS unsigned char*)dyn_smem, cvid, ncv);
#endif
      if (threadIdx.x == 0) { stw[0] = s0; stw[1] = s1; stw[2] = 0u; stw[3] = 0u; }
      __syncthreads();
    }
  } else {
    XcdBarrier barc = xcd_barrier_post(p.bar + XCD_BAR_WORDS, (volatile LAS unsigned*)dyn_smem + 2, (unsigned)nc);
#if !JOIN_LATE
    phase_ln_in(p, cbid, nc);
    phase_convert(p, smem, cbid, nc);
    xcd_barrier(barc);
#endif
    phase_in_proj(p, lds, smem, cbid, nc);
    xcd_barrier(barc);
    phase_norm_latents(p, cbid, nc);
    xcd_barrier(barc);
    phase_mla_proj(p, lds, smem, cbid, nc);
    xcd_barrier(barc);
    if (cbid < nca) phase_attn(p, lds, smem, cbid, nca);
    xcd_barrier(barc);
    phase_attn_norm(p, cbid, nc);
#if JOIN_LATE == 1
    xcd_barrier(barc);
    phase_wo(p, lds, smem, cbid, nc);
#endif
    if (ncv == 0) convert_experts_dma<4>(p, lds, bid, nb);
  }
  xcd_barrier(bar);
#if JOIN_LATE != 1
  phase_wo(p, lds, smem, bid, nb);
  xcd_barrier(bar);
#endif
  phase_ln_router(p, smem, bid, nb);
  xcd_barrier(bar);
#if MOE_PROBE
  phase_moe<1, MOE_PROBE>(p, lds, bid, nb);
  xcd_barrier(bar);
#endif
  phase_moe<1>(p, lds, bid, nb);
  xcd_barrier(bar);
  phase_moe<2>(p, lds, bid, nb);
  xcd_barrier(bar);
  phase_final(p, bid, nb);
}

extern "C" void kernel_launch(void* const* d_in, const int* in_sizes, int n_in, void* d_out, int out_size, void* d_ws,
                              size_t ws_size, hipStream_t stream) {
  Params p{};
  p.x = (const float*)d_in[0]; p.pos = (const int*)d_in[1]; p.ln_in_g = (const float*)d_in[2]; p.ln_in_b = (const float*)d_in[3];
  p.w_in = (const float*)d_in[4]; p.q_a_norm = (const float*)d_in[5]; p.w_q_b = (const float*)d_in[6];
  p.kv_a_norm = (const float*)d_in[7]; p.w_kv_b = (const float*)d_in[8]; p.sb_out_norm = (const float*)d_in[9];
  p.mla_out_norm = (const float*)d_in[10]; p.w_o = (const float*)d_in[11]; p.ln_mix_g = (const float*)d_in[12];
  p.ln_mix_b = (const float*)d_in[13]; p.w_router = (const float*)d_in[14]; p.b_router = (const float*)d_in[15];
  p.w_gate_up = (const float*)d_in[16]; p.b_gate_up = (const float*)d_in[17]; p.w_down = (const float*)d_in[18];
  p.b_down = (const float*)d_in[19]; p.ln_ffn_g = (const float*)d_in[20]; p.ln_ffn_b = (const float*)d_in[21];
  p.out = (float*)d_out;
  char* w = (char*)d_ws;
  size_t off = 0;
  auto take = [&](size_t bytes) { char* r = w + off; off += (bytes + 255) & ~(size_t)255; return r; };
  constexpr size_t ZERO_BYTES = 2 * XCD_BAR_WORDS * 4 + 4096;
  p.bar = (unsigned*)take(ZERO_BYTES);
  p.cnt = (int*)((char*)p.bar + 2 * XCD_BAR_WORDS * 4);
  p.h0f = (float*)take((size_t)NTOK * DM * 4);
  p.h0b = (bf16_t*)take((size_t)NTOK * DM * 2);
  p.qkv = (bf16_t*)take((size_t)NTOK * 3072 * 2);
  p.qlat = (bf16_t*)take((size_t)NTOK * 512 * 2);
  p.kvlat = (bf16_t*)take((size_t)NTOK * 256 * 2);
  p.krope = (bf16_t*)take((size_t)NTOK * 64 * 2);
  p.qn = (bf16_t*)take((size_t)NTOK * 512 * 2);
  p.kvn = (bf16_t*)take((size_t)NTOK * 256 * 2);
  p.mq = (bf16_t*)take((size_t)NTOK * 1536 * 2);
  p.mkv = (bf16_t*)take((size_t)NTOK * 2048 * 2);
  p.oA = (bf16_t*)take((size_t)NTOK * 1024 * 2);
  p.oB = (bf16_t*)take((size_t)NTOK * 1024 * 2);
  p.on = (bf16_t*)take((size_t)NTOK * 2048 * 2);
  p.z1 = nullptr;
  p.z1b = (bf16_t*)take((size_t)NTOK * DM * 2);
  p.h1f = (float*)take((size_t)NTOK * DM * 4);
  p.h1b = (bf16_t*)take((size_t)NTOK * DM * 2);
  p.gate = (float*)take((size_t)NTOK * 4 * 4);
  p.rowlist = (int*)take((size_t)32 * 8192 * 4);
  p.act = (bf16_t*)take((size_t)NTOK * 4 * 2048 * 2);
  p.yb = (bf16_t*)take((size_t)NTOK * 4 * 2048 * 2);
  p.h1q = (unsigned char*)take((size_t)NTOK * 2048);
  p.wq1 = (unsigned char*)take((size_t)32 * 4096 * 2048);
  p.wq2 = (unsigned char*)take((size_t)32 * 2048 * 2048);
  p.cvdump = (unsigned char*)take((size_t)64 * 2048);
  p.wt_in = (bf16_t*)take((size_t)4096 * 2048 * 2);
  p.wt_o = (bf16_t*)take((size_t)2048 * 2048 * 2);
  p.wt_q = (bf16_t*)take((size_t)1536 * 512 * 2);
  p.wt_kv = (bf16_t*)take((size_t)2048 * 256 * 2);
  p.actq = (unsigned char*)take((size_t)NTOK * 4 * 2048);

  static int grid = 0;
  if (!grid) {
    int dev = 0, cus = 0, per_cu = 0;
    (void)hipGetDevice(&dev);
    (void)hipDeviceGetAttribute(&cus, hipDeviceAttributeMultiprocessorCount, dev);
    (void)hipFuncSetAttribute((const void*)k_forward, hipFuncAttributeMaxDynamicSharedMemorySize, MK_LDS);
    (void)hipOccupancyMaxActiveBlocksPerMultiprocessor(&per_cu, (const void*)k_forward, NTHREADS, MK_LDS);
    grid = cus * (per_cu < 1 ? per_cu : 1);
  }
  (void)hipMemsetAsync(p.bar, 0, ZERO_BYTES, stream);
  if (grid > 0) k_forward<<<grid, NTHREADS, MK_LDS, stream>>>(p);
}
```

```cpp
#include <hip/hip_runtime.h>
#include <stdint.h>
#include <type_traits>

#define DI __device__ __forceinline__
typedef unsigned short bf16_t;
typedef __attribute__((ext_vector_type(8))) short bf16x8;
typedef __attribute__((ext_vector_type(16))) float f32x16;
typedef __attribute__((ext_vector_type(2))) __bf16 bf16x2_t;
typedef __attribute__((ext_vector_type(2))) float f32x2_t;

constexpr int NTOK = 8192, DM = 2048, SEQ = 2048;
constexpr int INP = 3904;
constexpr int NEXP = 32, DFF = 2048;
constexpr float LN_EPS = 1e-5f, RMS_EPS = 1e-6f;
constexpr float DN_ALPHA = 1.189207115002721f;
constexpr int NTHREADS = 512, NWAVES = 8;
#ifndef DENSE_DMA
#define DENSE_DMA 1
#endif
#ifndef JOIN_LATE
#define JOIN_LATE 2
#endif
#ifndef CV_REPEAT
#define CV_REPEAT 1
#endif
#ifndef CV_FUNC
#define CV_FUNC convert_experts_dma
#endif
#ifndef MOE_PROBE
#define MOE_PROBE 0
#endif
#ifndef CV_EXTRA
#define CV_EXTRA 4
#endif
#ifndef CVG
#define CVG 4
#endif
#ifndef CV_PER_16
#define CV_PER_16 5
#endif
#ifndef MOE_FP8
#define MOE_FP8 2
#endif

struct Params {
  const float* x; const int* pos; const float* ln_in_g; const float* ln_in_b; const float* w_in;
  const float* q_a_norm; const float* w_q_b; const float* kv_a_norm; const float* w_kv_b;
  const float* sb_out_norm; const float* mla_out_norm; const float* w_o; const float* ln_mix_g; const float* ln_mix_b;
  const float* w_router; const float* b_router; const float* w_gate_up; const float* b_gate_up;
  const float* w_down; const float* b_down; const float* ln_ffn_g; const float* ln_ffn_b;
  float* out;
  int wid0, pad0;
  unsigned* bar;
  int* cnt;
  float* h0f;
  bf16_t* h0b;
  bf16_t* qkv;
  bf16_t* qlat;
  bf16_t* kvlat;
  bf16_t* krope;
  bf16_t* qn;
  bf16_t* kvn;
  bf16_t* mq;
  bf16_t* mkv;
  bf16_t* oA;
  bf16_t* oB;
  bf16_t* on;
  float* z1;
  bf16_t* z1b;
  float* h1f;
  bf16_t* h1b;
  float* gate;
  int* rowlist;
  bf16_t* act;
  bf16_t* yb;
  bf16_t* wt_in;
  bf16_t* wt_o;
  bf16_t* wt_q;
  bf16_t* wt_kv;
  unsigned char* wq1;
  unsigned char* wq2;
  unsigned char* cvdump;
  unsigned char* h1q;
  unsigned char* actq;
};

DI unsigned pack2(float a, float b) {
  f32x2_t v = {a, b};
  bf16x2_t r = __builtin_convertvector(v, bf16x2_t);
  return __builtin_bit_cast(unsigned, r);
}
DI bf16_t f2bf(float a) { return (bf16_t)(pack2(a, 0.f) & 0xffffu); }
DI float bf2f(bf16_t h) { return __uint_as_float(((unsigned)h) << 16); }
DI float bflo(unsigned u) { return __uint_as_float(u << 16); }
DI float bfhi(unsigned u) { return __uint_as_float(u & 0xffff0000u); }
DI int crow(int reg, int h) { return (reg & 3) + 8 * (reg >> 2) + 4 * h; }
DI float wave_sum(float v) {
#pragma unroll
  for (int o = 32; o > 0; o >>= 1) v += __shfl_xor(v, o);
  return v;
}
DI float wave_max(float v) {
#pragma unroll
  for (int o = 32; o > 0; o >>= 1) v = fmaxf(v, __shfl_xor(v, o));
  return v;
}

__constant__ float INV_FREQ[32] = {1.000000000e+00f, 7.498942093e-01f, 5.623413252e-01f, 4.216965034e-01f, 3.162277660e-01f, 2.371373706e-01f, 1.778279410e-01f, 1.333521432e-01f, 1.000000000e-01f, 7.498942093e-02f, 5.623413252e-02f, 4.216965034e-02f, 3.162277660e-02f, 2.371373706e-02f, 1.778279410e-02f, 1.333521432e-02f, 1.000000000e-02f, 7.498942093e-03f, 5.623413252e-03f, 4.216965034e-03f, 3.162277660e-03f, 2.371373706e-03f, 1.778279410e-03f, 1.333521432e-03f, 1.000000000e-03f, 7.498942093e-04f, 5.623413252e-04f, 4.216965034e-04f, 3.162277660e-04f, 2.371373706e-04f, 1.778279410e-04f, 1.333521432e-04f};
DI void rope_sc(int pos, int i, float& sn, float& cs) {
  const float ang = (float)pos * INV_FREQ[i];
  double rev = (double)ang * 0.15915494309189535;
  rev -= rint(rev);
  const float fr = (float)rev;
  sn = __builtin_amdgcn_sinf(fr);
  cs = __builtin_amdgcn_cosf(fr);
}
typedef __attribute__((ext_vector_type(4))) short s16x4;
#define LDS_AS __attribute__((address_space(3)))
DI s16x4 tr_read4(const bf16_t* p) { return __builtin_amdgcn_ds_read_tr16_b64_v4i16((LDS_AS s16x4*)p); }
DI bf16x8 tr_frag(const bf16_t* p0, const bf16_t* p1) {
  const s16x4 a = tr_read4(p0), b = tr_read4(p1);
  return __builtin_shufflevector(a, b, 0, 1, 2, 3, 4, 5, 6, 7);
}
DI int lane_id_now() { int l; asm volatile("v_mbcnt_lo_u32_b32 %0, -1, 0\n\tv_mbcnt_hi_u32_b32 %0, -1, %0" : "=v"(l)); return l; }
#define OPAQUE_TID(P) (((P).wid0 << 6) | lane_id_now())
DI int pack4_fp8(float a, float b, float c, float d) {
  int pk = 0;
  pk = __builtin_amdgcn_cvt_pk_fp8_f32(a, b, pk, false);
  pk = __builtin_amdgcn_cvt_pk_fp8_f32(c, d, pk, true);
  return pk;
}
#define MFMA32(a, b, c) __builtin_amdgcn_mfma_f32_32x32x16_bf16((a), (b), (c), 0, 0, 0)

DI void ln_row_store(const float (&v)[32], int lane, const float* g, const float* b, float* outf, bf16_t* outb) {
  float s = 0.f;
#pragma unroll
  for (int i = 0; i < 32; ++i) s += v[i];
  s = wave_sum(s);
  const float mu = s * (1.f / 2048.f);
  float q = 0.f;
#pragma unroll
  for (int i = 0; i < 32; ++i) { const float d = v[i] - mu; q += d * d; }
  q = wave_sum(q);
  const float rs = rsqrtf(q * (1.f / 2048.f) + LN_EPS);
#pragma unroll
  for (int i = 0; i < 8; ++i) {
    const int c = (i * 64 + lane) * 4;
    const float4 gg = *(const float4*)(g + c);
    const float4 bb = *(const float4*)(b + c);
    float4 o;
    o.x = (v[4 * i + 0] - mu) * rs * gg.x + bb.x;
    o.y = (v[4 * i + 1] - mu) * rs * gg.y + bb.y;
    o.z = (v[4 * i + 2] - mu) * rs * gg.z + bb.z;
    o.w = (v[4 * i + 3] - mu) * rs * gg.w + bb.w;
    if (outf) *(float4*)(outf + c) = o;
    if (outb) { uint2 pk; pk.x = pack2(o.x, o.y); pk.y = pack2(o.z, o.w); *(uint2*)(outb + c) = pk; }
  }
}

DI void phase_ln_in(const Params& p, int bid, int nb) {
  const int tid_ = OPAQUE_TID(p), lane = tid_ & 63, wv = tid_ >> 6;
  typedef __attribute__((ext_vector_type(4))) float f32x4l;
  f32x4l nx[8];
  {
    const int t0 = bid * NWAVES + wv;
    const float* xr = p.x + (size_t)(t0 < NTOK ? t0 : 0) * DM;
#pragma unroll
    for (int i = 0; i < 8; ++i) nx[i] = *(const f32x4l*)(xr + (i * 64 + lane) * 4);
  }
  for (int t = bid * NWAVES + wv; t < NTOK; t += nb * NWAVES) {
    float v[32];
#pragma unroll
    for (int i = 0; i < 8; ++i) { v[4 * i] = nx[i][0]; v[4 * i + 1] = nx[i][1]; v[4 * i + 2] = nx[i][2]; v[4 * i + 3] = nx[i][3]; }
    {
      const int tn = t + nb * NWAVES;
      const float* xr = p.x + (size_t)(tn < NTOK ? tn : t) * DM;
#pragma unroll
      for (int i = 0; i < 8; ++i) nx[i] = *(const f32x4l*)(xr + (i * 64 + lane) * 4);
    }
    ln_row_store(v, lane, p.ln_in_g, p.ln_in_b, nullptr, p.h0b + (size_t)t * DM);
  }
}

#define XB_TMO      128
#define XB_XCNT(j)  (256  + 64 * (j))
#define XB_XSUB(j)  (1280 + 64 * (j))
#define XB_XGEN(j)  (2304 + 64 * (j))
#define XB_TOP      3328
#define XB_TOPGEN   3392
#define XCD_BAR_WORDS 3456
#define XB_SPIN_CAP (1u << 18)
#define LAS __attribute__((address_space(3)))

__device__ __forceinline__ unsigned xb_ld(unsigned* p)              { return __hip_atomic_load(p, __ATOMIC_RELAXED, __HIP_MEMORY_SCOPE_AGENT); }
__device__ __forceinline__ unsigned xb_add(unsigned* p, unsigned v) { return __hip_atomic_fetch_add(p, v, __ATOMIC_RELAXED, __HIP_MEMORY_SCOPE_AGENT); }
__device__ __forceinline__ unsigned xb_xcc_id() { return (unsigned)__builtin_amdgcn_s_getreg((3 << 11) | 20) & 0xFu; }
#define XB_SPIN(cond, bar) do { unsigned _sp = 0; while (cond) { __builtin_amdgcn_s_sleep(1); \
    if ((++_sp & 255u) == 0u) { if (xb_ld(&(bar)[XB_TMO])) break; if (_sp > XB_SPIN_CAP) { atomicAdd(&(bar)[XB_TMO], 1u); break; } } } } while (0)

struct XcdBarrier {
    unsigned* bar; unsigned x;
    volatile LAS unsigned* st;
    unsigned G;
};

__device__ __forceinline__ XcdBarrier xcd_barrier_post(unsigned* bar, volatile LAS unsigned* st, unsigned G) {
    XcdBarrier b; b.bar = bar; b.x = xb_xcc_id(); b.st = st; b.G = G;
    if (threadIdx.x == 0) (void)xb_add(&bar[XB_XCNT(b.x)], 1u);
    return b;
}
__device__ __forceinline__ void xcd_barrier_complete(unsigned* bar, unsigned x, unsigned G, unsigned& nloc, unsigned& nx) {
    unsigned sum, cnt, mine, sp = 0u;
    for (;;) {
        sum = 0u; cnt = 0u; mine = 0u;
#pragma unroll
        for (unsigned j = 0; j < 16; ++j) { const unsigned c = xb_ld(&bar[XB_XCNT(j)]); sum += c; cnt += (c > 0u) ? 1u : 0u; mine = (j == x) ? c : mine; }
        if (sum == G) break;
        __builtin_amdgcn_s_sleep(1);
        if ((++sp & 255u) == 0u) { if (xb_ld(&bar[XB_TMO])) break; if (sp > XB_SPIN_CAP) { atomicAdd(&bar[XB_TMO], 1u); break; } }
    }
    nloc = mine > 0u ? mine : 1u; nx = cnt > 0u ? cnt : 1u;
}

__device__ __forceinline__ void xcd_barrier(const XcdBarrier& b) {
    asm volatile("s_waitcnt vmcnt(0)" ::: "memory");
    __syncthreads();
    if (threadIdx.x == 0) {
        unsigned* bar = b.bar;
        __builtin_amdgcn_s_waitcnt(0);
        unsigned nloc = b.st[0], nx = b.st[1];
        if (nloc == 0u) { xcd_barrier_complete(bar, b.x, b.G, nloc, nx); b.st[0] = nloc; b.st[1] = nx; }
        const unsigned old = xb_add(&bar[XB_XSUB(b.x)], 1u);
        const unsigned gen = old / nloc;
        if (old + 1u == (gen + 1u) * nloc) {
            __builtin_amdgcn_fence(__ATOMIC_RELEASE, "agent");
            asm volatile("s_waitcnt vmcnt(0)" ::: "memory");
            const unsigned og = xb_add(&bar[XB_TOP], 1u);
            const unsigned tg = og / nx;
            if (og + 1u == (tg + 1u) * nx) xb_add(&bar[XB_TOPGEN], 1u);
            else XB_SPIN(xb_ld(&bar[XB_TOPGEN]) == tg, bar);
            __builtin_amdgcn_fence(__ATOMIC_ACQUIRE, "agent");
            xb_add(&bar[XB_XGEN(b.x)], 1u);
            asm volatile("s_waitcnt vmcnt(0)" ::: "memory");
        } else {
            XB_SPIN(xb_ld(&bar[XB_XGEN(b.x)]) == gen, bar);
            __builtin_amdgcn_fence(__ATOMIC_ACQUIRE, "agent");
            asm volatile("s_waitcnt vmcnt(0)" ::: "memory");
        }
    }
    __syncthreads();
}

constexpr int HTB = 16384;
constexpr int G256_LDS = 8 * HTB;
#define G_SA(b, h) (((b) * 2 + (h)) * HTB)
#define G_SB(b, h) ((4 + (b) * 2 + (h)) * HTB)
typedef __attribute__((ext_vector_type(4))) float f32x4;
typedef __attribute__((ext_vector_type(4))) unsigned u32x4;
typedef __attribute__((ext_vector_type(2))) unsigned u32x2;

DI int lds_byte(int r, int c) { const int st = (r >> 4) * 2 + (c >> 5), rr = r & 15, cc = c & 31, ob = rr * 64 + cc * 2; return st * 1024 + (ob ^ (((ob >> 9) & 1) << 5)); }
DI void stage_rc(int b, int& R, int& C) { const int st = b / 1024, sb = b % 1024, swz = sb ^ (((sb >> 9) & 1) << 5); R = (st >> 1) * 16 + swz / 64; C = (st & 1) * 32 + (swz % 64) / 2; }
DI unsigned offb(unsigned row, unsigned ch) { return 256u * row + 16u * (ch ^ (((row & 3u) << 2) | ((row >> 2) & 3u))); }

DI f32x4 bufload4(__amdgpu_buffer_rsrc_t rs, unsigned voff, unsigned soff) {
#if defined(__HIP_DEVICE_COMPILE__)
  return __builtin_bit_cast(f32x4, __builtin_amdgcn_raw_buffer_load_b128(rs, voff, soff, 0));
#else
  return (f32x4){0.f, 0.f, 0.f, 0.f};
#endif
}
DI int tcol_p64(int lc) { return (lc & ~0x30) | ((lc & 0x10) << 1) | ((lc & 0x20) >> 1); }
DI int tcol_gu(int lc) { return ((lc & 0x30) << 1) | ((lc & 0x40) >> 2) | (lc & 15); }

#define G_WAIT_V(n) asm volatile("s_waitcnt vmcnt(" #n ")" ::: "memory")
#define G_WAIT_L0() asm volatile("s_waitcnt lgkmcnt(0)" ::: "memory")
#define G_BAR() __builtin_amdgcn_s_barrier()
#define G_SCHED() __builtin_amdgcn_sched_barrier(0)

template <class Cfg, int MODE = 0, bool TOPHALF = false>
DI void gemm256_unit(LDS_AS unsigned char* lds, const Cfg& cfg) {
  const int tid = OPAQUE_TID(cfg.p), wid = __builtin_amdgcn_readfirstlane(tid >> 6), lane = tid & 63, wr = wid >> 2, wc = wid & 3, fr = lane & 15, fq = lane >> 4;
  const int nt = cfg.nkt();
  constexpr bool act0 = true, act1 = !TOPHALF;
  unsigned voffA[2][2];
#pragma unroll
  for (int i = 0; i < 2; ++i) {
    int R, C; stage_rc(tid * 16 + i * 8192, R, C);
    voffA[0][i] = cfg.a_rowoff(R) + (unsigned)C * 2u;
    voffA[1][i] = cfg.a_rowoff(128 + R) + (unsigned)C * 2u;
  }
  const __amdgpu_buffer_rsrc_t rsA = __builtin_amdgcn_make_buffer_rsrc((void*)cfg.a_base(), 0, cfg.a_bytes(), 0x00020000);
  const __amdgpu_buffer_rsrc_t rsB = __builtin_amdgcn_make_buffer_rsrc((void*)cfg.b_base(), 0, cfg.b_bytes(), 0x00020000);
  const unsigned ldsw = (unsigned)__builtin_amdgcn_readfirstlane((int)(unsigned)(size_t)lds) + (unsigned)wid * 1024u;
#define G_STAGE_A(slot, half, kt) do { if (MODE == 3 || MODE == 4) break; _Pragma("unroll") for (int _i = 0; _i < 2; ++_i) { const unsigned _m0 = ldsw + (unsigned)((slot) + _i * 8192); const unsigned _so = (unsigned)(kt) * 128u; \
    asm volatile("s_mov_b32 m0, %0\n\ts_nop 4\n\tbuffer_load_dwordx4 %1, %2, %3 offen lds" :: "s"(_m0), "v"(voffA[half][_i]), "s"(rsA), "s"(_so) : "m0", "memory"); } } while (0)
  const int kk = tid >> 5, lc = (tid & 31) * 4;
  const int ldb = cfg.ldb();
  unsigned voffB[2];
  voffB[0] = (unsigned)(kk * ldb + cfg.b_gcol(0, lc)) * 4u;
  voffB[1] = (unsigned)(kk * ldb + cfg.b_gcol(1, lc)) * 4u;
  const int tc = Cfg::GU ? tcol_gu(lc) : tcol_p64(lc);
  const unsigned wofB = offb((unsigned)kk, (unsigned)(tc >> 3)) + ((tc & 4) ? 8u : 0u);
  const unsigned ldb64 = (unsigned)ldb * 256u;
  const unsigned ldb16 = (unsigned)ldb * 64u;
#define G_LOAD_B(dst, half, kt) do { if (MODE == 3 || MODE == 5) { _Pragma("unroll") for (int _i = 0; _i < 4; ++_i) asm volatile("" : "+v"(dst[_i])); break; } _Pragma("unroll") for (int _i = 0; _i < 4; ++_i) { const unsigned _so = (unsigned)(kt) * ldb64 + _i * ldb16; \
    asm volatile("s_nop 4\n\tbuffer_load_dwordx4 %0, %1, %2, %3 offen" : "=v"(dst[_i]) : "v"(voffB[half]), "s"(rsB), "s"(_so) : "memory"); } } while (0)
#define G_WAIT_B(n, r) asm volatile("s_waitcnt vmcnt(" #n ")" : "+v"(r[0]), "+v"(r[1]), "+v"(r[2]), "+v"(r[3]) :: "memory")
#define G_WRITE_B(slot, src) do { _Pragma("unroll") for (int _i = 0; _i < 4; ++_i) { u32x2 _pk; _pk.x = pack2(src[_i][0], src[_i][1]); _pk.y = pack2(src[_i][2], src[_i][3]); \
    *(LDS_AS u32x2*)(lds + (slot) + wofB + _i * 4096) = _pk; } } while (0)
  const int aoff = lds_byte(wr * 64 + fr, fq * 8);
  unsigned boff[2][2];
  {
    const unsigned q = (unsigned)(lane & 15) >> 2, pp = (unsigned)lane & 3u;
#pragma unroll
    for (int n = 0; n < 2; ++n)
#pragma unroll
      for (int t = 0; t < 2; ++t)
        boff[n][t] = offb(8u * fq + 4u * t + q, (unsigned)(4 * wc + 2 * n) + (pp >> 1)) + 8u * (pp & 1u);
  }
#define G_LDA(dst, slot) do { if (MODE == 6) { _Pragma("unroll") for (int m = 0; m < 4; ++m) _Pragma("unroll") for (int k = 0; k < 2; ++k) asm volatile("" : "+v"(dst[m][k])); break; } _Pragma("unroll") for (int m = 0; m < 4; ++m) _Pragma("unroll") for (int k = 0; k < 2; ++k) \
    dst[m][k] = *(const LDS_AS bf16x8*)(lds + (slot) + aoff + m * 2048 + k * 1024); } while (0)
#define G_LDB(dst, slot) do { if (MODE == 6) { _Pragma("unroll") for (int n = 0; n < 2; ++n) _Pragma("unroll") for (int k = 0; k < 2; ++k) asm volatile("" : "+v"(dst[n][k])); break; } _Pragma("unroll") for (int n = 0; n < 2; ++n) _Pragma("unroll") for (int k = 0; k < 2; ++k) { \
    const s16x4 _lo = __builtin_amdgcn_ds_read_tr16_b64_v4i16((LDS_AS s16x4*)(lds + (slot) + boff[n][0] + k * 8192)); \
    const s16x4 _hi = __builtin_amdgcn_ds_read_tr16_b64_v4i16((LDS_AS s16x4*)(lds + (slot) + boff[n][1] + k * 8192)); \
    dst[n][k] = __builtin_shufflevector(_lo, _hi, 0, 1, 2, 3, 4, 5, 6, 7); } } while (0)
#define G_MMA(ai, bj, At, Bf) do { if (!((ai) ? act1 : act0)) break; if (MODE == 2) { _Pragma("unroll") for (int m = 0; m < 4; ++m) _Pragma("unroll") for (int k = 0; k < 2; ++k) asm volatile("" :: "v"(At[m][k])); _Pragma("unroll") for (int n = 0; n < 2; ++n) _Pragma("unroll") for (int k = 0; k < 2; ++k) asm volatile("" :: "v"(Bf[n][k])); break; } __builtin_amdgcn_s_setprio(1); _Pragma("unroll") for (int m = 0; m < 4; ++m) _Pragma("unroll") for (int n = 0; n < 2; ++n) _Pragma("unroll") for (int k = 0; k < 2; ++k) \
    acc[ai][bj][m][n] = __builtin_amdgcn_mfma_f32_16x16x32_bf16(Bf[n][k], At[m][k], acc[ai][bj][m][n], 0, 0, 0); __builtin_amdgcn_s_setprio(0); } while (0)

#define G_MFMA4(ai, bj, At, Bf, m) do { if (!((ai) ? act1 : act0)) break; _Pragma("unroll") for (int n = 0; n < 2; ++n) _Pragma("unroll") for (int k = 0; k < 2; ++k) \
    acc[ai][bj][m][n] = __builtin_amdgcn_mfma_f32_16x16x32_bf16(Bf[n][k], At[m][k], acc[ai][bj][m][n], 0, 0, 0); } while (0)
#define G_WRITE_B2(slot, src, i0) do { if (MODE == 8) break; _Pragma("unroll") for (int _i = i0; _i < i0 + 2; ++_i) { u32x2 _pk; _pk.x = pack2(src[_i][0], src[_i][1]); _pk.y = pack2(src[_i][2], src[_i][3]); \
    *(LDS_AS u32x2*)(lds + (slot) + wofB + _i * 4096) = _pk; } } while (0)
#define G_LOAD_B2(dst, half, kt, i0) do { if (MODE == 3 || MODE == 5) { _Pragma("unroll") for (int _i = i0; _i < i0 + 2; ++_i) asm volatile("" : "+v"(dst[_i])); break; } \
    _Pragma("unroll") for (int _i = i0; _i < i0 + 2; ++_i) { const unsigned _so = (unsigned)(kt) * ldb64 + _i * ldb16; \
    asm volatile("s_nop 4\n\tbuffer_load_dwordx4 %0, %1, %2, %3 offen" : "=v"(dst[_i]) : "v"(voffB[half]), "s"(rsB), "s"(_so) : "memory"); } } while (0)
#define G_MMA_STAGE(ai, bj, At, Bf, slot, Rs, half, kt) do { if (MODE == 2) { G_MMA(ai, bj, At, Bf); G_WAIT_B(8, Rs); G_WRITE_B(slot, Rs); G_LOAD_B(Rs, half, kt); break; } \
    __builtin_amdgcn_s_setprio(1); \
    G_MFMA4(ai, bj, At, Bf, 0); G_SCHED(); G_WAIT_B(8, Rs); G_WRITE_B2(slot, Rs, 0); G_SCHED(); \
    G_MFMA4(ai, bj, At, Bf, 1); G_SCHED(); G_WRITE_B2(slot, Rs, 2); G_SCHED(); \
    G_MFMA4(ai, bj, At, Bf, 2); G_SCHED(); G_LOAD_B2(Rs, half, kt, 0); G_SCHED(); \
    G_MFMA4(ai, bj, At, Bf, 3); G_SCHED(); G_LOAD_B2(Rs, half, kt, 2); \
    __builtin_amdgcn_s_setprio(0); } while (0)
  f32x4 Ra[4], Rb[4];
  if (MODE == 3 || MODE == 5) { _Pragma("unroll") for (int i = 0; i < 4; ++i) { const float f = (float)((tid * 2654435761u + i * 40503u) & 0xffffu) * (1.f / 32768.f) - 1.f; Ra[i] = (f32x4){f, -f * 0.7f, f * 0.3f + 0.1f, 0.5f - f}; Rb[i] = (f32x4){0.2f - f, f * 0.9f, -f, f * 0.5f}; } }
  {
    G_STAGE_A(G_SA(0, 0), 0, 0); G_STAGE_A(G_SA(0, 1), 1, 0); G_STAGE_A(G_SA(1, 0), 0, 1);
    f32x4 X0[4], X1[4], X2[4];
    G_LOAD_B(X0, 1, 0); G_LOAD_B(X1, 0, 0); G_LOAD_B(X2, 1, 1); G_LOAD_B(Ra, 0, 1); G_LOAD_B(Rb, 1, (2 < nt ? 2 : 0));
    G_WAIT_B(8, X0); G_WAIT_B(8, X1); G_WAIT_B(8, X2);
    G_WRITE_B(G_SB(0, 1), X0); G_WRITE_B(G_SB(0, 0), X1); G_WRITE_B(G_SB(1, 1), X2);
    G_WAIT_B(0, Ra); G_WAIT_B(0, Rb);
    G_WAIT_L0();
    G_BAR();
  }
  f32x4 acc[2][2][4][2];
#pragma unroll
  for (int a = 0; a < 2; ++a)
#pragma unroll
    for (int b = 0; b < 2; ++b)
#pragma unroll
      for (int m = 0; m < 4; ++m)
#pragma unroll
        for (int n = 0; n < 2; ++n) acc[a][b][m][n] = (f32x4){0.f, 0.f, 0.f, 0.f};
  bf16x8 At[4][2], B0[2][2], B1[2][2];
  if (MODE == 6) { _Pragma("unroll") for (int m = 0; m < 4; ++m) _Pragma("unroll") for (int k = 0; k < 2; ++k) At[m][k] = (bf16x8){1, 2, 3, 4, 5, 6, 7, 8}; _Pragma("unroll") for (int n = 0; n < 2; ++n) _Pragma("unroll") for (int k = 0; k < 2; ++k) { B0[n][k] = (bf16x8){1, 2, 3, 4, 5, 6, 7, 8}; B1[n][k] = B0[n][k]; } }
  if (wr == 1 && MODE != 7) G_BAR();
#define G_LBAR() do { if (MODE != 7) G_BAR(); } while (0)
#pragma clang loop unroll(disable)
  for (int t = 0; t < nt; t += 2) {
    const int t1 = t + 1;
    const int t2 = (t + 2 < nt) ? t + 2 : 0;
    const int t3 = (t + 2 < nt) ? t + 3 : 1;
    const int t4 = (t + 4 < nt) ? t + 4 : (t + 4 - nt < nt ? t + 4 - nt : 0);
    G_LDB(B0, G_SB(0, 0)); G_LDA(At, G_SA(0, 0)); G_STAGE_A(G_SA(1, 1), 1, t1);
    G_LBAR(); G_WAIT_L0(); G_SCHED(); G_MMA(0, 0, At, B0); G_LBAR(); G_SCHED();
    G_LDB(B1, G_SB(0, 1));
    G_LBAR(); G_WAIT_L0(); G_SCHED(); G_MMA_STAGE(0, 1, At, B1, G_SB(1, 0), Ra, 0, t2); G_LBAR(); G_SCHED();
    G_LDA(At, G_SA(0, 1)); G_STAGE_A(G_SA(0, 0), 0, t2);
    G_LBAR(); G_WAIT_L0(); G_SCHED(); G_MMA(1, 1, At, B1); G_LBAR(); G_SCHED();
    G_LDB(B0, G_SB(0, 0));
    G_LBAR(); G_WAIT_L0(); G_SCHED(); G_MMA_STAGE(1, 0, At, B0, G_SB(0, 1), Rb, 1, t3); G_LBAR(); G_SCHED();
    G_LDB(B0, G_SB(1, 0)); G_LDA(At, G_SA(1, 0)); G_STAGE_A(G_SA(0, 1), 1, t2);
    G_LBAR(); G_WAIT_L0(); G_SCHED(); G_MMA(0, 0, At, B0); G_LBAR(); G_SCHED();
    G_LDB(B1, G_SB(1, 1));
    G_LBAR(); G_WAIT_L0(); G_SCHED(); G_MMA_STAGE(0, 1, At, B1, G_SB(0, 0), Ra, 0, t3); G_LBAR(); G_SCHED();
    G_LDA(At, G_SA(1, 1)); G_STAGE_A(G_SA(1, 0), 0, t3);
    G_LBAR(); G_WAIT_L0(); G_SCHED(); G_MMA(1, 1, At, B1); G_LBAR(); G_SCHED();
    G_LDB(B0, G_SB(1, 0));
    G_LBAR(); G_WAIT_L0(); G_SCHED(); G_MMA_STAGE(1, 0, At, B0, G_SB(1, 1), Rb, 1, t4); G_LBAR(); G_SCHED();
  }
  G_WAIT_B(0, Ra); G_WAIT_B(0, Rb); G_SCHED();
  if (wr == 0 && MODE != 7) G_BAR();
  {
    const int wid2 = wid, ln2 = lane_id_now(), wr2 = wid2 >> 2, wc2 = wid2 & 3, fr2 = ln2 & 15, fq2 = ln2 >> 4;
#pragma unroll
    for (int ai = 0; ai < 2; ++ai)
#pragma unroll
      for (int m = 0; m < 4; ++m)
#pragma unroll
        for (int bj = 0; bj < 2; ++bj)
          if (MODE == 0) cfg.epi(ai * 128 + wr2 * 64 + m * 16 + fr2, bj, wc2, fq2, acc[ai][bj][m][0], acc[ai][bj][m][1]);
          else asm volatile("" :: "v"(acc[ai][bj][m][0]), "v"(acc[ai][bj][m][1]));
  }
  G_BAR();
#undef G_STAGE_A
#undef G_LOAD_B
#undef G_WRITE_B
#undef G_LDA
#undef G_LDB
#undef G_MMA
#undef G_MFMA4
#undef G_WRITE_B2
#undef G_LOAD_B2
#undef G_MMA_STAGE
}

constexpr int F8_SA_BYTES = 16384, F8_SB_BYTES = 128 * 144;
constexpr int G256F8_LDS = 4 * F8_SA_BYTES + 4 * F8_SB_BYTES;
#define F_SA(b, h) (((b) * 2 + (h)) * F8_SA_BYTES)
#define F_SB(b, h) (4 * F8_SA_BYTES + ((b) * 2 + (h)) * F8_SB_BYTES)
typedef __attribute__((ext_vector_type(8))) int i32x8;
typedef __attribute__((ext_vector_type(4))) int i32x4;

template <class Cfg, bool TOPHALF = false>
DI void gemm256f8_unit(LDS_AS unsigned char* lds, const Cfg& cfg) {
  const int tid = OPAQUE_TID(cfg.p), wid = __builtin_amdgcn_readfirstlane(tid >> 6), lane = tid & 63, wr = wid >> 2, wc = wid & 3, fr = lane & 15, fq = lane >> 4;
  const int nt = cfg.nkt();
  constexpr bool act1 = !TOPHALF;
  unsigned voffA[2][2];
#pragma unroll
  for (int i = 0; i < 2; ++i) {
    const int r = 8 * (wid + 8 * i) + (lane >> 3);
    const unsigned cofs = 16u * (((unsigned)lane & 7u) ^ (((unsigned)lane >> 3) & 7u));
    voffA[0][i] = cfg.a_rowoff(r) + cofs;
    voffA[1][i] = cfg.a_rowoff(128 + r) + cofs;
  }
  const __amdgpu_buffer_rsrc_t rsA = __builtin_amdgcn_make_buffer_rsrc((void*)cfg.a_base(), 0, cfg.a_bytes(), 0x00020000);
  const __amdgpu_buffer_rsrc_t rsB = __builtin_amdgcn_make_buffer_rsrc((void*)cfg.b_base(), 0, cfg.b_bytes(), 0x00020000);
  const unsigned ldsw = (unsigned)__builtin_amdgcn_readfirstlane((int)(unsigned)(size_t)lds) + (unsigned)wid * 1024u;
#define F_STAGE_A(slot, half, kt) do { _Pragma("unroll") for (int _i = 0; _i < 2; ++_i) { const unsigned _m0 = ldsw + (unsigned)((slot) + _i * 8192); const unsigned _so = (unsigned)(kt) * 128u; \
    asm volatile("s_mov_b32 m0, %0\n\ts_nop 4\n\tbuffer_load_dwordx4 %1, %2, %3 offen lds" :: "s"(_m0), "v"(voffA[half][_i]), "s"(rsA), "s"(_so) : "m0", "memory"); } } while (0)
  const int kg = tid >> 5, lc = (tid & 31) * 4;
  const int ldb = cfg.ldb();
  unsigned voffB[2];
  voffB[0] = (unsigned)(4 * kg * ldb + cfg.b_gcol(0, lc)) * 4u;
  voffB[1] = (unsigned)(4 * kg * ldb + cfg.b_gcol(1, lc)) * 4u;
  const int tc = Cfg::GU ? tcol_gu(lc) : tcol_p64(lc);
  const unsigned wofB = (unsigned)tc * 144u + 4u * (unsigned)kg;
  const unsigned ldb128 = (unsigned)ldb * 512u;
  const unsigned ldb1 = (unsigned)ldb * 4u;
  const float bmul = cfg.bmul();
#define F_LOAD_B4(dst, half, kt, b) do { _Pragma("unroll") for (int _r = 0; _r < 4; ++_r) { const unsigned _so = (unsigned)(kt) * ldb128 + (unsigned)(64 * (b) + _r) * ldb1; \
    asm volatile("s_nop 4\n\tbuffer_load_dwordx4 %0, %1, %2, %3 offen" : "=v"(dst[4 * (b) + _r]) : "v"(voffB[half]), "s"(rsB), "s"(_so) : "memory"); } } while (0)
#define F_LOAD_B(dst, half, kt) do { F_LOAD_B4(dst, half, kt, 0); F_LOAD_B4(dst, half, kt, 1); } while (0)
#define F_WRITE_B4(slot, src, b) do { _Pragma("unroll") for (int _j = 0; _j < 4; ++_j) { int _pk = 0; \
    _pk = __builtin_amdgcn_cvt_pk_fp8_f32(src[4 * (b) + 0][_j] * bmul, src[4 * (b) + 1][_j] * bmul, _pk, false); \
    _pk = __builtin_amdgcn_cvt_pk_fp8_f32(src[4 * (b) + 2][_j] * bmul, src[4 * (b) + 3][_j] * bmul, _pk, true); \
    *(LDS_AS int*)(lds + (slot) + wofB + _j * 144 + (b) * 64) = _pk; } } while (0)
#define F_WRITE_B(slot, src) do { F_WRITE_B4(slot, src, 0); F_WRITE_B4(slot, src, 1); } while (0)
#define F_WAIT_B(n, r) asm volatile("s_waitcnt vmcnt(" #n ")" : "+v"(r[0]), "+v"(r[1]), "+v"(r[2]), "+v"(r[3]), "+v"(r[4]), "+v"(r[5]), "+v"(r[6]), "+v"(r[7]) :: "memory")
  unsigned aoff[2];
  aoff[0] = (unsigned)(64 * wr + fr) * 128u + 16u * ((2u * fq) ^ ((unsigned)fr & 7u));
  aoff[1] = (unsigned)(64 * wr + fr) * 128u + 16u * ((2u * fq + 1u) ^ ((unsigned)fr & 7u));
  const unsigned boff = (unsigned)(32 * wc + fr) * 144u + 32u * fq;
#define F_LDA(dst, slot) do { _Pragma("unroll") for (int m = 0; m < 4; ++m) { \
    const i32x4 _lo = *(const LDS_AS i32x4*)(lds + (slot) + aoff[0] + m * 2048); const i32x4 _hi = *(const LDS_AS i32x4*)(lds + (slot) + aoff[1] + m * 2048); \
    dst[m] = __builtin_shufflevector(_lo, _hi, 0, 1, 2, 3, 4, 5, 6, 7); } } while (0)
#define F_LDB(dst, slot) do { _Pragma("unroll") for (int n = 0; n < 2; ++n) { \
    const i32x4 _lo = *(const LDS_AS i32x4*)(lds + (slot) + boff + n * 2304); const i32x4 _hi = *(const LDS_AS i32x4*)(lds + (slot) + boff + n * 2304 + 16); \
    dst[n] = __builtin_shufflevector(_lo, _hi, 0, 1, 2, 3, 4, 5, 6, 7); } } while (0)
  const int scw = cfg.scale_w(), scx = cfg.scale_x();
#define F_MFMA2(ai, bj, At, Bf, m) do { if ((ai) && !act1) break; _Pragma("unroll") for (int n = 0; n < 2; ++n) \
    acc[ai][bj][m][n] = __builtin_amdgcn_mfma_scale_f32_16x16x128_f8f6f4(Bf[n], At[m], acc[ai][bj][m][n], 0, 0, 0, scw, 0, scx); } while (0)
#define F_MMA(ai, bj, At, Bf) do { __builtin_amdgcn_s_setprio(1); _Pragma("unroll") for (int m = 0; m < 4; ++m) F_MFMA2(ai, bj, At, Bf, m); __builtin_amdgcn_s_setprio(0); } while (0)
#define F_MMA_STAGE(ai, bj, At, Bf, slot, Rs, half, kt) do { __builtin_amdgcn_s_setprio(1); \
    F_MFMA2(ai, bj, At, Bf, 0); G_SCHED(); F_WAIT_B(2, Rs); F_WRITE_B4(slot, Rs, 0); G_SCHED(); \
    F_MFMA2(ai, bj, At, Bf, 1); G_SCHED(); F_WRITE_B4(slot, Rs, 1); G_SCHED(); \
    F_MFMA2(ai, bj, At, Bf, 2); G_SCHED(); F_LOAD_B4(Rs, half, kt, 0); G_SCHED(); \
    F_MFMA2(ai, bj, At, Bf, 3); G_SCHED(); F_LOAD_B4(Rs, half, kt, 1); \
    __builtin_amdgcn_s_setprio(0); } while (0)
  f32x4 R[8];
  {
    F_STAGE_A(F_SA(0, 0), 0, 0); F_STAGE_A(F_SA(0, 1), 1, 0); F_STAGE_A(F_SA(1, 0), 0, 1);
    f32x4 X0[8], X1[8], X2[8];
    F_LOAD_B(X0, 1, 0); F_LOAD_B(X1, 0, 0); F_LOAD_B(X2, 1, 1); F_LOAD_B(R, 0, 1);
    F_WAIT_B(8, X0); F_WAIT_B(8, X1); F_WAIT_B(8, X2);
    F_WRITE_B(F_SB(0, 1), X0); F_WRITE_B(F_SB(0, 0), X1); F_WRITE_B(F_SB(1, 1), X2);
    G_WAIT_L0();
    G_BAR();
  }
  f32x4 acc[2][2][4][2];
#pragma unroll
  for (int a = 0; a < 2; ++a)
#pragma unroll
    for (int b = 0; b < 2; ++b)
#pragma unroll
      for (int m = 0; m < 4; ++m)
#pragma unroll
        for (int n = 0; n < 2; ++n) acc[a][b][m][n] = (f32x4){0.f, 0.f, 0.f, 0.f};
  i32x8 At[4], B0[2], B1[2];
  if (wr == 1) G_BAR();
#pragma clang loop unroll(disable)
  for (int t = 0; t < nt; t += 2) {
    const int t1 = t + 1;
    const int t2 = (t + 2 < nt) ? t + 2 : 0;
    const int t3 = (t + 2 < nt) ? t + 3 : 1;
    F_LDB(B0, F_SB(0, 0)); F_LDA(At, F_SA(0, 0)); F_STAGE_A(F_SA(1, 1), 1, t1);
    G_BAR(); G_WAIT_L0(); G_SCHED(); F_MMA(0, 0, At, B0); G_BAR(); G_SCHED();
    F_LDB(B1, F_SB(0, 1));
    G_BAR(); G_WAIT_L0(); G_SCHED(); F_MMA_STAGE(0, 1, At, B1, F_SB(1, 0), R, 1, t2); G_BAR(); G_SCHED();
    F_LDA(At, F_SA(0, 1)); F_STAGE_A(F_SA(0, 0), 0, t2);
    G_BAR(); G_WAIT_L0(); G_SCHED(); F_MMA(1, 1, At, B1); G_BAR(); G_SCHED();
    F_LDB(B0, F_SB(0, 0));
    G_BAR(); G_WAIT_L0(); G_SCHED(); F_MMA_STAGE(1, 0, At, B0, F_SB(0, 1), R, 0, t2); G_BAR(); G_SCHED();
    F_LDB(B0, F_SB(1, 0)); F_LDA(At, F_SA(1, 0)); F_STAGE_A(F_SA(0, 1), 1, t2);
    G_BAR(); G_WAIT_L0(); G_SCHED(); F_MMA(0, 0, At, B0); G_BAR(); G_SCHED();
    F_LDB(B1, F_SB(1, 1));
    G_BAR(); G_WAIT_L0(); G_SCHED(); F_MMA_STAGE(0, 1, At, B1, F_SB(0, 0), R, 1, t3); G_BAR(); G_SCHED();
    F_LDA(At, F_SA(1, 1)); F_STAGE_A(F_SA(1, 0), 0, t3);
    G_BAR(); G_WAIT_L0(); G_SCHED(); F_MMA(1, 1, At, B1); G_BAR(); G_SCHED();
    F_LDB(B0, F_SB(1, 0));
    G_BAR(); G_WAIT_L0(); G_SCHED(); F_MMA_STAGE(1, 0, At, B0, F_SB(1, 1), R, 0, t3); G_BAR(); G_SCHED();
  }
  F_WAIT_B(0, R); G_SCHED();
  if (wr == 0) G_BAR();
  {
    const int wid2 = wid, ln2 = lane_id_now(), wr2 = wid2 >> 2, wc2 = wid2 & 3, fr2 = ln2 & 15, fq2 = ln2 >> 4;
#pragma unroll
    for (int ai = 0; ai < 2; ++ai)
#pragma unroll
      for (int m = 0; m < 4; ++m)
#pragma unroll
        for (int bj = 0; bj < 2; ++bj)
          cfg.epi(ai * 128 + wr2 * 64 + m * 16 + fr2, bj, wc2, fq2, acc[ai][bj][m][0], acc[ai][bj][m][1]);
  }
  G_BAR();
#undef F_STAGE_A
#undef F_LOAD_B4
#undef F_LOAD_B
#undef F_WRITE_B4
#undef F_WRITE_B
#undef F_WAIT_B
#undef F_LDA
#undef F_LDB
#undef F_MFMA2
#undef F_MMA
#undef F_MMA_STAGE
}

template <class Cfg>
DI void gemm256dma_unit(LDS_AS unsigned char* lds, const Cfg& cfg) {
  const int tid = OPAQUE_TID(cfg.p), wid = __builtin_amdgcn_readfirstlane(tid >> 6), lane = tid & 63, wr = wid >> 2, wc = wid & 3, fr = lane & 15, fq = lane >> 4;
  const int nt = cfg.nkt();
  unsigned voffA[2][2], voffB[2][2];
#pragma unroll
  for (int i = 0; i < 2; ++i) {
    int R, C; stage_rc(tid * 16 + i * 8192, R, C);
    voffA[0][i] = cfg.a_rowoff(R) + (unsigned)C * 2u;
    voffA[1][i] = cfg.a_rowoff(128 + R) + (unsigned)C * 2u;
    voffB[0][i] = cfg.bt_rowoff(0, R) + (unsigned)C * 2u;
    voffB[1][i] = cfg.bt_rowoff(1, R) + (unsigned)C * 2u;
  }
  const __amdgpu_buffer_rsrc_t rsA = __builtin_amdgcn_make_buffer_rsrc((void*)cfg.a_base(), 0, cfg.a_bytes(), 0x00020000);
  const __amdgpu_buffer_rsrc_t rsB = __builtin_amdgcn_make_buffer_rsrc((void*)cfg.bt_base(), 0, cfg.bt_bytes(), 0x00020000);
  const unsigned ldsw = (unsigned)__builtin_amdgcn_readfirstlane((int)(unsigned)(size_t)lds) + (unsigned)wid * 1024u;
#define D_STAGE(rs, voff, slot, half, kt) do { _Pragma("unroll") for (int _i = 0; _i < 2; ++_i) { const unsigned _m0 = ldsw + (unsigned)((slot) + _i * 8192); const unsigned _so = (unsigned)(kt) * 128u; \
    asm volatile("s_mov_b32 m0, %0\n\ts_nop 4\n\tbuffer_load_dwordx4 %1, %2, %3 offen lds" :: "s"(_m0), "v"(voff[half][_i]), "s"(rs), "s"(_so) : "m0", "memory"); } } while (0)
#define D_STAGE_A(slot, half, kt) D_STAGE(rsA, voffA, slot, half, kt)
#define D_STAGE_B(slot, half, kt) D_STAGE(rsB, voffB, slot, half, kt)
  const int aoff = lds_byte(wr * 64 + fr, fq * 8), boff = lds_byte(wc * 32 + fr, fq * 8);
#define D_LDA(dst, slot) do { _Pragma("unroll") for (int m = 0; m < 4; ++m) _Pragma("unroll") for (int k = 0; k < 2; ++k) \
    dst[m][k] = *(const LDS_AS bf16x8*)(lds + (slot) + aoff + m * 2048 + k * 1024); } while (0)
#define D_LDB(dst, slot) do { _Pragma("unroll") for (int n = 0; n < 2; ++n) _Pragma("unroll") for (int k = 0; k < 2; ++k) \
    dst[n][k] = *(const LDS_AS bf16x8*)(lds + (slot) + boff + n * 2048 + k * 1024); } while (0)
#define D_MMA(ai, bj, At, Bf) do { __builtin_amdgcn_s_setprio(1); _Pragma("unroll") for (int m = 0; m < 4; ++m) _Pragma("unroll") for (int n = 0; n < 2; ++n) _Pragma("unroll") for (int k = 0; k < 2; ++k) \
    acc[ai][bj][m][n] = __builtin_amdgcn_mfma_f32_16x16x32_bf16(Bf[n][k], At[m][k], acc[ai][bj][m][n], 0, 0, 0); __builtin_amdgcn_s_setprio(0); } while (0)
#define D_WAIT_L(n) asm volatile("s_waitcnt lgkmcnt(" #n ")" ::: "memory")
  f32x4 acc[2][2][4][2];
#pragma unroll
  for (int a = 0; a < 2; ++a)
#pragma unroll
    for (int b = 0; b < 2; ++b)
#pragma unroll
      for (int m = 0; m < 4; ++m)
#pragma unroll
        for (int n = 0; n < 2; ++n) acc[a][b][m][n] = (f32x4){0.f, 0.f, 0.f, 0.f};
  bf16x8 At[4][2], B0[2][2], B1[2][2];
  D_STAGE_B(G_SB(0, 0), 0, 0); D_STAGE_A(G_SA(0, 0), 0, 0); D_STAGE_B(G_SB(0, 1), 1, 0); D_STAGE_A(G_SA(0, 1), 1, 0);
  if (wr == 1) G_BAR();
  G_WAIT_V(4); G_BAR();
  D_STAGE_B(G_SB(1, 0), 0, 1); D_STAGE_A(G_SA(1, 0), 0, 1); D_STAGE_B(G_SB(1, 1), 1, 1);
  G_WAIT_V(6); G_BAR();
#pragma clang loop unroll(disable)
  for (int t = 0; t < nt; t += 2) {
    const int t1 = t + 1;
    const int t2 = (t + 2 < nt) ? t + 2 : 0;
    const int t3 = (t + 2 < nt) ? t + 3 : 1;
    D_LDB(B0, G_SB(0, 0)); G_SCHED(); D_LDA(At, G_SA(0, 0)); D_STAGE_A(G_SA(1, 1), 1, t1);
    D_WAIT_L(8); G_BAR(); D_WAIT_L(0); G_SCHED(); D_MMA(0, 0, At, B0); G_BAR(); G_SCHED();
    D_LDB(B1, G_SB(0, 1)); D_STAGE_B(G_SB(0, 0), 0, t2);
    G_BAR(); D_WAIT_L(0); G_SCHED(); D_MMA(0, 1, At, B1); G_BAR(); G_SCHED();
    D_LDA(At, G_SA(0, 1)); D_STAGE_A(G_SA(0, 0), 0, t2);
    G_BAR(); D_WAIT_L(0); G_SCHED(); D_MMA(1, 0, At, B0); G_BAR(); G_SCHED();
    D_STAGE_B(G_SB(0, 1), 1, t2);
    G_WAIT_V(6); G_BAR(); G_SCHED(); D_MMA(1, 1, At, B1); G_BAR(); G_SCHED();
    D_LDB(B0, G_SB(1, 0)); G_SCHED(); D_LDA(At, G_SA(1, 0)); D_STAGE_A(G_SA(0, 1), 1, t2);
    D_WAIT_L(8); G_BAR(); D_WAIT_L(0); G_SCHED(); D_MMA(0, 0, At, B0); G_BAR(); G_SCHED();
    D_LDB(B1, G_SB(1, 1)); D_STAGE_B(G_SB(1, 0), 0, t3);
    G_BAR(); D_WAIT_L(0); G_SCHED(); D_MMA(0, 1, At, B1); G_BAR(); G_SCHED();
    D_LDA(At, G_SA(1, 1)); D_STAGE_A(G_SA(1, 0), 0, t3);
    G_BAR(); D_WAIT_L(0); G_SCHED(); D_MMA(1, 0, At, B0); G_BAR(); G_SCHED();
    D_STAGE_B(G_SB(1, 1), 1, t3);
    G_WAIT_V(6); G_BAR(); G_SCHED(); D_MMA(1, 1, At, B1); G_BAR(); G_SCHED();
  }
  G_WAIT_V(0);
  if (wr == 0) G_BAR();
  {
    const int wid2 = wid, ln2 = lane_id_now(), wr2 = wid2 >> 2, wc2 = wid2 & 3, fr2 = ln2 & 15, fq2 = ln2 >> 4;
#pragma unroll
    for (int ai = 0; ai < 2; ++ai)
#pragma unroll
      for (int m = 0; m < 4; ++m)
#pragma unroll
        for (int bj = 0; bj < 2; ++bj)
          cfg.epi(ai * 128 + wr2 * 64 + m * 16 + fr2, bj, wc2, fq2, acc[ai][bj][m][0], acc[ai][bj][m][1]);
  }
  G_BAR();
#undef D_STAGE
#undef D_STAGE_A
#undef D_STAGE_B
#undef D_LDA
#undef D_LDB
#undef D_MMA
#undef D_WAIT_L
}

#ifndef F8_PEEL
#define F8_PEEL 0
#endif
#ifndef EPI_HOIST
#define EPI_HOIST 1
#endif
template <class Cfg>
DI void f8dma_issue_prologue(LDS_AS unsigned char* lds, const Cfg& cfg) {
  const int tid = OPAQUE_TID(cfg.p), wid = __builtin_amdgcn_readfirstlane(tid >> 6), lane = tid & 63;
  unsigned voffA[2][2], voffB0;
#pragma unroll
  for (int i = 0; i < 2; ++i) {
    const int r = 8 * (wid + 8 * i) + (lane >> 3);
    const unsigned cofs = 16u * (((unsigned)lane & 7u) ^ (((unsigned)lane >> 3) & 7u));
    voffA[0][i] = cfg.a_rowoff(r) + cofs;
    voffA[1][i] = cfg.a_rowoff(128 + r) + cofs;
    if (i == 0) voffB0 = cfg.bt_rowoff(0, r) + cofs;
  }
  const unsigned bt_half = cfg.bt_rowoff(1, 0) - cfg.bt_rowoff(0, 0), bt_piece = cfg.bt_rowoff(0, 64) - cfg.bt_rowoff(0, 0);
  const __amdgpu_buffer_rsrc_t rsA = __builtin_amdgcn_make_buffer_rsrc((void*)cfg.a_base(), 0, cfg.a_bytes(), 0x00020000);
  const __amdgpu_buffer_rsrc_t rsB = __builtin_amdgcn_make_buffer_rsrc((void*)cfg.bt_base(), 0, cfg.bt_bytes(), 0x00020000);
  const unsigned ldsw = (unsigned)__builtin_amdgcn_readfirstlane((int)(unsigned)(size_t)lds) + (unsigned)wid * 1024u;
#define P_STAGE_A(slot, half, kt) do { _Pragma("unroll") for (int _i = 0; _i < 2; ++_i) { const unsigned _m0 = ldsw + (unsigned)((slot) + _i * 8192); const unsigned _so = (unsigned)(kt) * 128u; \
    asm volatile("s_mov_b32 m0, %0\n\ts_nop 4\n\tbuffer_load_dwordx4 %1, %2, %3 offen lds" :: "s"(_m0), "v"(voffA[half][_i]), "s"(rsA), "s"(_so) : "m0", "memory"); } } while (0)
#define P_STAGE_B(slot, half, kt) do { _Pragma("unroll") for (int _i = 0; _i < 2; ++_i) { const unsigned _m0 = ldsw + (unsigned)((slot) + _i * 8192); const unsigned _so = (unsigned)(kt) * 128u + (half) * bt_half + _i * bt_piece; \
    asm volatile("s_mov_b32 m0, %0\n\ts_nop 4\n\tbuffer_load_dwordx4 %1, %2, %3 offen lds" :: "s"(_m0), "v"(voffB0), "s"(rsB), "s"(_so) : "m0", "memory"); } } while (0)
  P_STAGE_B(G_SB(0, 0), 0, 0); P_STAGE_A(G_SA(0, 0), 0, 0); P_STAGE_B(G_SB(0, 1), 1, 0); P_STAGE_A(G_SA(0, 1), 1, 0);
  P_STAGE_B(G_SB(1, 0), 0, 1); P_STAGE_A(G_SA(1, 0), 0, 1); P_STAGE_B(G_SB(1, 1), 1, 1);
#undef P_STAGE_A
#undef P_STAGE_B
}
constexpr int F8_STASH = G256F8_LDS + 1024;
template <class Cfg>
DI void f8dma_issue_prologue_st(LDS_AS unsigned char* lds, const Cfg& cfg) {
  const int tid = OPAQUE_TID(cfg.p), wid = __builtin_amdgcn_readfirstlane(tid >> 6), lane = tid & 63;
  const LDS_AS unsigned* stash = (const LDS_AS unsigned*)(lds + F8_STASH);
  unsigned voffA[2][2], voffB0;
  voffA[0][0] = stash[tid]; voffA[0][1] = stash[512 + tid]; voffA[1][0] = stash[1024 + tid]; voffA[1][1] = stash[1536 + tid];
  {
    const int r = 8 * wid + (lane >> 3);
    const unsigned cofs = 16u * (((unsigned)lane & 7u) ^ (((unsigned)lane >> 3) & 7u));
    voffB0 = cfg.bt_rowoff(0, r) + cofs;
  }
  const unsigned bt_half = cfg.bt_rowoff(1, 0) - cfg.bt_rowoff(0, 0), bt_piece = cfg.bt_rowoff(0, 64) - cfg.bt_rowoff(0, 0);
  const __amdgpu_buffer_rsrc_t rsA = __builtin_amdgcn_make_buffer_rsrc((void*)cfg.a_base(), 0, cfg.a_bytes(), 0x00020000);
  const __amdgpu_buffer_rsrc_t rsB = __builtin_amdgcn_make_buffer_rsrc((void*)cfg.bt_base(), 0, cfg.bt_bytes(), 0x00020000);
  const unsigned ldsw = (unsigned)__builtin_amdgcn_readfirstlane((int)(unsigned)(size_t)lds) + (unsigned)wid * 1024u;
#define P_STAGE_A(slot, half, kt) do { _Pragma("unroll") for (int _i = 0; _i < 2; ++_i) { const unsigned _m0 = ldsw + (unsigned)((slot) + _i * 8192); const unsigned _so = (unsigned)(kt) * 128u; \
    asm volatile("s_mov_b32 m0, %0\n\ts_nop 4\n\tbuffer_load_dwordx4 %1, %2, %3 offen lds" :: "s"(_m0), "v"(voffA[half][_i]), "s"(rsA), "s"(_so) : "m0", "memory"); } } while (0)
#define P_STAGE_B(slot, half, kt) do { _Pragma("unroll") for (int _i = 0; _i < 2; ++_i) { const unsigned _m0 = ldsw + (unsigned)((slot) + _i * 8192); const unsigned _so = (unsigned)(kt) * 128u + (half) * bt_half + _i * bt_piece; \
    asm volatile("s_mov_b32 m0, %0\n\ts_nop 4\n\tbuffer_load_dwordx4 %1, %2, %3 offen lds" :: "s"(_m0), "v"(voffB0), "s"(rsB), "s"(_so) : "m0", "memory"); } } while (0)
  P_STAGE_B(G_SB(0, 0), 0, 0); P_STAGE_A(G_SA(0, 0), 0, 0); P_STAGE_B(G_SB(0, 1), 1, 0); P_STAGE_A(G_SA(0, 1), 1, 0);
  P_STAGE_B(G_SB(1, 0), 0, 1); P_STAGE_A(G_SA(1, 0), 0, 1); P_STAGE_B(G_SB(1, 1), 1, 1);
#undef P_STAGE_A
#undef P_STAGE_B
}
template <class Cfg, bool TOPHALF = false, bool PRE = false, int PMODE = 0>
DI void gemm256f8dma_unit(LDS_AS unsigned char* lds, const Cfg& cfg, bool has_nxt, const Cfg& nxt) {
  const int tid = OPAQUE_TID(cfg.p), wid = __builtin_amdgcn_readfirstlane(tid >> 6), lane = tid & 63, wr = wid >> 2, wc = wid & 3, fr = lane & 15, fq = lane >> 4;
  const int nt = PMODE == 2 ? cfg.nkt() / 2 : cfg.nkt();
  unsigned voffA[2][2], voffB0;
  {
    LDS_AS unsigned* stash = (LDS_AS unsigned*)(lds + F8_STASH);
    if (PRE) { voffA[0][0] = stash[tid]; voffA[0][1] = stash[512 + tid]; voffA[1][0] = stash[1024 + tid]; voffA[1][1] = stash[1536 + tid]; }
#pragma unroll
    for (int i = 0; i < 2; ++i) {
      const int r = 8 * (wid + 8 * i) + (lane >> 3);
      const unsigned cofs = 16u * (((unsigned)lane & 7u) ^ (((unsigned)lane >> 3) & 7u));
      if (!PRE) { voffA[0][i] = cfg.a_rowoff(r) + cofs; voffA[1][i] = cfg.a_rowoff(128 + r) + cofs; }
      if (i == 0) voffB0 = cfg.bt_rowoff(0, r) + cofs;
    }
    if (has_nxt) {
#pragma unroll
      for (int i = 0; i < 2; ++i) {
        const int r = 8 * (wid + 8 * i) + (lane >> 3);
        const unsigned cofs = 16u * (((unsigned)lane & 7u) ^ (((unsigned)lane >> 3) & 7u));
        stash[i * 512 + tid] = nxt.a_rowoff(r) + cofs;
        stash[(2 + i) * 512 + tid] = nxt.a_rowoff(128 + r) + cofs;
      }
    }
  }
  const unsigned bt_half = cfg.bt_rowoff(1, 0) - cfg.bt_rowoff(0, 0), bt_piece = cfg.bt_rowoff(0, 64) - cfg.bt_rowoff(0, 0);
  const __amdgpu_buffer_rsrc_t rsA = __builtin_amdgcn_make_buffer_rsrc((void*)cfg.a_base(), 0, cfg.a_bytes(), 0x00020000);
  const __amdgpu_buffer_rsrc_t rsB = __builtin_amdgcn_make_buffer_rsrc((void*)cfg.bt_base(), 0, cfg.bt_bytes(), 0x00020000);
  const unsigned ldsw = (unsigned)__builtin_amdgcn_readfirstlane((int)(unsigned)(size_t)lds) + (unsigned)wid * 1024u;
#define D_STAGE(rs, voff, slot, half, kt) do { _Pragma("unroll") for (int _i = 0; _i < 2; ++_i) { const unsigned _m0 = ldsw + (unsigned)((slot) + _i * 8192); const unsigned _so = (unsigned)(kt) * 128u; \
    asm volatile("s_mov_b32 m0, %0\n\ts_nop 4\n\tbuffer_load_dwordx4 %1, %2, %3 offen lds" :: "s"(_m0), "v"(voff[half][_i]), "s"(rs), "s"(_so) : "m0", "memory"); } } while (0)
#define D_STAGE_A(slot, half, kt) D_STAGE(rsA, voffA, slot, half, kt)
#define D_STAGE_B(slot, half, kt) do { _Pragma("unroll") for (int _i = 0; _i < 2; ++_i) { const unsigned _m0 = ldsw + (unsigned)((slot) + _i * 8192); const unsigned _so = (unsigned)(kt) * 128u + (half) * bt_half + _i * bt_piece; \
    asm volatile("s_mov_b32 m0, %0\n\ts_nop 4\n\tbuffer_load_dwordx4 %1, %2, %3 offen lds" :: "s"(_m0), "v"(voffB0), "s"(rsB), "s"(_so) : "m0", "memory"); } } while (0)
  unsigned aoff[2], boff[2];
#pragma unroll
  for (int j = 0; j < 2; ++j) {
    aoff[j] = (unsigned)(64 * wr + fr) * 128u + 16u * ((2u * fq + j) ^ ((unsigned)fr & 7u));
    boff[j] = (unsigned)(32 * wc + fr) * 128u + 16u * ((2u * fq + j) ^ ((unsigned)fr & 7u));
  }
#define D_LDA(dst, slot) do { _Pragma("unroll") for (int m = 0; m < 4; ++m) { \
    const i32x4 _lo = *(const LDS_AS i32x4*)(lds + (slot) + aoff[0] + m * 2048); const i32x4 _hi = *(const LDS_AS i32x4*)(lds + (slot) + aoff[1] + m * 2048); \
    dst[m] = __builtin_shufflevector(_lo, _hi, 0, 1, 2, 3, 4, 5, 6, 7); } } while (0)
#define D_LDB(dst, slot) do { _Pragma("unroll") for (int n = 0; n < 2; ++n) { \
    const i32x4 _lo = *(const LDS_AS i32x4*)(lds + (slot) + boff[0] + n * 2048); const i32x4 _hi = *(const LDS_AS i32x4*)(lds + (slot) + boff[1] + n * 2048); \
    dst[n] = __builtin_shufflevector(_lo, _hi, 0, 1, 2, 3, 4, 5, 6, 7); } } while (0)
  const int scw = cfg.scale_w(), scx = cfg.scale_x();
#define D_MMA(ai, bj, At, Bf) do { if ((ai) && TOPHALF) break; __builtin_amdgcn_s_setprio(1); _Pragma("unroll") for (int m = 0; m < 4; ++m) _Pragma("unroll") for (int n = 0; n < 2; ++n) \
    acc[ai][bj][m][n] = __builtin_amdgcn_mfma_scale_f32_16x16x128_f8f6f4(Bf[n], At[m], acc[ai][bj][m][n], 0, 0, 0, scw, 0, scx); __builtin_amdgcn_s_setprio(0); } while (0)
#define D_PIN(ai, bj) do { if ((ai) && TOPHALF) break; asm volatile("" : "+v"(acc[ai][bj][0][0]), "+v"(acc[ai][bj][0][1]), "+v"(acc[ai][bj][1][0]), "+v"(acc[ai][bj][1][1]), \
    "+v"(acc[ai][bj][2][0]), "+v"(acc[ai][bj][2][1]), "+v"(acc[ai][bj][3][0]), "+v"(acc[ai][bj][3][1])); } while (0)
#define D_WAIT_L(n) asm volatile("s_waitcnt lgkmcnt(" #n ")" ::: "memory")
  f32x4 acc[2][2][4][2];
#pragma unroll
  for (int a = 0; a < 2; ++a)
#pragma unroll
    for (int b = 0; b < 2; ++b)
#pragma unroll
      for (int m = 0; m < 4; ++m)
#pragma unroll
        for (int n = 0; n < 2; ++n) acc[a][b][m][n] = (f32x4){0.f, 0.f, 0.f, 0.f};
  i32x8 At[4], B0[2], B1[2];
  if (!PRE) {
    D_STAGE_B(G_SB(0, 0), 0, 0); D_STAGE_A(G_SA(0, 0), 0, 0); D_STAGE_B(G_SB(0, 1), 1, 0); D_STAGE_A(G_SA(0, 1), 1, 0);
    D_STAGE_B(G_SB(1, 0), 0, 1); D_STAGE_A(G_SA(1, 0), 0, 1); D_STAGE_B(G_SB(1, 1), 1, 1);
  }
  G_WAIT_V(0); G_BAR();
  if (wr == 1) G_BAR();
#pragma clang loop unroll(disable)
  for (int t = 0; t < (F8_PEEL ? nt - 2 : nt); t += 2) {
    const int t1 = t + 1;
    const int t2 = (F8_PEEL || t + 2 < nt) ? t + 2 : t;
    const int t3 = (F8_PEEL || t + 2 < nt) ? t + 3 : t + 1;
    D_LDB(B0, G_SB(0, 0)); G_SCHED(); D_LDA(At, G_SA(0, 0)); D_STAGE_A(G_SA(1, 1), 1, t1);
    D_WAIT_L(8); G_BAR(); D_WAIT_L(0); G_SCHED(); D_MMA(0, 0, At, B0); G_BAR(); G_SCHED();
    D_LDB(B1, G_SB(0, 1)); D_STAGE_B(G_SB(0, 0), 0, t2);
    G_BAR(); D_WAIT_L(0); G_SCHED(); D_MMA(0, 1, At, B1); G_BAR(); G_SCHED();
    D_LDA(At, G_SA(0, 1)); D_STAGE_A(G_SA(0, 0), 0, t2);
    G_BAR(); D_WAIT_L(0); G_SCHED(); D_MMA(1, 0, At, B0); G_BAR(); G_SCHED();
    D_STAGE_B(G_SB(0, 1), 1, t2);
    G_WAIT_V(6); G_BAR(); G_SCHED(); D_MMA(1, 1, At, B1); G_BAR(); G_SCHED();
    D_LDB(B0, G_SB(1, 0)); G_SCHED(); D_LDA(At, G_SA(1, 0)); D_STAGE_A(G_SA(0, 1), 1, t2);
    D_WAIT_L(8); G_BAR(); D_WAIT_L(0); G_SCHED(); D_MMA(0, 0, At, B0); G_BAR(); G_SCHED();
    D_LDB(B1, G_SB(1, 1)); D_STAGE_B(G_SB(1, 0), 0, t3);
    G_BAR(); D_WAIT_L(0); G_SCHED(); D_MMA(0, 1, At, B1); G_BAR(); G_SCHED();
    D_LDA(At, G_SA(1, 1)); D_STAGE_A(G_SA(1, 0), 0, t3);
    G_BAR(); D_WAIT_L(0); G_SCHED(); D_MMA(1, 0, At, B0); G_BAR(); G_SCHED();
    D_STAGE_B(G_SB(1, 1), 1, t3);
    G_WAIT_V(6); G_BAR(); G_SCHED(); D_MMA(1, 1, At, B1); G_BAR(); G_SCHED();
  }
  if (!F8_PEEL) G_WAIT_V(0);
  if (F8_PEEL) {
    D_LDB(B0, G_SB(0, 0)); G_SCHED(); D_LDA(At, G_SA(0, 0)); D_STAGE_A(G_SA(1, 1), 1, nt - 1);
    D_WAIT_L(8); G_BAR(); D_WAIT_L(0); G_SCHED(); D_MMA(0, 0, At, B0); D_PIN(0, 0); G_BAR(); G_SCHED();
    D_LDB(B1, G_SB(0, 1));
    G_BAR(); D_WAIT_L(0); G_SCHED(); D_MMA(0, 1, At, B1); D_PIN(0, 1); G_BAR(); G_SCHED();
    D_LDA(At, G_SA(0, 1));
    G_BAR(); D_WAIT_L(0); G_SCHED(); D_MMA(1, 0, At, B0); D_PIN(1, 0); G_BAR(); G_SCHED();
    G_WAIT_V(0); G_BAR(); G_SCHED(); D_MMA(1, 1, At, B1); D_PIN(1, 1); G_BAR(); G_SCHED();
    D_LDB(B0, G_SB(1, 0)); G_SCHED(); D_LDA(At, G_SA(1, 0));
    D_WAIT_L(8); G_BAR(); D_WAIT_L(0); G_SCHED(); D_MMA(0, 0, At, B0); D_PIN(0, 0); G_BAR(); G_SCHED();
    D_LDB(B1, G_SB(1, 1));
    G_BAR(); D_WAIT_L(0); G_SCHED(); D_MMA(0, 1, At, B1); D_PIN(0, 1); G_BAR(); G_SCHED();
    D_LDA(At, G_SA(1, 1));
    G_BAR(); D_WAIT_L(0); G_SCHED(); D_MMA(1, 0, At, B0); D_PIN(1, 0); G_BAR(); G_SCHED();
    G_BAR(); G_SCHED(); D_MMA(1, 1, At, B1); D_PIN(1, 1); G_BAR(); G_SCHED();
  }
  if (wr == 0) G_BAR();
  if (has_nxt) f8dma_issue_prologue_st(lds, nxt);
  {
    const int wid2 = wid, ln2 = lane_id_now(), wr2 = wid2 >> 2, wc2 = wid2 & 3, fr2 = ln2 & 15, fq2 = ln2 >> 4;
    if (PMODE == 0 && EPI_HOIST) {
      typename Cfg::RowTok tok[2][4];
#pragma unroll
      for (int ai = 0; ai < 2; ++ai)
#pragma unroll
        for (int m = 0; m < 4; ++m) tok[ai][m] = cfg.row_tok(ai * 128 + wr2 * 64 + m * 16 + fr2);
      typename Cfg::ColCtx cc[2];
#pragma unroll
      for (int bj = 0; bj < 2; ++bj) cc[bj] = cfg.col_ctx(bj, wc2, fq2);
#pragma unroll
      for (int ai = 0; ai < 2; ++ai)
#pragma unroll
        for (int m = 0; m < 4; ++m)
#pragma unroll
          for (int bj = 0; bj < 2; ++bj) cfg.epi_t(tok[ai][m], cc[bj], acc[ai][bj][m][0], acc[ai][bj][m][1]);
    } else if (PMODE == 0) {
#pragma unroll
      for (int ai = 0; ai < 2; ++ai)
#pragma unroll
        for (int m = 0; m < 4; ++m)
#pragma unroll
          for (int bj = 0; bj < 2; ++bj) cfg.epi(ai * 128 + wr2 * 64 + m * 16 + fr2, bj, wc2, fq2, acc[ai][bj][m][0], acc[ai][bj][m][1]);
    } else {
#pragma unroll
      for (int ai = 0; ai < 2; ++ai)
#pragma unroll
        for (int m = 0; m < 4; ++m)
#pragma unroll
          for (int bj = 0; bj < 2; ++bj) asm volatile("" :: "v"(acc[ai][bj][m][0]), "v"(acc[ai][bj][m][1]));
    }
  }
  if (!has_nxt) G_BAR();
#undef D_STAGE
#undef D_STAGE_A
#undef D_STAGE_B
#undef D_LDA
#undef D_LDB
#undef D_MMA
#undef D_WAIT_L
#undef D_PIN
}

DI void convert_tile(const float* W, int ldw, bf16_t* Wt, int K, int kt, int ntile, float* tl, int tid) {
  {
    const int r = tid >> 4, c4 = (tid & 15) * 4;
#pragma unroll
    for (int i = 0; i < 2; ++i) {
      const float4 v = *(const float4*)(W + (size_t)(kt * 64 + r + 32 * i) * ldw + ntile * 64 + c4);
      float* d = tl + (r + 32 * i) * 65 + c4;
      d[0] = v.x; d[1] = v.y; d[2] = v.z; d[3] = v.w;
    }
  }
  __syncthreads();
  {
    const int n = tid >> 3, kc = (tid & 7) * 8;
    uint4 o;
    o.x = pack2(tl[(kc + 0) * 65 + n], tl[(kc + 1) * 65 + n]); o.y = pack2(tl[(kc + 2) * 65 + n], tl[(kc + 3) * 65 + n]);
    o.z = pack2(tl[(kc + 4) * 65 + n], tl[(kc + 5) * 65 + n]); o.w = pack2(tl[(kc + 6) * 65 + n], tl[(kc + 7) * 65 + n]);
    *(uint4*)(Wt + (size_t)(ntile * 64 + n) * K + kt * 64 + kc) = o;
  }
  __syncthreads();
}
DI void phase_convert(const Params& p, char* smem, int bid, int nb) {
  float* tl = (float*)smem;
  const int tid = OPAQUE_TID(p);
  constexpr int U0 = 32 * 61, U1 = U0 + 32 * 32, U2 = U1 + 8 * 24, U3 = U2 + 4 * 32;
  const int nmine = bid < U3 ? (U3 - bid + nb - 1) / nb : 0;
  const int r = tid >> 4, c4 = (tid & 15) * 4;
  const int n = tid >> 3, kc = (tid & 7) * 8;
  f32x4 a[4][2];
#define DC_DECODE(i) \
    const int _u0 = bid + (i) * nb; const bool _ok = _u0 < U3; const int _u = __builtin_amdgcn_readfirstlane(_ok ? _u0 : U3 - 1); \
    const int _w = _u < U0 ? 0 : (_u < U1 ? 1 : (_u < U2 ? 2 : 3)); \
    const int _v = _u - (_w == 0 ? 0 : (_w == 1 ? U0 : (_w == 2 ? U1 : U2))); \
    const int _nn = _w == 0 ? 61 : (_w == 2 ? 24 : 32); \
    const int _kt = _w == 0 ? (int)((unsigned)_v / 61u) : (_w == 2 ? (int)((unsigned)_v / 24u) : (_v >> 5)), _nt = _v - _kt * _nn;     \
    const unsigned long long _m0 = _w == 0 ? ~0ull : 0ull, _m1 = _w == 1 ? ~0ull : 0ull, _m2 = _w == 2 ? ~0ull : 0ull, _m3 = _w == 3 ? ~0ull : 0ull;     \
    const float* _W = (const float*)(((unsigned long long)p.w_in & _m0) | ((unsigned long long)p.w_o & _m1) | ((unsigned long long)p.w_q_b & _m2) | ((unsigned long long)p.w_kv_b & _m3)); \
    const int _ldw = _w == 0 ? INP : (_w == 2 ? 1536 : 2048); \
    bf16_t* _Wt = (bf16_t*)(((unsigned long long)p.wt_in & _m0) | ((unsigned long long)p.wt_o & _m1) | ((unsigned long long)p.wt_q & _m2) | ((unsigned long long)p.wt_kv & _m3)); \
    const int _K = _w == 2 ? 512 : (_w == 3 ? 256 : 2048);
#define DC_LOAD(slot, i) do { DC_DECODE(i) (void)_Wt; (void)_K; \
    _Pragma("unroll") for (int _q = 0; _q < 2; ++_q) { const float* _src = _W + (size_t)(_kt * 64 + r + 32 * _q) * _ldw + _nt * 64 + c4; \
      asm volatile("global_load_dwordx4 %0, %1, off" : "=v"(a[slot][_q]) : "v"(_src) : "memory"); } } while (0)
#define DC_TILE(slot, i, N) do { \
    float* _tl = tl + (((slot) & 1) ? 64 * 65 : 0); \
    asm volatile("s_waitcnt vmcnt(" #N ")" : "+v"(a[slot][0]), "+v"(a[slot][1]) :: "memory");        \
    _Pragma("unroll") for (int _q = 0; _q < 2; ++_q) { float* d = _tl + (r + 32 * _q) * 65 + c4; d[0] = a[slot][_q][0]; d[1] = a[slot][_q][1]; d[2] = a[slot][_q][2]; d[3] = a[slot][_q][3]; } \
    unsigned char* _dst; { DC_DECODE(i) (void)_W; (void)_ldw; \
      _dst = _ok ? (unsigned char*)(_Wt + (size_t)(_nt * 64 + n) * _K + _kt * 64 + kc) : p.cvdump + (size_t)n * 128 + kc * 2; } \
    asm volatile("s_waitcnt lgkmcnt(0)" ::: "memory");        \
    __builtin_amdgcn_sched_barrier(0); \
    DC_LOAD(slot, (i) + 4); \
    __syncthreads(); \
    uint4 o; \
    o.x = pack2(_tl[(kc + 0) * 65 + n], _tl[(kc + 1) * 65 + n]); o.y = pack2(_tl[(kc + 2) * 65 + n], _tl[(kc + 3) * 65 + n]); \
    o.z = pack2(_tl[(kc + 4) * 65 + n], _tl[(kc + 5) * 65 + n]); o.w = pack2(_tl[(kc + 6) * 65 + n], _tl[(kc + 7) * 65 + n]); \
    { u32x4 _o = {o.x, o.y, o.z, o.w}; asm volatile("global_store_dwordx4 %0, %1, off\n\ts_nop 1" :: "v"(_dst), "v"(_o) : "memory"); }   \
  } while (0)
  DC_LOAD(0, 0); DC_LOAD(1, 1); DC_LOAD(2, 2); DC_LOAD(3, 3);
#pragma unroll 1
  DC_TILE(0, 0, 6); DC_TILE(1, 1, 6); DC_TILE(2, 2, 6); DC_TILE(3, 3, 6);
  for (int i0 = 4; i0 < nmine; i0 += 4) { DC_TILE(0, i0, 6); DC_TILE(1, i0 + 1, 6); DC_TILE(2, i0 + 2, 6); DC_TILE(3, i0 + 3, 6); }
  asm volatile("s_waitcnt vmcnt(0)" : "+v"(a[0][0]), "+v"(a[0][1]), "+v"(a[1][0]), "+v"(a[1][1]), "+v"(a[2][0]), "+v"(a[2][1]), "+v"(a[3][0]), "+v"(a[3][1]) :: "memory");
#undef DC_TILE
#undef DC_LOAD
#undef DC_DECODE
  __syncthreads();
  for (int i = bid * NTHREADS + tid; i < 192 * 256; i += nb * NTHREADS) *(uint4*)(p.wt_in + (size_t)3904 * 2048 + (size_t)i * 8) = make_uint4(0u, 0u, 0u, 0u);
}


#define CVX_E(t) ((t) < 16384 ? ((t) >> 9) : (((t) - 16384) >> 10))
#define CVX_R(t) ((t) < 16384 ? (1024 + ((t) & 511)) : (((t) - 16384) & 1023))
DI void cvx_addr(const Params& p, int t, const float*& W, int& ldw, unsigned char*& Wq, int& kt, int& ntile) {
  const int e = CVX_E(t), r = CVX_R(t);
  if (r < 1024) { W = p.w_gate_up + (size_t)e * 2048 * 4096; ldw = 4096; Wq = p.wq1 + (size_t)e * 4096 * 2048; kt = r >> 6; ntile = r & 63; }
  else { const int q = r - 1024; W = p.w_down + (size_t)e * 2048 * 2048; ldw = 2048; Wq = p.wq2 + (size_t)e * 2048 * 2048; kt = q >> 5; ntile = q & 31; }
}
DI void cvx_load(const Params& p, int t, int r, int c4, float4 (&v)[4]) {
  if (t < 32 * 1536) {
    const float* W; int ldw, kt, ntile; unsigned char* Wq;
    cvx_addr(p, t, W, ldw, Wq, kt, ntile);
#pragma unroll
    for (int i = 0; i < 4; ++i) { const f32x4 q = __builtin_nontemporal_load((const f32x4*)(W + (size_t)(kt * 128 + r + 32 * i) * ldw + ntile * 64 + c4)); v[i] = make_float4(q[0], q[1], q[2], q[3]); }
  } else {
#pragma unroll
    for (int i = 0; i < 4; ++i) v[i] = make_float4(0.f, 0.f, 0.f, 0.f);
  }
}
DI void cvx_store(const Params& p, int t, int tid, int r, int c4, const float4 (&v)[4], float* tl) {
  if (t >= 32 * 1536) { __syncthreads(); return; }
  const float* W; int ldw, kt, ntile; unsigned char* Wq;
  cvx_addr(p, t, W, ldw, Wq, kt, ntile);
#pragma unroll
  for (int i = 0; i < 4; ++i) {
    float* d = tl + (r + 32 * i) * 65 + c4;
    d[0] = v[i].x * 512.f; d[1] = v[i].y * 512.f; d[2] = v[i].z * 512.f; d[3] = v[i].w * 512.f;
  }
  __syncthreads();
  {
    const int n = tid & 63, kc = (tid >> 6) * 16;
    uint4 o;
    o.x = (unsigned)pack4_fp8(tl[(kc + 0) * 65 + n], tl[(kc + 1) * 65 + n], tl[(kc + 2) * 65 + n], tl[(kc + 3) * 65 + n]);
    o.y = (unsigned)pack4_fp8(tl[(kc + 4) * 65 + n], tl[(kc + 5) * 65 + n], tl[(kc + 6) * 65 + n], tl[(kc + 7) * 65 + n]);
    o.z = (unsigned)pack4_fp8(tl[(kc + 8) * 65 + n], tl[(kc + 9) * 65 + n], tl[(kc + 10) * 65 + n], tl[(kc + 11) * 65 + n]);
    o.w = (unsigned)pack4_fp8(tl[(kc + 12) * 65 + n], tl[(kc + 13) * 65 + n], tl[(kc + 14) * 65 + n], tl[(kc + 15) * 65 + n]);
    *(uint4*)(Wq + (size_t)(ntile * 64 + n) * 2048 + kt * 128 + kc) = o;
  }
}
DI void convert_chunk(const Params& p, char* smem, int bid, int nb, int slot, const int CVX_SLOTS) {
  float* tl = (float*)smem;
  const int tid = OPAQUE_TID(p);
  const int r = tid >> 4, c4 = (tid & 15) * 4;
  constexpr int NT = 32 * 1536;
  const int nper = (NT + nb - 1) / nb;
  const int i0 = nper * slot / CVX_SLOTS, i1 = nper * (slot + 1) / CVX_SLOTS;
#define CVX_T(i) ((i) < i1 ? bid + (i) * nb : NT)
  float4 a0[4], a1[4], a2[4], a3[4];
  cvx_load(p, CVX_T(i0), r, c4, a0); cvx_load(p, CVX_T(i0 + 1), r, c4, a1); cvx_load(p, CVX_T(i0 + 2), r, c4, a2); cvx_load(p, CVX_T(i0 + 3), r, c4, a3);
#pragma unroll 1
  for (int i = i0; i < i1; i += 4) {
    float4 b0[4], b1[4], b2[4], b3[4];
    cvx_load(p, CVX_T(i + 4), r, c4, b0); cvx_load(p, CVX_T(i + 5), r, c4, b1); cvx_load(p, CVX_T(i + 6), r, c4, b2); cvx_load(p, CVX_T(i + 7), r, c4, b3);
    cvx_store(p, CVX_T(i), tid, r, c4, a0, tl);
    cvx_store(p, CVX_T(i + 1), tid, r, c4, a1, tl + 128 * 65);
    cvx_store(p, CVX_T(i + 2), tid, r, c4, a2, tl);
    cvx_store(p, CVX_T(i + 3), tid, r, c4, a3, tl + 128 * 65);
#pragma unroll
    for (int k = 0; k < 4; ++k) { a0[k] = b0[k]; a1[k] = b1[k]; a2[k] = b2[k]; a3[k] = b3[k]; }
  }
#undef CVX_T
  __syncthreads();
}

template <int NS, bool STREAM_ONLY = false>
DI void convert_experts_dma(const Params& p, LDS_AS unsigned char* lds, int bid, int nb) {
  const int tid = OPAQUE_TID(p), wid = __builtin_amdgcn_readfirstlane(tid >> 6), lane = tid & 63;
  constexpr int NT = 32 * 1536;
  const int nvalid = bid < NT / CVG ? CVG * ((NT / CVG - bid + nb - 1) / nb) : 0;
#define CVX_TILE_OF(i) ((bid + ((i) / CVG) * nb) * CVG + ((i) % CVG))
  const __amdgpu_buffer_rsrc_t rs1 = __builtin_amdgcn_make_buffer_rsrc((void*)p.w_gate_up, 0, 0x40000000u, 0x00020000);
  const __amdgpu_buffer_rsrc_t rs2 = __builtin_amdgcn_make_buffer_rsrc((void*)p.w_down, 0, 0x20000000u, 0x00020000);
  const __amdgpu_buffer_rsrc_t rs0 = __builtin_amdgcn_make_buffer_rsrc((void*)p.w_down, 0, 0u, 0x00020000);
  const unsigned vo1 = ((unsigned)lane >> 4) * 16384u + ((((unsigned)lane & 15u) ^ (unsigned)wid) << 4);
  const unsigned vo2 = ((unsigned)lane >> 4) * 8192u + ((((unsigned)lane & 15u) ^ (unsigned)wid) << 4);
  const unsigned ldsw = (unsigned)__builtin_amdgcn_readfirstlane((int)(unsigned)(size_t)lds) + (unsigned)wid * 4096u;
  const int n = 8 * wid + (lane >> 3), kc = lane & 7;
  const unsigned roff = (unsigned)kc * 4096u + ((((unsigned)n >> 2) ^ (unsigned)kc) << 4) + (((unsigned)n & 3u) << 2);
#define CVD_ISSUE(i, slot) do { \
    const int _t = __builtin_amdgcn_readfirstlane(CVX_TILE_OF(i)); const bool _ok = (i) < nvalid; \
    const int _e = CVX_E(_t), _r = CVX_R(_t); const bool _gu = _r < 1024; \
    const int _kt = _gu ? (_r >> 6) : ((_r - 1024) >> 5), _nt = _gu ? (_r & 63) : ((_r - 1024) & 31); \
    const unsigned _ldw = _gu ? 16384u : 8192u; \
    const unsigned _so = (unsigned)(_e * 2048 + _kt * 128 + wid * 16) * _ldw + (unsigned)_nt * 256u; \
    const unsigned _vo = _gu ? vo1 : vo2; \
    const unsigned _mb = ldsw + (unsigned)(slot) * 32768u; \
    if (!_ok) { _Pragma("unroll") for (int _q = 0; _q < 4; ++_q) asm volatile("s_mov_b32 m0, %0\n\ts_nop 4\n\tbuffer_load_dwordx4 %1, %2, %3 offen lds" :: "s"(_mb + _q * 1024u), "v"(_vo), "s"(rs0), "s"(0u) : "m0", "memory"); } \
    else if (_gu) { _Pragma("unroll") for (int _q = 0; _q < 4; ++_q) asm volatile("s_mov_b32 m0, %0\n\ts_nop 4\n\tbuffer_load_dwordx4 %1, %2, %3 offen lds" :: "s"(_mb + _q * 1024u), "v"(_vo), "s"(rs1), "s"(_so + _q * 4u * _ldw) : "m0", "memory"); } \
    else { _Pragma("unroll") for (int _q = 0; _q < 4; ++_q) asm volatile("s_mov_b32 m0, %0\n\ts_nop 4\n\tbuffer_load_dwordx4 %1, %2, %3 offen lds" :: "s"(_mb + _q * 1024u), "v"(_vo), "s"(rs2), "s"(_so + _q * 4u * _ldw) : "m0", "memory"); } \
  } while (0)
  CVD_ISSUE(0, 0); CVD_ISSUE(1, 1); CVD_ISSUE(2, 2);
  if (NS == 5) CVD_ISSUE(3, 3);
  int si = 0;
#pragma unroll 1
  for (int i = 0; i < nvalid; ++i) {
    if (NS == 4) asm volatile("s_waitcnt vmcnt(8)" ::: "memory");
    else asm volatile("s_waitcnt vmcnt(12)" ::: "memory");
    __builtin_amdgcn_s_barrier();
    __builtin_amdgcn_sched_barrier(0);
    const int sp = si == 0 ? NS - 1 : si - 1;
    CVD_ISSUE(i + NS - 1, sp);
    const int t = __builtin_amdgcn_readfirstlane(CVX_TILE_OF(i));
    const int e = CVX_E(t), r = CVX_R(t); const bool gu = r < 1024;
    const int kt = gu ? (r >> 6) : ((r - 1024) >> 5), ntile = gu ? (r & 63) : ((r - 1024) & 31);
    unsigned char* Wq = gu ? p.wq1 + (size_t)e * 4096 * 2048 : p.wq2 + (size_t)e * 2048 * 2048;
    if (!STREAM_ONLY) {
    const LDS_AS float* src = (const LDS_AS float*)(lds + (unsigned)si * 32768u + roff);
    float v[16];
#pragma unroll
    for (int j = 0; j < 16; ++j) v[j] = src[j * 64] * 512.f;
    uint4 o;
    o.x = (unsigned)pack4_fp8(v[0], v[1], v[2], v[3]); o.y = (unsigned)pack4_fp8(v[4], v[5], v[6], v[7]);
    o.z = (unsigned)pack4_fp8(v[8], v[9], v[10], v[11]); o.w = (unsigned)pack4_fp8(v[12], v[13], v[14], v[15]);
    *(uint4*)(Wq + (size_t)(ntile * 64 + n) * 2048 + kt * 128 + kc * 16) = o;
    }
    si = si == NS - 1 ? 0 : si + 1;
    __builtin_amdgcn_sched_barrier(0);
  }
#undef CVD_ISSUE
  asm volatile("s_waitcnt vmcnt(0)" ::: "memory");
  __syncthreads();
}

DI void convert_experts_wave(const Params& p, LDS_AS unsigned char* lds, int bid, int nb) {
  const int tid = OPAQUE_TID(p), wid = __builtin_amdgcn_readfirstlane(tid >> 6), lane = tid & 63;
  constexpr int NT = 32 * 1536;
  const int nvalid = bid < NT / CVG ? CVG * ((NT / CVG - bid + nb - 1) / nb) : 0;
  const __amdgpu_buffer_rsrc_t rs1 = __builtin_amdgcn_make_buffer_rsrc((void*)p.w_gate_up, 0, 0x40000000u, 0x00020000);
  const __amdgpu_buffer_rsrc_t rs2 = __builtin_amdgcn_make_buffer_rsrc((void*)p.w_down, 0, 0x20000000u, 0x00020000);
  const __amdgpu_buffer_rsrc_t rs0 = __builtin_amdgcn_make_buffer_rsrc((void*)p.w_down, 0, 0u, 0x00020000);
  const unsigned vo1 = ((unsigned)lane >> 4) * 16384u + (((unsigned)lane & 15u) << 4);
  const unsigned vo2 = ((unsigned)lane >> 4) * 8192u + (((unsigned)lane & 15u) << 4);
  const unsigned ldsw = (unsigned)__builtin_amdgcn_readfirstlane((int)(unsigned)(size_t)lds) + (unsigned)wid * 16384u;
  LDS_AS unsigned char* ring = lds + (unsigned)wid * 16384u + (unsigned)lane * 4u;
#define CVW_ISSUE(i) do { \
    const int _t = __builtin_amdgcn_readfirstlane(CVX_TILE_OF(i)); const bool _ok = (i) < nvalid; \
    const int _e = CVX_E(_t), _r = CVX_R(_t); const bool _gu = _r < 1024; \
    const int _kt = _gu ? (_r >> 6) : ((_r - 1024) >> 5), _nt = _gu ? (_r & 63) : ((_r - 1024) & 31); \
    const unsigned _ldw = _gu ? 16384u : 8192u; \
    const unsigned _so = (unsigned)(_e * 2048 + _kt * 128 + wid * 16) * _ldw + (unsigned)_nt * 256u; \
    const unsigned _vo = _gu ? vo1 : vo2; \
    const unsigned _mb = ldsw + (unsigned)((i) & 3) * 4096u; \
    if (!_ok) { _Pragma("unroll") for (int _q = 0; _q < 4; ++_q) asm volatile("s_mov_b32 m0, %0\n\ts_nop 4\n\tbuffer_load_dwordx4 %1, %2, %3 offen lds" :: "s"(_mb + _q * 1024u), "v"(_vo), "s"(rs0), "s"(0u) : "m0", "memory"); } \
    else if (_gu) { _Pragma("unroll") for (int _q = 0; _q < 4; ++_q) asm volatile("s_mov_b32 m0, %0\n\ts_nop 4\n\tbuffer_load_dwordx4 %1, %2, %3 offen lds" :: "s"(_mb + _q * 1024u), "v"(_vo), "s"(rs1), "s"(_so + _q * 4u * _ldw) : "m0", "memory"); } \
    else { _Pragma("unroll") for (int _q = 0; _q < 4; ++_q) asm volatile("s_mov_b32 m0, %0\n\ts_nop 4\n\tbuffer_load_dwordx4 %1, %2, %3 offen lds" :: "s"(_mb + _q * 1024u), "v"(_vo), "s"(rs2), "s"(_so + _q * 4u * _ldw) : "m0", "memory"); } \
  } while (0)
  CVW_ISSUE(0); CVW_ISSUE(1); CVW_ISSUE(2);
#pragma unroll 1
  for (int i = 0; i < nvalid; ++i) {
    if (i < 3) asm volatile("s_waitcnt vmcnt(8)" ::: "memory"); else asm volatile("s_waitcnt vmcnt(11)" ::: "memory");
    __builtin_amdgcn_sched_barrier(0);
    CVW_ISSUE(i + 3);
    const int t = __builtin_amdgcn_readfirstlane(CVX_TILE_OF(i));
    const int e = CVX_E(t), r = CVX_R(t); const bool gu = r < 1024;
    const int kt = gu ? (r >> 6) : ((r - 1024) >> 5), ntile = gu ? (r & 63) : ((r - 1024) & 31);
    unsigned char* Wq = gu ? p.wq1 + (size_t)e * 4096 * 2048 : p.wq2 + (size_t)e * 2048 * 2048;
    const LDS_AS float* src = (const LDS_AS float*)(ring + (unsigned)(i & 3) * 4096u);
    float v[16];
#pragma unroll
    for (int j = 0; j < 16; ++j) v[j] = src[j * 64] * 512.f;
    uint4 o;
    o.x = (unsigned)pack4_fp8(v[0], v[1], v[2], v[3]); o.y = (unsigned)pack4_fp8(v[4], v[5], v[6], v[7]);
    o.z = (unsigned)pack4_fp8(v[8], v[9], v[10], v[11]); o.w = (unsigned)pack4_fp8(v[12], v[13], v[14], v[15]);
    *(uint4*)(Wq + (size_t)(ntile * 64 + lane) * 2048 + kt * 128 + wid * 16) = o;
    __builtin_amdgcn_sched_barrier(0);
  }
#undef CVW_ISSUE
  asm volatile("s_waitcnt vmcnt(0)" ::: "memory");
  __syncthreads();
}
DI void convert_experts_reg(const Params& p, LDS_AS unsigned char* lds, int bid, int nb) {
  const int tid = OPAQUE_TID(p), wid = __builtin_amdgcn_readfirstlane(tid >> 6), lane = tid & 63;
  constexpr int NT = 32 * 1536;
  const int nvalid = bid < NT / CVG ? CVG * ((NT / CVG - bid + nb - 1) / nb) : 0;
  const int r = tid >> 4, c = tid & 15;
  const unsigned vo1 = (unsigned)r * 16384u + (unsigned)c * 16u, vo2 = (unsigned)r * 8192u + (unsigned)c * 16u;
  const unsigned woff = (unsigned)r * 256u;
  const int n = 8 * wid + (lane >> 3), kc = lane & 7;
  const unsigned roff = (unsigned)kc * 4096u + ((((unsigned)n >> 2) ^ (unsigned)kc) << 4) + (((unsigned)n & 3u) << 2);
  f32x4 a[8][4];
#define CVR_LOAD(u, i) do { \
    const int _i = (i); const bool _ok = _i < nvalid; const int _t = __builtin_amdgcn_readfirstlane(_ok ? CVX_TILE_OF(_i) : 0); \
    const int _e = CVX_E(_t), _r = CVX_R(_t); const bool _gu = _r < 1024; \
    const int _kt = _gu ? (_r >> 6) : ((_r - 1024) >> 5), _nt = _gu ? (_r & 63) : ((_r - 1024) & 31); \
    const unsigned _ldw = _gu ? 16384u : 8192u; \
    const unsigned _so = (unsigned)(_e * 2048 + _kt * 128) * _ldw + (unsigned)_nt * 256u; \
    const unsigned _vo = _ok ? (_gu ? vo1 : vo2) : 0xFFFFFFF0u;            \
    const __amdgpu_buffer_rsrc_t _rs = __builtin_amdgcn_make_buffer_rsrc((void*)(_gu ? p.w_gate_up : p.w_down), 0, 0x40000000u, 0x00020000); \
    _Pragma("unroll") for (int _q = 0; _q < 4; ++_q) \
      asm volatile("buffer_load_dwordx4 %0, %1, %2, %3 offen" : "=v"(a[u][_q]) : "v"(_vo), "s"(_rs), "s"(_so + (unsigned)_q * 32u * _ldw) : "memory"); \
  } while (0)
#define CVR_TILE(u, i, N) do { \
    const int _ii = (i); \
    LDS_AS unsigned char* buf = lds + (unsigned)((u) & 1) * 32768u; \
    asm volatile("s_waitcnt vmcnt(" #N ")" : "+v"(a[u][0]), "+v"(a[u][1]), "+v"(a[u][2]), "+v"(a[u][3]) :: "memory"); \
    _Pragma("unroll") for (int q = 0; q < 4; ++q) \
      *(LDS_AS f32x4*)(buf + woff + (unsigned)q * 8192u + ((((unsigned)c) ^ (((unsigned)r >> 4) + 2u * q)) << 4)) = a[u][q]; \
    const bool ok = _ii < nvalid; \
    const int t = __builtin_amdgcn_readfirstlane(ok ? CVX_TILE_OF(_ii) : 0); \
    const int e = CVX_E(t), rr = CVX_R(t); const bool gu = rr < 1024; \
    const int kt = gu ? (rr >> 6) : ((rr - 1024) >> 5), ntile = gu ? (rr & 63) : ((rr - 1024) & 31); \
    unsigned char* Wq = gu ? p.wq1 + (size_t)e * 4096 * 2048 : p.wq2 + (size_t)e * 2048 * 2048; \
    unsigned char* dst = ok ? Wq + (size_t)(ntile * 64 + n) * 2048 + kt * 128 + kc * 16 : p.cvdump + (size_t)n * 2048 + kc * 16; \
    asm volatile("s_waitcnt lgkmcnt(0)" ::: "memory"); \
    __builtin_amdgcn_sched_barrier(0); \
    CVR_LOAD(u, _ii + 8); \
    __builtin_amdgcn_s_barrier();                   \
    __builtin_amdgcn_sched_barrier(0); \
    const LDS_AS float* src = (const LDS_AS float*)(buf + roff); \
    float v[16]; \
    _Pragma("unroll") for (int j = 0; j < 16; ++j) v[j] = src[j * 64] * 512.f; \
    u32x4 o; \
    o[0] = (unsigned)pack4_fp8(v[0], v[1], v[2], v[3]); o[1] = (unsigned)pack4_fp8(v[4], v[5], v[6], v[7]); \
    o[2] = (unsigned)pack4_fp8(v[8], v[9], v[10], v[11]); o[3] = (unsigned)pack4_fp8(v[12], v[13], v[14], v[15]); \
    asm volatile("global_store_dwordx4 %0, %1, off\n\ts_nop 1" :: "v"(dst), "v"(o) : "memory"); \
    __builtin_amdgcn_sched_barrier(0); \
  } while (0)
  CVR_LOAD(0, 0); CVR_LOAD(1, 1); CVR_LOAD(2, 2); CVR_LOAD(3, 3); CVR_LOAD(4, 4); CVR_LOAD(5, 5); CVR_LOAD(6, 6); CVR_LOAD(7, 7);
  CVR_TILE(0, 0, 28); CVR_TILE(1, 1, 29); CVR_TILE(2, 2, 30); CVR_TILE(3, 3, 31); CVR_TILE(4, 4, 32); CVR_TILE(5, 5, 33); CVR_TILE(6, 6, 34); CVR_TILE(7, 7, 35);
#pragma unroll 1
  for (int i0 = 8; i0 < nvalid; i0 += 8) {
    CVR_TILE(0, i0, 36); CVR_TILE(1, i0 + 1, 36); CVR_TILE(2, i0 + 2, 36); CVR_TILE(3, i0 + 3, 36);
    CVR_TILE(4, i0 + 4, 36); CVR_TILE(5, i0 + 5, 36); CVR_TILE(6, i0 + 6, 36); CVR_TILE(7, i0 + 7, 36);
  }
  asm volatile("s_waitcnt vmcnt(0)" : "+v"(a[0][0]), "+v"(a[0][1]), "+v"(a[0][2]), "+v"(a[0][3]), "+v"(a[1][0]), "+v"(a[1][1]), "+v"(a[1][2]), "+v"(a[1][3]) :: "memory");
  asm volatile("" : "+v"(a[2][0]), "+v"(a[2][1]), "+v"(a[2][2]), "+v"(a[2][3]), "+v"(a[3][0]), "+v"(a[3][1]), "+v"(a[3][2]), "+v"(a[3][3]) :: "memory");
  asm volatile("" : "+v"(a[4][0]), "+v"(a[4][1]), "+v"(a[4][2]), "+v"(a[4][3]), "+v"(a[5][0]), "+v"(a[5][1]), "+v"(a[5][2]), "+v"(a[5][3]) :: "memory");
  asm volatile("" : "+v"(a[6][0]), "+v"(a[6][1]), "+v"(a[6][2]), "+v"(a[6][3]), "+v"(a[7][0]), "+v"(a[7][1]), "+v"(a[7][2]), "+v"(a[7][3]) :: "memory");
#undef CVR_LOAD
#undef CVR_TILE
  __syncthreads();
}


#if DENSE_DMA
#define DENSE_UNIT(lds, cfg) gemm256dma_unit(lds, cfg)
#else
#define DENSE_UNIT(lds, cfg) gemm256_unit(lds, cfg)
#endif
DI void st_bf16x4(bf16_t* dst, const f32x4& v) { u32x2 pk; pk.x = pack2(v[0], v[1]); pk.y = pack2(v[2], v[3]); *(u32x2*)dst = pk; }
DI int tile_gc(int pn, int bj, int wc, int fq) { return pn * 256 + 128 * bj + 64 * (wc >> 1) + 16 * (wc & 1) + 4 * fq; }

struct CfgInProj {
  const Params& p; int pm, pn;
  static constexpr bool GU = false;
  DI int vrows() const { return 256; }
  DI const void* bt_base() const { return p.wt_in; }
  DI unsigned bt_bytes() const { return 4096u * 4096u; }
  DI unsigned bt_rowoff(int h, int R) const { return (unsigned)(pn * 256 + 128 * h + tcol_p64(R)) * 4096u; }
  DI int nkt() const { return 32; }
  DI const void* a_base() const { return p.h0b; }
  DI unsigned a_bytes() const { return (unsigned)NTOK * 4096u; }
  DI unsigned a_rowoff(int r) const { return (unsigned)(pm * 256 + r) * 4096u; }
  DI const float* b_base() const { return p.w_in; }
  DI unsigned b_bytes() const { return 2048u * (unsigned)INP * 4u; }
  DI int ldb() const { return INP; }
  DI int b_gcol(int h, int lc) const { return pn * 256 + 128 * h + lc; }
  DI void epi(int r, int bj, int wc, int fq, const f32x4& v0, const f32x4& v1) const {
    const int t = pm * 256 + r; const int gc = tile_gc(pn, bj, wc, fq);
    if (gc < 3072) { st_bf16x4(p.qkv + (size_t)t * 3072 + gc, v0); st_bf16x4(p.qkv + (size_t)t * 3072 + gc + 32, v1); }
    else if (gc < 3584) { st_bf16x4(p.qlat + (size_t)t * 512 + gc - 3072, v0); st_bf16x4(p.qlat + (size_t)t * 512 + gc - 3072 + 32, v1); }
    else if (gc < 3840) { st_bf16x4(p.kvlat + (size_t)t * 256 + gc - 3584, v0); st_bf16x4(p.kvlat + (size_t)t * 256 + gc - 3584 + 32, v1); }
    else if (gc < 3872) {
      const int i0 = gc - 3840; const int ps = p.pos[t];
      f32x4 a, b;
#pragma unroll
      for (int e = 0; e < 4; ++e) { float sn, cs; rope_sc(ps, i0 + e, sn, cs); a[e] = v0[e] * cs - v1[e] * sn; b[e] = v1[e] * cs + v0[e] * sn; }
      st_bf16x4(p.krope + (size_t)t * 64 + i0, a); st_bf16x4(p.krope + (size_t)t * 64 + i0 + 32, b);
    }
  }
};
DI void phase_in_proj(const Params& p, LDS_AS unsigned char* lds, char* smem, int bid, int nb) {
  for (int u = bid; u < 32 * 16; u += nb) {
    const int uu = __builtin_amdgcn_readfirstlane(u);
    CfgInProj cfg{p, uu >> 4, uu & 15};
    DENSE_UNIT(lds, cfg);
  }
}

DI void phase_norm_latents(const Params& p, int bid, int nb) {
  const int tid_ = OPAQUE_TID(p), lane = tid_ & 63, wv = tid_ >> 6;
  for (int t = bid * NWAVES + wv; t < NTOK; t += nb * NWAVES) {
    const uint4 a = *(const uint4*)(p.qlat + (size_t)t * 512 + lane * 8);
    float v[8] = {bflo(a.x), bfhi(a.x), bflo(a.y), bfhi(a.y), bflo(a.z), bfhi(a.z), bflo(a.w), bfhi(a.w)};
    float s = 0.f;
#pragma unroll
    for (int i = 0; i < 8; ++i) s += v[i] * v[i];
    s = wave_sum(s);
    const float rs = rsqrtf(s * (1.f / 512.f) + RMS_EPS);
    const float4 g0 = *(const float4*)(p.q_a_norm + lane * 8), g1 = *(const float4*)(p.q_a_norm + lane * 8 + 4);
    uint4 o;
    o.x = pack2(v[0] * rs * g0.x, v[1] * rs * g0.y); o.y = pack2(v[2] * rs * g0.z, v[3] * rs * g0.w);
    o.z = pack2(v[4] * rs * g1.x, v[5] * rs * g1.y); o.w = pack2(v[6] * rs * g1.z, v[7] * rs * g1.w);
    *(uint4*)(p.qn + (size_t)t * 512 + lane * 8) = o;
    const uint2 b = *(const uint2*)(p.kvlat + (size_t)t * 256 + lane * 4);
    float w[4] = {bflo(b.x), bfhi(b.x), bflo(b.y), bfhi(b.y)};
    float s2 = w[0] * w[0] + w[1] * w[1] + w[2] * w[2] + w[3] * w[3];
    s2 = wave_sum(s2);
    const float rs2 = rsqrtf(s2 * (1.f / 256.f) + RMS_EPS);
    const float4 g2 = *(const float4*)(p.kv_a_norm + lane * 4);
    uint2 o2;
    o2.x = pack2(w[0] * rs2 * g2.x, w[1] * rs2 * g2.y); o2.y = pack2(w[2] * rs2 * g2.z, w[3] * rs2 * g2.w);
    *(uint2*)(p.kvn + (size_t)t * 256 + lane * 4) = o2;
  }
}

struct CfgMlaQ {
  const Params& p; int pm, pn;
  static constexpr bool GU = false;
  DI int vrows() const { return 256; }
  DI const void* bt_base() const { return p.wt_q; }
  DI unsigned bt_bytes() const { return 1536u * 1024u; }
  DI unsigned bt_rowoff(int h, int R) const { return (unsigned)(pn * 256 + 128 * h + tcol_p64(R)) * 1024u; }
  DI int nkt() const { return 8; }
  DI const void* a_base() const { return p.qn; }
  DI unsigned a_bytes() const { return (unsigned)NTOK * 1024u; }
  DI unsigned a_rowoff(int r) const { return (unsigned)(pm * 256 + r) * 1024u; }
  DI const float* b_base() const { return p.w_q_b; }
  DI unsigned b_bytes() const { return 512u * 1536u * 4u; }
  DI int ldb() const { return 1536; }
  DI int b_gcol(int h, int lc) const { return pn * 256 + 128 * h + lc; }
  DI void epi(int r, int bj, int wc, int fq, const f32x4& v0, const f32x4& v1) const {
    const int t = pm * 256 + r; const int gc = tile_gc(pn, bj, wc, fq);
    f32x4 a = v0, b = v1;
    if (((gc >> 6) % 3) == 2) {
      const int i0 = gc & 31; const int ps = p.pos[t];
#pragma unroll
      for (int e = 0; e < 4; ++e) { float sn, cs; rope_sc(ps, i0 + e, sn, cs); a[e] = v0[e] * cs - v1[e] * sn; b[e] = v1[e] * cs + v0[e] * sn; }
    }
    st_bf16x4(p.mq + (size_t)t * 1536 + gc, a); st_bf16x4(p.mq + (size_t)t * 1536 + gc + 32, b);
  }
};
struct CfgMlaKV {
  const Params& p; int pm, pn;
  static constexpr bool GU = false;
  DI int vrows() const { return 256; }
  DI const void* bt_base() const { return p.wt_kv; }
  DI unsigned bt_bytes() const { return 2048u * 512u; }
  DI unsigned bt_rowoff(int h, int R) const { return (unsigned)(pn * 256 + 128 * h + tcol_p64(R)) * 512u; }
  DI int nkt() const { return 4; }
  DI const void* a_base() const { return p.kvn; }
  DI unsigned a_bytes() const { return (unsigned)NTOK * 512u; }
  DI unsigned a_rowoff(int r) const { return (unsigned)(pm * 256 + r) * 512u; }
  DI const float* b_base() const { return p.w_kv_b; }
  DI unsigned b_bytes() const { return 256u * 2048u * 4u; }
  DI int ldb() const { return 2048; }
  DI int b_gcol(int h, int lc) const { return pn * 256 + 128 * h + lc; }
  DI void epi(int r, int bj, int wc, int fq, const f32x4& v0, const f32x4& v1) const {
    const int t = pm * 256 + r; const int gc = tile_gc(pn, bj, wc, fq);
    st_bf16x4(p.mkv + (size_t)t * 2048 + gc, v0); st_bf16x4(p.mkv + (size_t)t * 2048 + gc + 32, v1);
  }
};
DI void phase_mla_proj(const Params& p, LDS_AS unsigned char* lds, char* smem, int bid, int nb) {
  for (int u = bid; u < 32 * 6; u += nb) {
    const int uu = __builtin_amdgcn_readfirstlane(u);
    CfgMlaQ cfg{p, uu / 6, uu % 6}; DENSE_UNIT(lds, cfg);
  }
  for (int u = nb - 1 - bid; u < 32 * 8; u += nb) {
    const int uu = __builtin_amdgcn_readfirstlane(u);
    CfgMlaKV cfg{p, uu >> 3, uu & 7}; DENSE_UNIT(lds, cfg);
  }
}

struct CfgWo {
  const Params& p; int pm, pn;
  static constexpr bool GU = false;
  DI int vrows() const { return 256; }
  DI const void* bt_base() const { return p.wt_o; }
  DI unsigned bt_bytes() const { return 2048u * 4096u; }
  DI unsigned bt_rowoff(int h, int R) const { return (unsigned)(pn * 256 + 128 * h + tcol_p64(R)) * 4096u; }
  DI int nkt() const { return 32; }
  DI const void* a_base() const { return p.on; }
  DI unsigned a_bytes() const { return (unsigned)NTOK * 4096u; }
  DI unsigned a_rowoff(int r) const { return (unsigned)(pm * 256 + r) * 4096u; }
  DI const float* b_base() const { return p.w_o; }
  DI unsigned b_bytes() const { return 2048u * 2048u * 4u; }
  DI int ldb() const { return 2048; }
  DI int b_gcol(int h, int lc) const { return pn * 256 + 128 * h + lc; }
  DI void epi(int r, int bj, int wc, int fq, const f32x4& v0, const f32x4& v1) const {
    const size_t o = (size_t)(pm * 256 + r) * 2048 + tile_gc(pn, bj, wc, fq);
    const u32x2 r0 = *(const u32x2*)(p.h0b + o), r1 = *(const u32x2*)(p.h0b + o + 32);
    const f32x4 h0 = {bflo(r0.x), bfhi(r0.x), bflo(r0.y), bfhi(r0.y)}, h1 = {bflo(r1.x), bfhi(r1.x), bflo(r1.y), bfhi(r1.y)};
    st_bf16x4(p.z1b + o, h0 * DN_ALPHA + v0);
    st_bf16x4(p.z1b + o + 32, h1 * DN_ALPHA + v1);
  }
};
template <int MODE = 0>
DI void phase_wo(const Params& p, LDS_AS unsigned char* lds, char* smem, int bid, int nb) {
  for (int u = bid; u < 32 * 8; u += nb) {
    const int uu = __builtin_amdgcn_readfirstlane(u);
    CfgWo cfg{p, uu >> 3, uu & 7};
    if (MODE == 0) DENSE_UNIT(lds, cfg); else gemm256_unit<CfgWo, MODE>(lds, cfg);
  }
}

struct MoeSched { int base[33]; int mt[32]; int cnt[32]; };
DI void moe_sched_build(const Params& p, MoeSched* s, int ntn, bool rev) {
  if (threadIdx.x == 0) {
    int acc = 0;
    for (int e = 0; e < 32; ++e) { const int c = p.cnt[(rev ? 31 - e : e) * 32]; const int m = (c + 255) >> 8; s->cnt[e] = c; s->mt[e] = m; s->base[e] = acc; acc += m * ntn; }
    s->base[32] = acc;
  }
  __syncthreads();
}
struct CfgMoe1 {
  const Params& p; int e, m0, tn, cnt;
  static constexpr bool GU = true;
  DI int vrows() const { return cnt - m0; }
  DI int nkt() const { return 32; }
  DI const void* a_base() const { return p.h1b; }
  DI unsigned a_bytes() const { return (unsigned)NTOK * 4096u; }
  DI unsigned a_rowoff(int r) const {
    int rr = m0 + r; rr = rr < cnt ? rr : cnt - 1;
    return (unsigned)(p.rowlist[e * 8192 + rr] >> 2) * 4096u;
  }
  DI const float* b_base() const { return p.w_gate_up + (size_t)e * 2048 * 4096; }
  DI unsigned b_bytes() const { return 2048u * 4096u * 4u; }
  DI int ldb() const { return 4096; }
  DI int b_gcol(int h, int lc) const { return (lc < 64 ? 0 : 2048 - 64) + tn * 128 + 64 * h + lc; }
  DI void epi(int r, int bj, int wc, int fq, const f32x4& v0, const f32x4& v1) const {
    const int rr = m0 + r;
    if (rr >= cnt) return;
    const int a = p.rowlist[e * 8192 + rr];
    const int j0 = tn * 128 + 64 * bj + 16 * wc + 4 * fq;
    const f32x4 bg = *(const f32x4*)(p.b_gate_up + e * 4096 + j0), bu = *(const f32x4*)(p.b_gate_up + e * 4096 + 2048 + j0);
    f32x4 o;
#pragma unroll
    for (int i = 0; i < 4; ++i) {
      const float g = fminf(v0[i] + bg[i], 7.f);
      const float up = fminf(fmaxf(v1[i] + bu[i], -7.f), 7.f);
      const float sg = 1.f / (1.f + __expf(-1.702f * g));
      o[i] = (up + 1.f) * (g * sg);
    }
    st_bf16x4(p.act + (size_t)a * 2048 + j0, o);
  }
};
struct CfgMoe2 {
  const Params& p; int e, m0, tn, cnt;
  static constexpr bool GU = false;
  DI int vrows() const { return cnt - m0; }
  DI int nkt() const { return 32; }
  DI const void* a_base() const { return p.act; }
  DI unsigned a_bytes() const { return (unsigned)NTOK * 4u * 4096u; }
  DI unsigned a_rowoff(int r) const {
    int rr = m0 + r; rr = rr < cnt ? rr : cnt - 1;
    return (unsigned)p.rowlist[e * 8192 + rr] * 4096u;
  }
  DI const float* b_base() const { return p.w_down + (size_t)e * 2048 * 2048; }
  DI unsigned b_bytes() const { return 2048u * 2048u * 4u; }
  DI int ldb() const { return 2048; }
  DI int b_gcol(int h, int lc) const { return tn * 256 + 128 * h + lc; }
  DI void epi(int r, int bj, int wc, int fq, const f32x4& v0, const f32x4& v1) const {
    const int rr = m0 + r;
    if (rr >= cnt) return;
    const int a = p.rowlist[e * 8192 + rr];
    const int gc = tile_gc(tn, bj, wc, fq);
    const float gt = p.gate[a];
    const f32x4 b0 = *(const f32x4*)(p.b_down + e * 2048 + gc), b1 = *(const f32x4*)(p.b_down + e * 2048 + gc + 32);
    st_bf16x4(p.yb + (size_t)a * 2048 + gc, (v0 + b0) * gt);
    st_bf16x4(p.yb + (size_t)a * 2048 + gc + 32, (v1 + b1) * gt);
  }
};
template <int MOE_HOT>
struct CfgMoe1F8T {
  const Params& p; int e, m0, tn, cnt;
  static constexpr bool GU = true;
#if 0
#elif 1
  DI const void* bt_base() const { return p.wq1 + (size_t)(MOE_HOT == 1 ? 0 : e) * 4096 * 2048; }
  DI unsigned bt_rowoff(int h, int R) const { return (unsigned)((((R >> 4) & 1) ? 2048 : 0) + (MOE_HOT == 1 ? 0 : tn) * 128 + 64 * h + 16 * (R >> 5) + (R & 15)) * 2048u; }
#elif 0
  DI const void* bt_base() const { return p.wq1 + (size_t)(e & 0) * 4096 * 2048; }
  DI unsigned bt_rowoff(int h, int R) const { return (unsigned)((((R >> 4) & 1) ? 2048 : 0) + (tn & 0) * 128 + 64 * h + 16 * (R >> 5) + (R & 15)) * 2048u; }
#else
  DI const void* bt_base() const { return p.wq1 + (size_t)e * 4096 * 2048; }
  DI unsigned bt_rowoff(int h, int R) const { return (unsigned)((((R >> 4) & 1) ? 2048 : 0) + tn * 128 + 64 * h + 16 * (R >> 5) + (R & 15)) * 2048u; }
#endif
  DI unsigned bt_bytes() const { return 4096u * 2048u; }
  DI int nkt() const { return 16; }
  DI float bmul() const { return 512.f; }
  DI int scale_w() const { return 0x76767676; }
  DI int scale_x() const { return 0x7B7B7B7B; }
  DI const void* a_base() const { return p.h1q; }
  DI unsigned a_bytes() const { return (unsigned)NTOK * 2048u; }
  DI unsigned a_rowoff(int r) const {
    int rr = m0 + r; rr = rr < cnt ? rr : cnt - 1;
    if (MOE_HOT == 2) return (unsigned)r * 2048u + 0u * (unsigned)p.rowlist[e * 8192 + rr];
    return (unsigned)(p.rowlist[e * 8192 + rr] >> 2) * 2048u;
  }
  DI const float* b_base() const { return p.w_gate_up + (size_t)e * 2048 * 4096; }
  DI unsigned b_bytes() const { return 2048u * 4096u * 4u; }
  DI int ldb() const { return 4096; }
  DI int b_gcol(int h, int lc) const { return (lc < 64 ? 0 : 2048 - 64) + tn * 128 + 64 * h + lc; }
  typedef int RowTok;
  struct ColCtx { int j0; f32x4 bg, bu; };
  DI RowTok row_tok(int r) const { const int rr = m0 + r; const int a = p.rowlist[e * 8192 + (rr < cnt ? rr : cnt - 1)]; return rr < cnt ? a : -1; }
  DI ColCtx col_ctx(int bj, int wc, int fq) const {
    ColCtx c; c.j0 = tn * 128 + 64 * bj + 16 * wc + 4 * fq;
    c.bg = *(const f32x4*)(p.b_gate_up + e * 4096 + c.j0); c.bu = *(const f32x4*)(p.b_gate_up + e * 4096 + 2048 + c.j0);
    return c;
  }
  DI void epi_t(RowTok a, const ColCtx& c, const f32x4& v0, const f32x4& v1) const {
    if (a < 0) return;
    float o[4];
#pragma unroll
    for (int i = 0; i < 4; ++i) {
      const float g = fminf(v0[i] + c.bg[i], 7.f);
      const float up = __builtin_amdgcn_fmed3f(v1[i] + c.bu[i], -7.f, 7.f);
      const float sg = __builtin_amdgcn_rcpf(1.f + __builtin_amdgcn_exp2f(g * (-1.702f * 1.44269504088896f)));
      o[i] = fmaf(up, 4.f, 4.f) * (g * sg);
    }
    *(int*)(p.actq + (size_t)a * 2048 + c.j0) = pack4_fp8(o[0], o[1], o[2], o[3]);
  }
  DI void epi(int r, int bj, int wc, int fq, const f32x4& v0, const f32x4& v1) const {
    const int rr = m0 + r;
    if (rr >= cnt) return;
    const int a = p.rowlist[e * 8192 + rr];
    const int j0 = tn * 128 + 64 * bj + 16 * wc + 4 * fq;
    const f32x4 bg = *(const f32x4*)(p.b_gate_up + e * 4096 + j0), bu = *(const f32x4*)(p.b_gate_up + e * 4096 + 2048 + j0);
    float o[4];
#pragma unroll
    for (int i = 0; i < 4; ++i) {
      const float g = fminf(v0[i] + bg[i], 7.f);
      const float up = fminf(fmaxf(v1[i] + bu[i], -7.f), 7.f);
      const float sg = 1.f / (1.f + __expf(-1.702f * g));
      o[i] = fminf(fmaxf((up + 1.f) * (g * sg) * 4.f, -440.f), 440.f);
    }
    *(int*)(p.actq + (size_t)a * 2048 + j0) = pack4_fp8(o[0], o[1], o[2], o[3]);
  }
};
typedef CfgMoe1F8T<0> CfgMoe1F8;
struct CfgMoe2F8 {
  const Params& p; int e, m0, tn, cnt;
  static constexpr bool GU = false;
  DI const void* bt_base() const { return p.wq2 + (size_t)e * 2048 * 2048; }
  DI unsigned bt_bytes() const { return 2048u * 2048u; }
  DI unsigned bt_rowoff(int h, int R) const { return (unsigned)(tn * 256 + 128 * h + tcol_p64(R)) * 2048u; }
  DI int nkt() const { return 16; }
  DI float bmul() const { return 512.f; }
  DI int scale_w() const { return 0x76767676; }
  DI int scale_x() const { return 0x7D7D7D7D; }
  DI const void* a_base() const { return p.actq; }
  DI unsigned a_bytes() const { return (unsigned)NTOK * 4u * 2048u; }
  DI unsigned a_rowoff(int r) const {
    int rr = m0 + r; rr = rr < cnt ? rr : cnt - 1;
    return (unsigned)p.rowlist[e * 8192 + rr] * 2048u;
  }
  DI const float* b_base() const { return p.w_down + (size_t)e * 2048 * 2048; }
  DI unsigned b_bytes() const { return 2048u * 2048u * 4u; }
  DI int ldb() const { return 2048; }
  DI int b_gcol(int h, int lc) const { return tn * 256 + 128 * h + lc; }
  struct RowTok { int a; float gt; };
  struct ColCtx { int gc; f32x4 b0, b1; };
  DI RowTok row_tok(int r) const {
    const int rr = m0 + r; const int a = p.rowlist[e * 8192 + (rr < cnt ? rr : cnt - 1)];
    RowTok t; t.a = rr < cnt ? a : -1; t.gt = p.gate[a]; return t;
  }
  DI ColCtx col_ctx(int bj, int wc, int fq) const {
    ColCtx c; c.gc = tile_gc(tn, bj, wc, fq);
    c.b0 = *(const f32x4*)(p.b_down + e * 2048 + c.gc); c.b1 = *(const f32x4*)(p.b_down + e * 2048 + c.gc + 32);
    return c;
  }
  DI void epi_t(const RowTok& t, const ColCtx& c, const f32x4& v0, const f32x4& v1) const {
    if (t.a < 0) return;
    st_bf16x4(p.yb + (size_t)t.a * 2048 + c.gc, (v0 + c.b0) * t.gt);
    st_bf16x4(p.yb + (size_t)t.a * 2048 + c.gc + 32, (v1 + c.b1) * t.gt);
  }
  DI void epi(int r, int bj, int wc, int fq, const f32x4& v0, const f32x4& v1) const {
    const int rr = m0 + r;
    if (rr >= cnt) return;
    const int a = p.rowlist[e * 8192 + rr];
    const int gc = tile_gc(tn, bj, wc, fq);
    const float gt = p.gate[a];
    const f32x4 b0 = *(const f32x4*)(p.b_down + e * 2048 + gc), b1 = *(const f32x4*)(p.b_down + e * 2048 + gc + 32);
    st_bf16x4(p.yb + (size_t)a * 2048 + gc, (v0 + b0) * gt);
    st_bf16x4(p.yb + (size_t)a * 2048 + gc + 32, (v1 + b1) * gt);
  }
};
template <int WHICH, int PMODE = 0>
DI void phase_moe(const Params& p, LDS_AS unsigned char* lds, int bid, int nb) {
  constexpr int NTN = WHICH == 1 ? 16 : 8;
  MoeSched* sch = (MoeSched*)((char*)lds + G256F8_LDS);
  moe_sched_build(p, sch, NTN, WHICH == 1);
  const int total = sch->base[32];
  const int slot = (bid & 7) * (nb >> 3) + (bid >> 3);
  int ehint = 0;
  auto decode = [&](int u, int& ee, int& m0, int& tn, int& cn) {
    int e = ehint;
    while (u >= sch->base[e + 1]) ++e;
    ehint = e;
    const int loc = u - sch->base[e];
    const int mt = sch->mt[e];
    ee = __builtin_amdgcn_readfirstlane(WHICH == 1 ? 31 - e : e); tn = __builtin_amdgcn_readfirstlane(loc / mt); m0 = __builtin_amdgcn_readfirstlane(loc % mt) * 256;
    cn = __builtin_amdgcn_readfirstlane(sch->cnt[e]);
  };
#if MOE_FP8 == 2
  typedef typename std::conditional<WHICH == 1, CfgMoe1F8T<(PMODE == 3 ? 1 : (PMODE == 4 ? 2 : 0))>, CfgMoe2F8>::type CfgT;
  int u = slot;
  if (u < total) {
    int ee, m0, tn, cn; decode(u, ee, m0, tn, cn);
    CfgT cur{p, ee, m0, tn, cn};
    bool pre = false;
#pragma unroll 1
    for (;;) {
      const int un = u + nb;
      const bool has_next = un < total;
      int e2 = 0, m2 = 0, t2 = 0, c2 = 1;
      if (has_next) decode(un, e2, m2, t2, c2);
      const CfgT nxtc{p, e2, m2, t2, c2};
      const bool tophalf = cur.cnt - cur.m0 <= 128;
      if (pre) { if (tophalf) gemm256f8dma_unit<CfgT, true, true, PMODE>(lds, cur, has_next, nxtc); else gemm256f8dma_unit<CfgT, false, true, PMODE>(lds, cur, has_next, nxtc); }
      else { if (tophalf) gemm256f8dma_unit<CfgT, true, false, PMODE>(lds, cur, has_next, nxtc); else gemm256f8dma_unit<CfgT, false, false, PMODE>(lds, cur, has_next, nxtc); }
      if (!has_next) break;
      cur.e = e2; cur.m0 = m2; cur.tn = t2; cur.cnt = c2; u = un; pre = true;
    }
  }
#else
  for (int u = slot; u < total; u += nb) {
    int ee, m0, tn, cn; decode(u, ee, m0, tn, cn);
    const bool tophalf = cn - m0 <= 128;
#if MOE_FP8
    if (WHICH == 1) { CfgMoe1F8 cfg{p, ee, m0, tn, cn}; if (tophalf) gemm256f8_unit<CfgMoe1F8, true>(lds, cfg); else gemm256f8_unit<CfgMoe1F8, false>(lds, cfg); }
    else { CfgMoe2F8 cfg{p, ee, m0, tn, cn}; if (tophalf) gemm256f8_unit<CfgMoe2F8, true>(lds, cfg); else gemm256f8_unit<CfgMoe2F8, false>(lds, cfg); }
#else
    if (WHICH == 1) { CfgMoe1 cfg{p, ee, m0, tn, cn}; if (tophalf) gemm256_unit<CfgMoe1, 0, true>(lds, cfg); else gemm256_unit<CfgMoe1, 0, false>(lds, cfg); }
    else { CfgMoe2 cfg{p, ee, m0, tn, cn}; if (tophalf) gemm256_unit<CfgMoe2, 0, true>(lds, cfg); else gemm256_unit<CfgMoe2, 0, false>(lds, cfg); }
#endif
  }
#endif
}

DI bf16x8 pack_frag(const f32x16& x, int s) {
  uint4 r;
  r.x = pack2(x[8 * s + 0], x[8 * s + 1]); r.y = pack2(x[8 * s + 2], x[8 * s + 3]);
  r.z = pack2(x[8 * s + 4], x[8 * s + 5]); r.w = pack2(x[8 * s + 6], x[8 * s + 7]);
  return __builtin_bit_cast(bf16x8, r);
}
DI void xhalf(float x, float& lo, float& hi) {
  auto r = __builtin_amdgcn_permlane32_swap(__float_as_uint(x), __float_as_uint(x), false, false);
  lo = __uint_as_float(r[0]); hi = __uint_as_float(r[1]);
}
constexpr int AT_SBK = 0, AT_SBV = 8192, AT_MLK = 16384, AT_MLR = 24576, AT_MLV = 28672, AT_BUF = 36864;
constexpr int AT_LDS = 3 * AT_BUF;

DI void pv_accum2(LDS_AS unsigned char* vimg, int lane, const bf16x8& wf0, const bf16x8& wf1, f32x16 (&o)[4]) {
  const unsigned hh = (unsigned)lane >> 5, q = ((unsigned)lane & 15u) >> 2, pp = (unsigned)lane & 3u, blk = ((unsigned)lane >> 4) & 1u;
#pragma unroll
  for (int d = 0; d < 4; ++d) {
    bf16x8 v[2];
#pragma unroll
    for (int s = 0; s < 2; ++s) {
      const unsigned a0 = offb(16u * s + 4u * hh + q, 4u * d + 2u * blk + (pp >> 1)) + 8u * (pp & 1u);
      const unsigned a1 = offb(16u * s + 8u + 4u * hh + q, 4u * d + 2u * blk + (pp >> 1)) + 8u * (pp & 1u);
      const s16x4 lo = __builtin_amdgcn_ds_read_tr16_b64_v4i16((LDS_AS s16x4*)(vimg + a0));
      const s16x4 hi = __builtin_amdgcn_ds_read_tr16_b64_v4i16((LDS_AS s16x4*)(vimg + a1));
      v[s] = __builtin_shufflevector(lo, hi, 0, 1, 2, 3, 4, 5, 6, 7);
    }
    o[d] = MFMA32(v[0], wf0, o[d]);
    o[d] = MFMA32(v[1], wf1, o[d]);
  }
}

template <bool DIAG>
DI void sb_weights(const f32x16& z, f32x16& w, float& csum, int l31, int hh) {
  const float c2 = 0.12751743074602268f;
  float sp[16], ls[16];
#pragma unroll
  for (int i = 0; i < 16; ++i) {
    const float t = z[i] * c2;
    const float u = __builtin_amdgcn_exp2f(-fabsf(t));
    const float spv = fmaxf(t, 0.f) + __builtin_amdgcn_logf(1.f + u);
    ls[i] = t - spv;
    sp[i] = (!DIAG || (crow(i, hh) < l31)) ? spv : 0.f;
  }
  float R[4], Rp[4];
#pragma unroll
  for (int g = 0; g < 4; ++g) { R[g] = (sp[4 * g] + sp[4 * g + 1]) + (sp[4 * g + 2] + sp[4 * g + 3]); float lo, hi; xhalf(R[g], lo, hi); Rp[g] = hh ? lo : hi; }
  float later = 0.f;
#pragma unroll
  for (int g = 3; g >= 0; --g) {
    const float base = csum + later + (hh == 0 ? Rp[g] : 0.f);
    float sfx = 0.f;
#pragma unroll
    for (int e = 3; e >= 0; --e) {
      const int i = 4 * g + e;
      const float wv = __builtin_amdgcn_exp2f(ls[i] - (base + sfx));
      w[i] = (!DIAG || (crow(i, hh) < l31)) ? wv : 0.f;
      sfx += sp[i];
    }
    later += R[g] + Rp[g];
  }
  csum += later;
}

struct AttnCtx {
  __amdgpu_buffer_rsrc_t rsQKV, rsMKV, rsKR;
  unsigned ldsb; int wv, lane;
  unsigned voff_sbk, voff_sbv, voff_mlk, voff_mlv, voff_r;
  int b, hd;
};
#define AT_DMA(rs, voff, soff, m0v) asm volatile("s_mov_b32 m0, %0\n\ts_nop 4\n\tbuffer_load_dwordx4 %1, %2, %3 offen lds" :: "s"(m0v), "v"(voff), "s"(rs), "s"(soff) : "m0", "memory")
DI void attn_issue(const AttnCtx& c, int kb, int bufsel) {
  const unsigned tok = (unsigned)(c.b * SEQ + kb * 32);
  const unsigned bb = c.ldsb + (unsigned)bufsel * AT_BUF + (unsigned)c.wv * 1024u;
  AT_DMA(c.rsQKV, c.voff_sbk, tok * 6144u, bb + AT_SBK); AT_DMA(c.rsQKV, c.voff_sbv, tok * 6144u, bb + AT_SBV);
  AT_DMA(c.rsMKV, c.voff_mlk, tok * 4096u, bb + AT_MLK); AT_DMA(c.rsMKV, c.voff_mlv, tok * 4096u, bb + AT_MLV);
  if (c.wv < 4) AT_DMA(c.rsKR, c.voff_r, tok * 128u, bb + AT_MLR);
}
DI void attn_step_end() { asm volatile("s_waitcnt vmcnt(0)" ::: "memory"); __builtin_amdgcn_s_barrier(); }
DI void attn_step_end_sb() { asm volatile("s_waitcnt vmcnt(5)" ::: "memory"); __builtin_amdgcn_s_barrier(); }
DI void attn_step_end_ml() { asm volatile("s_waitcnt vmcnt(4)" ::: "memory"); __builtin_amdgcn_s_barrier(); }

DI void attn_sb_item(const Params& p, LDS_AS unsigned char* lds, const AttnCtx& c, int qb, int nsteps) {
  const int lane = c.lane, l31 = lane & 31, hh = lane >> 5;
  const size_t tokbase = (size_t)c.b * SEQ;
  bf16x8 qf[8];
  {
    const bf16_t* qp = p.qkv + (tokbase + qb * 32 + l31) * 3072 + c.hd * 128 + 8 * hh;
#pragma unroll
    for (int s = 0; s < 8; ++s) qf[s] = *(const bf16x8*)(qp + 16 * s);
  }
  f32x16 o[4];
#pragma unroll
  for (int d = 0; d < 4; ++d)
#pragma unroll
    for (int i = 0; i < 16; ++i) o[d][i] = 0.f;
  float csum = 0.f;
  attn_issue(c, nsteps - 1, 0);
  attn_issue(c, nsteps - 2, 1);
  attn_step_end_sb();
  int s = 0, rb = 0;
  const int nskip = nsteps - 1 - qb;
#pragma unroll 1
  for (; s < nskip; ++s) { if (s + 2 < nsteps) { attn_issue(c, nsteps - 3 - s, rb == 0 ? 2 : rb - 1); attn_step_end_sb(); } else attn_step_end(); rb = rb == 2 ? 0 : rb + 1; }
#pragma unroll 1
  for (; s < nsteps; ++s) {
    const int kb = nsteps - 1 - s;
    if (s + 2 < nsteps) { attn_issue(c, kb - 2, rb == 0 ? 2 : rb - 1); }
    LDS_AS unsigned char* Bf = lds + rb * AT_BUF;
    bf16x8 kf[8];
#pragma unroll
    for (int ks = 0; ks < 8; ++ks) kf[ks] = *(const LDS_AS bf16x8*)(Bf + AT_SBK + offb((unsigned)l31, (unsigned)(2 * ks + hh)));
    __builtin_amdgcn_sched_barrier(0);
    f32x16 z;
#pragma unroll
    for (int i = 0; i < 16; ++i) z[i] = 0.f;
#pragma unroll
    for (int ks = 0; ks < 8; ++ks) z = MFMA32(kf[ks], qf[ks], z);
    f32x16 w;
    if (kb == qb) sb_weights<true>(z, w, csum, l31, hh); else sb_weights<false>(z, w, csum, l31, hh);
    const bf16x8 wf0 = pack_frag(w, 0), wf1 = pack_frag(w, 1);
    pv_accum2(Bf + AT_SBV, lane, wf0, wf1, o);
    if (s + 2 < nsteps) attn_step_end_sb(); else attn_step_end();
    rb = rb == 2 ? 0 : rb + 1;
  }
  bf16_t* op = p.oA + (tokbase + qb * 32 + l31) * 1024 + c.hd * 128;
#pragma unroll
  for (int d = 0; d < 4; ++d)
#pragma unroll
    for (int g = 0; g < 4; ++g) {
      uint2 pk; pk.x = pack2(o[d][4 * g], o[d][4 * g + 1]); pk.y = pack2(o[d][4 * g + 2], o[d][4 * g + 3]);
      *(uint2*)(op + d * 32 + 8 * g + 4 * hh) = pk;
    }
}

DI void attn_mla_item(const Params& p, LDS_AS unsigned char* lds, const AttnCtx& c, int qb, int nsteps) {
  const int lane = c.lane, l31 = lane & 31, hh = lane >> 5;
  const size_t tokbase = (size_t)c.b * SEQ;
  bf16x8 qf[12];
  {
    const bf16_t* qp = p.mq + (tokbase + qb * 32 + l31) * 1536 + c.hd * 192 + 8 * hh;
#pragma unroll
    for (int s = 0; s < 12; ++s) qf[s] = *(const bf16x8*)(qp + 16 * s);
  }
  f32x16 o[4];
#pragma unroll
  for (int d = 0; d < 4; ++d)
#pragma unroll
    for (int i = 0; i < 16; ++i) o[d][i] = 0.f;
  float mrun = -1e30f, lrun = 0.f;
  attn_issue(c, nsteps - 1, 0);
  attn_issue(c, nsteps - 2, 1);
  attn_step_end_ml();
  int s = 0, rb = 0;
  const int nskip = nsteps - ((qb >> 1) + 1) * 2;
#pragma unroll 1
  for (; s < nskip; ++s) { if (s + 2 < nsteps) { attn_issue(c, nsteps - 3 - s, rb == 0 ? 2 : rb - 1); attn_step_end_ml(); } else attn_step_end(); rb = rb == 2 ? 0 : rb + 1; }
#pragma unroll 1
  for (; s < nsteps; ++s) {
    const int kb = nsteps - 1 - s;
    if (s + 2 < nsteps) { attn_issue(c, kb - 2, rb == 0 ? 2 : rb - 1); }
    LDS_AS unsigned char* Bf = lds + rb * AT_BUF;
    bf16x8 kf[12];
#pragma unroll
    for (int ks = 0; ks < 8; ++ks) kf[ks] = *(const LDS_AS bf16x8*)(Bf + AT_MLK + offb((unsigned)l31, (unsigned)(2 * ks + hh)));
#pragma unroll
    for (int ks = 0; ks < 4; ++ks) kf[8 + ks] = *(const LDS_AS bf16x8*)(Bf + AT_MLR + 128u * (unsigned)l31 + 16u * ((unsigned)(2 * ks + hh) ^ ((unsigned)l31 & 7u)));
    __builtin_amdgcn_sched_barrier(0);
    f32x16 z;
#pragma unroll
    for (int i = 0; i < 16; ++i) z[i] = 0.f;
#pragma unroll
    for (int ks = 0; ks < 12; ++ks) z = MFMA32(kf[ks], qf[ks], z);
    const float c2 = 0.10411754584378834f;
    float mx = fmaxf(fmaxf(z[0], z[1]), fmaxf(z[2], z[3]));
#pragma unroll
    for (int i = 4; i < 16; i += 2) mx = fmaxf(mx, fmaxf(z[i], z[i + 1]));
    { float lo, hi; xhalf(mx, lo, hi); mx = fmaxf(lo, hi) * c2; }
    if (__builtin_amdgcn_ballot_w64(mx - mrun > 8.f) != 0ull) {
      const float mnew = fmaxf(mrun, mx);
      const float alpha = __builtin_amdgcn_exp2f(mrun - mnew);
      lrun *= alpha; mrun = mnew;
#pragma unroll
      for (int d = 0; d < 4; ++d)
#pragma unroll
        for (int i = 0; i < 16; ++i) o[d][i] *= alpha;
    }
    float ls = 0.f;
#pragma unroll
    for (int i = 0; i < 16; ++i) { z[i] = __builtin_amdgcn_exp2f(fmaf(z[i], c2, -mrun)); ls += z[i]; }
    { float lo, hi; xhalf(ls, lo, hi); ls = lo + hi; }
    lrun += ls;
    const bf16x8 wf0 = pack_frag(z, 0), wf1 = pack_frag(z, 1);
    pv_accum2(Bf + AT_MLV, lane, wf0, wf1, o);
    if (s + 2 < nsteps) attn_step_end_ml(); else attn_step_end();
    rb = rb == 2 ? 0 : rb + 1;
  }
  const float inv = 1.f / lrun;
  bf16_t* op = p.oB + (tokbase + qb * 32 + l31) * 1024 + c.hd * 128;
#pragma unroll
  for (int d = 0; d < 4; ++d)
#pragma unroll
    for (int g = 0; g < 4; ++g) {
      uint2 pk; pk.x = pack2(o[d][4 * g] * inv, o[d][4 * g + 1] * inv); pk.y = pack2(o[d][4 * g + 2] * inv, o[d][4 * g + 3] * inv);
      *(uint2*)(op + d * 32 + 8 * g + 4 * hh) = pk;
    }
}

DI void phase_attn(const Params& p, LDS_AS unsigned char* lds, char* smem, int bid, int nb) {
  const int tid = OPAQUE_TID(p);
  AttnCtx c;
  c.wv = __builtin_amdgcn_readfirstlane(tid >> 6); c.lane = tid & 63;
  const int w4 = c.wv & 3;
  c.ldsb = (unsigned)__builtin_amdgcn_readfirstlane((int)(unsigned)(size_t)lds);
  c.rsQKV = __builtin_amdgcn_make_buffer_rsrc((void*)p.qkv, 0, (unsigned)NTOK * 6144u, 0x00020000);
  c.rsMKV = __builtin_amdgcn_make_buffer_rsrc((void*)p.mkv, 0, (unsigned)NTOK * 4096u, 0x00020000);
  c.rsKR = __builtin_amdgcn_make_buffer_rsrc((void*)p.krope, 0, (unsigned)NTOK * 128u, 0x00020000);
  const unsigned drow = 4u * c.wv + ((unsigned)c.lane >> 4), dchp = (unsigned)c.lane & 15u;
  const unsigned dch = dchp ^ (((drow & 3u) << 2) | ((drow >> 2) & 3u));
  const unsigned rrow = 8u * w4 + ((unsigned)c.lane >> 3), rch = ((unsigned)c.lane & 7u) ^ (rrow & 7u);
#pragma unroll 1
  for (int rnd = 0; rnd * nb < 512; ++rnd) {
    const int s = __builtin_amdgcn_readfirstlane(rnd * nb + ((rnd & 1) ? nb - 1 - bid : bid));
    if (s >= 512) break;
    const int q8 = ((rnd & 1) && (nb & 7) == 0) ? 7 - (s & 7) : (s & 7);
    const int bh = q8 * 4 + ((s >> 3) & 3), ch = 15 - (s >> 5);
    c.b = bh >> 3; c.hd = bh & 7;
    c.voff_sbk = drow * 6144u + (unsigned)(1024 + c.hd * 128) * 2u + dch * 16u;
    c.voff_sbv = drow * 6144u + (unsigned)(2048 + c.hd * 128) * 2u + dch * 16u;
    c.voff_mlk = drow * 4096u + (unsigned)(c.hd * 256) * 2u + dch * 16u;
    c.voff_mlv = drow * 4096u + (unsigned)(c.hd * 256 + 128) * 2u + dch * 16u;
    c.voff_r = rrow * 128u + rch * 16u;
    if (c.wv < 4) attn_sb_item(p, lds, c, 4 * ch + w4, 4 * ch + 4);
    else attn_mla_item(p, lds, c, 4 * ch + w4, 4 * ch + 4);
  }
}
#undef AT_DMA

DI void phase_attn_norm(const Params& p, int bid, int nb) {
  const int tid_ = OPAQUE_TID(p), lane = tid_ & 63, wv = tid_ >> 6;
  for (int t = bid * NWAVES + wv; t < NTOK; t += nb * NWAVES) {
#pragma unroll
    for (int grp = 0; grp < 2; ++grp) {
      const bf16_t* src = (grp ? p.oB : p.oA) + (size_t)t * 1024 + lane * 16;
      const float* g = (grp ? p.mla_out_norm : p.sb_out_norm) + lane * 16;
      const uint4 a0 = *(const uint4*)src, a1 = *(const uint4*)(src + 8);
      float v[16] = {bflo(a0.x), bfhi(a0.x), bflo(a0.y), bfhi(a0.y), bflo(a0.z), bfhi(a0.z), bflo(a0.w), bfhi(a0.w),
                     bflo(a1.x), bfhi(a1.x), bflo(a1.y), bfhi(a1.y), bflo(a1.z), bfhi(a1.z), bflo(a1.w), bfhi(a1.w)};
      float s = 0.f;
#pragma unroll
      for (int i = 0; i < 16; ++i) s += v[i] * v[i];
      s = wave_sum(s);
      const float rs = rsqrtf(s * (1.f / 1024.f) + RMS_EPS);
      uint4 o0, o1;
      o0.x = pack2(v[0] * rs * g[0], v[1] * rs * g[1]); o0.y = pack2(v[2] * rs * g[2], v[3] * rs * g[3]);
      o0.z = pack2(v[4] * rs * g[4], v[5] * rs * g[5]); o0.w = pack2(v[6] * rs * g[6], v[7] * rs * g[7]);
      o1.x = pack2(v[8] * rs * g[8], v[9] * rs * g[9]); o1.y = pack2(v[10] * rs * g[10], v[11] * rs * g[11]);
      o1.z = pack2(v[12] * rs * g[12], v[13] * rs * g[13]); o1.w = pack2(v[14] * rs * g[14], v[15] * rs * g[15]);
      bf16_t* dst = p.on + (size_t)t * 2048 + grp * 1024 + lane * 16;
      *(uint4*)dst = o0; *(uint4*)(dst + 8) = o1;
    }
  }
}

template <bool DRY = false>
DI void phase_ln_router(const Params& p, char* smem, int bid, int nb) {
  float* hs = (float*)smem;
  float* red = hs + 8 * 2048;
  float* lg = red + 32 * 8 * 32;
  int* lcnt = (int*)(lg + 8 * 32);
  int* lbase = lcnt + 32;
  int* lasg = lbase + 32;
  int* lnum = lasg + 1024;
  const int tid = OPAQUE_TID(p), lane = tid & 63, wv = tid >> 6;
  const int e = tid & 15, ks = tid >> 4;
  f32x2_t wr[64];
#pragma unroll
  for (int i = 0; i < 64; ++i) { wr[i][0] = p.w_router[(size_t)(ks * 64 + i) * 32 + e]; wr[i][1] = p.w_router[(size_t)(ks * 64 + i) * 32 + e + 16]; }
  if (tid < 32) lcnt[tid] = 0;
  if (tid == 32) lnum[0] = 0;
  __syncthreads();
  u32x2 za[8];
  {
    const int tf = bid * 8 + wv;
    const bf16_t* zr = p.z1b + (size_t)(tf < NTOK ? tf : 0) * DM;
#pragma unroll
    for (int i = 0; i < 8; ++i) za[i] = *(const u32x2*)(zr + (i * 64 + lane) * 4);
  }
  for (int t0 = bid * 8; t0 < NTOK; t0 += nb * 8) {
    const int t = t0 + wv;
    {
      float v[32];
#pragma unroll
      for (int i = 0; i < 8; ++i) {
        const u32x2 a = za[i];
        v[4 * i] = bflo(a.x); v[4 * i + 1] = bfhi(a.x); v[4 * i + 2] = bflo(a.y); v[4 * i + 3] = bfhi(a.y);
      }
      {
        const int tn2 = t + nb * 8;
        const bf16_t* zr = p.z1b + (size_t)(tn2 < NTOK ? tn2 : t) * DM;
#pragma unroll
        for (int i = 0; i < 8; ++i) za[i] = *(const u32x2*)(zr + (i * 64 + lane) * 4);
      }
      float s = 0.f;
#pragma unroll
      for (int i = 0; i < 32; ++i) s += v[i];
      s = wave_sum(s);
      const float mu = s * (1.f / 2048.f);
      float q = 0.f;
#pragma unroll
      for (int i = 0; i < 32; ++i) { const float d = v[i] - mu; q += d * d; }
      q = wave_sum(q);
      const float rs = rsqrtf(q * (1.f / 2048.f) + LN_EPS);
#pragma unroll
      for (int i = 0; i < 8; ++i) {
        const int c = (i * 64 + lane) * 4;
        const float4 gg = *(const float4*)(p.ln_mix_g + c);
        const float4 bb = *(const float4*)(p.ln_mix_b + c);
        float4 o;
        o.x = (v[4 * i + 0] - mu) * rs * gg.x + bb.x;
        o.y = (v[4 * i + 1] - mu) * rs * gg.y + bb.y;
        o.z = (v[4 * i + 2] - mu) * rs * gg.z + bb.z;
        o.w = (v[4 * i + 3] - mu) * rs * gg.w + bb.w;
        { uint2 pk; pk.x = pack2(o.x, o.y); pk.y = pack2(o.z, o.w); *(uint2*)(p.h1b + (size_t)t * DM + c) = pk; }
#if MOE_FP8
        {
          int pq = 0;
          pq = __builtin_amdgcn_cvt_pk_fp8_f32(fminf(fmaxf(o.x * 16.f, -440.f), 440.f), fminf(fmaxf(o.y * 16.f, -440.f), 440.f), pq, false);
          pq = __builtin_amdgcn_cvt_pk_fp8_f32(fminf(fmaxf(o.z * 16.f, -440.f), 440.f), fminf(fmaxf(o.w * 16.f, -440.f), 440.f), pq, true);
          *(int*)(p.h1q + (size_t)t * DM + c) = pq;
        }
#endif
        *(float4*)(hs + wv * 2048 + c) = o;
      }
    }
    __syncthreads();
    {
      f32x2_t acc[8];
#pragma unroll
      for (int j = 0; j < 8; ++j) acc[j] = (f32x2_t){0.f, 0.f};
#pragma unroll
      for (int j = 0; j < 8; ++j) {
#pragma unroll
        for (int i4 = 0; i4 < 16; ++i4) {
          const float4 h = *(const float4*)(hs + j * 2048 + ks * 64 + 4 * i4);
          acc[j] = __builtin_elementwise_fma((f32x2_t){h.x, h.x}, wr[4 * i4], acc[j]); acc[j] = __builtin_elementwise_fma((f32x2_t){h.y, h.y}, wr[4 * i4 + 1], acc[j]);
          acc[j] = __builtin_elementwise_fma((f32x2_t){h.z, h.z}, wr[4 * i4 + 2], acc[j]); acc[j] = __builtin_elementwise_fma((f32x2_t){h.w, h.w}, wr[4 * i4 + 3], acc[j]);
          if ((i4 & 7) == 7) __builtin_amdgcn_sched_barrier(0);
        }
      }
#pragma unroll
      for (int j = 0; j < 8; ++j) { red[(ks * 8 + j) * 32 + e] = acc[j][0]; red[(ks * 8 + j) * 32 + e + 16] = acc[j][1]; }
    }
    __syncthreads();
    if (tid < 256) {
      const int e2 = tid & 31, j = tid >> 5;
      float s = 0.f;
#pragma unroll
      for (int k2 = 0; k2 < 32; ++k2) s += red[(k2 * 8 + j) * 32 + e2];
      lg[j * 32 + e2] = s + p.b_router[e2];
    }
    __syncthreads();
    {
      float val = (lane < 32) ? lg[wv * 32 + lane] : -3.0e38f;
      float tv[4]; int ti[4];
#pragma unroll
      for (int k = 0; k < 4; ++k) {
        const float m = wave_max(val);
        const unsigned long long bal = __ballot(val == m);
        const int idx = __ffsll((long long)bal) - 1;
        tv[k] = m; ti[k] = idx;
        if (lane == idx) val = -3.0e38f;
      }
      const float e1 = __expf(tv[1] - tv[0]), e2 = __expf(tv[2] - tv[0]), e3 = __expf(tv[3] - tv[0]);
      const float inv = 1.f / (1.f + e1 + e2 + e3);
      if (lane < 4) {
        const float gk = (lane == 0 ? 1.f : lane == 1 ? e1 : lane == 2 ? e2 : e3) * inv;
        const int ek = lane == 0 ? ti[0] : lane == 1 ? ti[1] : lane == 2 ? ti[2] : ti[3];
        const int rank = atomicAdd(lcnt + ek, 1);
        const int slot = atomicAdd(lnum, 1);
        if (slot < 1024) lasg[slot] = ((t * 4 + lane) << 16) | (ek << 11) | rank;
        p.gate[t * 4 + lane] = gk;
      }
    }
    __syncthreads();
  }
  if (DRY) return;
  if (tid < 32) lbase[tid] = atomicAdd(p.cnt + tid * 32, lcnt[tid]);
  __syncthreads();
  {
    const int n = lnum[0] < 1024 ? lnum[0] : 1024;
    for (int i = tid; i < n; i += NTHREADS) {
      const int v = lasg[i], a = (int)((unsigned)v >> 16), ek = (v >> 11) & 31, rank = v & 2047;
      p.rowlist[ek * 8192 + lbase[ek] + rank] = a;
    }
  }
  __syncthreads();
}

DI void phase_final(const Params& p, int bid, int nb) {
  const int tid_ = OPAQUE_TID(p), lane = tid_ & 63, wv = tid_ >> 6;
  for (int t = bid * NWAVES + wv; t < NTOK; t += nb * NWAVES) {
    float v[32];
    const bf16_t* hr = p.h1b + (size_t)t * DM;
#pragma unroll
    for (int i = 0; i < 8; ++i) {
      const int c = (i * 64 + lane) * 4;
      const uint2 ab = *(const uint2*)(hr + c);
      float4 a; a.x = bflo(ab.x); a.y = bfhi(ab.x); a.z = bflo(ab.y); a.w = bfhi(ab.y);
      float s0 = 0.f, s1 = 0.f, s2 = 0.f, s3 = 0.f;
#pragma unroll
      for (int k = 0; k < 4; ++k) {
        const uint2 y = *(const uint2*)(p.yb + (size_t)(t * 4 + k) * 2048 + c);
        s0 += bflo(y.x); s1 += bfhi(y.x); s2 += bflo(y.y); s3 += bfhi(y.y);
      }
      v[4 * i] = DN_ALPHA * a.x + s0; v[4 * i + 1] = DN_ALPHA * a.y + s1;
      v[4 * i + 2] = DN_ALPHA * a.z + s2; v[4 * i + 3] = DN_ALPHA * a.w + s3;
    }
    ln_row_store(v, lane, p.ln_ffn_g, p.ln_ffn_b, p.out + (size_t)t * DM, nullptr);
  }
}

constexpr int MK_LDS = 163840;
extern __shared__ __attribute__((aligned(16))) char dyn_smem[];

__global__ void __launch_bounds__(NTHREADS, 2) k_forward(Params p_in) {
  Params p = p_in;
  p.wid0 = __builtin_amdgcn_readfirstlane((int)(threadIdx.x >> 6));
  if (threadIdx.x == 0) *(uint4*)dyn_smem = make_uint4(0u, 0u, 0u, 0u);
  __syncthreads();
  char* smem = dyn_smem + 16;
  LDS_AS unsigned char* lds = (LDS_AS unsigned char*)(dyn_smem + 16);
  const int bid = blockIdx.x, nb = gridDim.x;
  const bool roles = (nb & 7) == 0 && nb >= 64;
  int ncv = 0, cv_before = 0;
  bool is_cv = false;
  if (roles) {
    const int j = bid >> 3;
    for (int i = 0; i < (nb >> 3); ++i) { const bool c = ((i * 5) & 15) < CV_PER_16; ncv += c ? 8 : 0; cv_before += (c && i < j) ? 8 : 0; if (i == j) is_cv = c; }
  }
  int cvid = cv_before + (bid & 7);
  const int extra = (roles && ((((nb >> 3) - 1) * 5) & 15) >= CV_PER_16) ? CV_EXTRA : 0;
  if (extra > 0 && bid >= nb - extra) { is_cv = true; cvid = ncv + (bid - (nb - extra)); }
  ncv += extra;
  const int nc = nb - ncv;
  const int cbid = (bid & ~7) - cv_before + (bid & 7);
  const int nca = roles ? (nc & ~7) : nc;
  XcdBarrier bar = xcd_barrier_post(p.bar, (volatile LAS unsigned*)dyn_smem, (unsigned)nb);
#if JOIN_LATE
  phase_ln_in(p, bid, nb);
  phase_convert(p, smem, bid, nb);
  xcd_barrier(bar);
#endif
  if (is_cv) {
    {
      volatile LAS unsigned* stw = (volatile LAS unsigned*)dyn_smem;
      const unsigned s0 = stw[0], s1 = stw[1];
      __syncthreads();
      convert_experts_dma<5>(p, (LDS_AS unsigned char*)dyn_smem, cvid, ncv);
#if CV_REPEAT == 2
      convert_experts_dma<5>(p, (LDS_AS unsigned char*)dyn_smem, cvid, ncv);
#elif CV_REPEAT == 3
      convert_experts_dma<5, true>(p, (LDS_AS unsigned char*)dyn_smem, cvid, ncv);
#endif
      if (threadIdx.x == 0) { stw[0] = s0; stw[1] = s1; stw[2] = 0u; stw[3] = 0u; }
      __syncthreads();
    }
  } else {
    XcdBarrier barc = xcd_barrier_post(p.bar + XCD_BAR_WORDS, (volatile LAS unsigned*)dyn_smem + 2, (unsigned)nc);
#if !JOIN_LATE
    phase_ln_in(p, cbid, nc);
    phase_convert(p, smem, cbid, nc);
    xcd_barrier(barc);
#endif
    phase_in_proj(p, lds, smem, cbid, nc);
    xcd_barrier(barc);
    phase_norm_latents(p, cbid, nc);
    xcd_barrier(barc);
    phase_mla_proj(p, lds, smem, cbid, nc);
    xcd_barrier(barc);
    if (cbid < nca) phase_attn(p, lds, smem, cbid, nca);
    xcd_barrier(barc);
    phase_attn_norm(p, cbid, nc);
#if JOIN_LATE == 1
    xcd_barrier(barc);
    phase_wo(p, lds, smem, cbid, nc);
#endif
    if (ncv == 0) convert_experts_dma<4>(p, lds, bid, nb);
  }
  xcd_barrier(bar);
#if JOIN_LATE != 1
  phase_wo(p, lds, smem, bid, nb);
  xcd_barrier(bar);
#endif
  phase_ln_router(p, smem, bid, nb);
  xcd_barrier(bar);
#if MOE_PROBE
  phase_moe<1, MOE_PROBE>(p, lds, bid, nb);
  xcd_barrier(bar);
#endif
  phase_moe<1>(p, lds, bid, nb);
  xcd_barrier(bar);
  phase_moe<2>(p, lds, bid, nb);
  xcd_barrier(bar);
  phase_final(p, bid, nb);
}

extern "C" void kernel_launch(void* const* d_in, const int* in_sizes, int n_in, void* d_out, int out_size, void* d_ws,
                              size_t ws_size, hipStream_t stream) {
  Params p{};
  p.x = (const float*)d_in[0]; p.pos = (const int*)d_in[1]; p.ln_in_g = (const float*)d_in[2]; p.ln_in_b = (const float*)d_in[3];
  p.w_in = (const float*)d_in[4]; p.q_a_norm = (const float*)d_in[5]; p.w_q_b = (const float*)d_in[6];
  p.kv_a_norm = (const float*)d_in[7]; p.w_kv_b = (const float*)d_in[8]; p.sb_out_norm = (const float*)d_in[9];
  p.mla_out_norm = (const float*)d_in[10]; p.w_o = (const float*)d_in[11]; p.ln_mix_g = (const float*)d_in[12];
  p.ln_mix_b = (const float*)d_in[13]; p.w_router = (const float*)d_in[14]; p.b_router = (const float*)d_in[15];
  p.w_gate_up = (const float*)d_in[16]; p.b_gate_up = (const float*)d_in[17]; p.w_down = (const float*)d_in[18];
  p.b_down = (const float*)d_in[19]; p.ln_ffn_g = (const float*)d_in[20]; p.ln_ffn_b = (const float*)d_in[21];
  p.out = (float*)d_out;
  char* w = (char*)d_ws;
  size_t off = 0;
  auto take = [&](size_t bytes) { char* r = w + off; off += (bytes + 255) & ~(size_t)255; return r; };
  constexpr size_t ZERO_BYTES = 2 * XCD_BAR_WORDS * 4 + 4096;
  p.bar = (unsigned*)take(ZERO_BYTES);
  p.cnt = (int*)((char*)p.bar + 2 * XCD_BAR_WORDS * 4);
  p.h0f = (float*)take((size_t)NTOK * DM * 4);
  p.h0b = (bf16_t*)take((size_t)NTOK * DM * 2);
  p.qkv = (bf16_t*)take((size_t)NTOK * 3072 * 2);
  p.qlat = (bf16_t*)take((size_t)NTOK * 512 * 2);
  p.kvlat = (bf16_t*)take((size_t)NTOK * 256 * 2);
  p.krope = (bf16_t*)take((size_t)NTOK * 64 * 2);
  p.qn = (bf16_t*)take((size_t)NTOK * 512 * 2);
  p.kvn = (bf16_t*)take((size_t)NTOK * 256 * 2);
  p.mq = (bf16_t*)take((size_t)NTOK * 1536 * 2);
  p.mkv = (bf16_t*)take((size_t)NTOK * 2048 * 2);
  p.oA = (bf16_t*)take((size_t)NTOK * 1024 * 2);
  p.oB = (bf16_t*)take((size_t)NTOK * 1024 * 2);
  p.on = (bf16_t*)take((size_t)NTOK * 2048 * 2);
  p.z1 = nullptr;
  p.z1b = (bf16_t*)take((size_t)NTOK * DM * 2);
  p.h1f = (float*)take((size_t)NTOK * DM * 4);
  p.h1b = (bf16_t*)take((size_t)NTOK * DM * 2);
  p.gate = (float*)take((size_t)NTOK * 4 * 4);
  p.rowlist = (int*)take((size_t)32 * 8192 * 4);
  p.act = (bf16_t*)take((size_t)NTOK * 4 * 2048 * 2);
  p.yb = (bf16_t*)take((size_t)NTOK * 4 * 2048 * 2);
  p.h1q = (unsigned char*)take((size_t)NTOK * 2048);
  p.wq1 = (unsigned char*)take((size_t)32 * 4096 * 2048);
  p.wq2 = (unsigned char*)take((size_t)32 * 2048 * 2048);
  p.cvdump = (unsigned char*)take((size_t)64 * 2048);
  p.wt_in = (bf16_t*)take((size_t)4096 * 2048 * 2);
  p.wt_o = (bf16_t*)take((size_t)2048 * 2048 * 2);
  p.wt_q = (bf16_t*)take((size_t)1536 * 512 * 2);
  p.wt_kv = (bf16_t*)take((size_t)2048 * 256 * 2);
  p.actq = (unsigned char*)take((size_t)NTOK * 4 * 2048);

  static int grid = 0;
  if (!grid) {
    int dev = 0, cus = 0, per_cu = 0;
    (void)hipGetDevice(&dev);
    (void)hipDeviceGetAttribute(&cus, hipDeviceAttributeMultiprocessorCount, dev);
    (void)hipFuncSetAttribute((const void*)k_forward, hipFuncAttributeMaxDynamicSharedMemorySize, MK_LDS);
    (void)hipOccupancyMaxActiveBlocksPerMultiprocessor(&per_cu, (const void*)k_forward, NTHREADS, MK_LDS);
    grid = cus * (per_cu < 1 ? per_cu : 1);
  }
  (void)hipMemsetAsync(p.bar, 0, ZERO_BYTES, stream);
  if (grid > 0) k_forward<<<grid, NTHREADS, MK_LDS, stream>>>(p);
}
```

```cpp
#include <hip/hip_runtime.h>
#include <stdint.h>
#include <type_traits>

#define DI __device__ __forceinline__
typedef unsigned short bf16_t;
typedef __attribute__((ext_vector_type(8))) short bf16x8;
typedef __attribute__((ext_vector_type(16))) float f32x16;
typedef __attribute__((ext_vector_type(2))) __bf16 bf16x2_t;
typedef __attribute__((ext_vector_type(2))) float f32x2_t;

constexpr int NTOK = 8192, DM = 2048, SEQ = 2048;
constexpr int INP = 3904;
constexpr int NEXP = 32, DFF = 2048;
constexpr float LN_EPS = 1e-5f, RMS_EPS = 1e-6f;
constexpr float DN_ALPHA = 1.189207115002721f;
constexpr int NTHREADS = 512, NWAVES = 8;
#ifndef DENSE_DMA
#define DENSE_DMA 1
#endif
#ifndef JOIN_LATE
#define JOIN_LATE 2
#endif
#ifndef CV_REPEAT
#define CV_REPEAT 1
#endif
#ifndef CV_FUNC
#define CV_FUNC convert_experts_dma
#endif
#ifndef MOE_PROBE
#define MOE_PROBE 0
#endif
#ifndef CV_EXTRA
#define CV_EXTRA 5
#endif
#ifndef CVG
#define CVG 4
#endif
#ifndef CV_PER_16
#define CV_PER_16 5
#endif
#ifndef MOE_FP8
#define MOE_FP8 2
#endif

struct Params {
  const float* x; const int* pos; const float* ln_in_g; const float* ln_in_b; const float* w_in;
  const float* q_a_norm; const float* w_q_b; const float* kv_a_norm; const float* w_kv_b;
  const float* sb_out_norm; const float* mla_out_norm; const float* w_o; const float* ln_mix_g; const float* ln_mix_b;
  const float* w_router; const float* b_router; const float* w_gate_up; const float* b_gate_up;
  const float* w_down; const float* b_down; const float* ln_ffn_g; const float* ln_ffn_b;
  float* out;
  int wid0, pad0;
  unsigned* bar;
  int* cnt;
  float* h0f;
  bf16_t* h0b;
  bf16_t* qkv;
  bf16_t* qlat;
  bf16_t* kvlat;
  bf16_t* krope;
  bf16_t* qn;
  bf16_t* kvn;
  bf16_t* mq;
  bf16_t* mkv;
  bf16_t* oA;
  bf16_t* oB;
  bf16_t* on;
  float* z1;
  bf16_t* z1b;
  float* h1f;
  bf16_t* h1b;
  float* gate;
  int* rowlist;
  unsigned long long* rowpair;
  bf16_t* act;
  bf16_t* yb;
  bf16_t* wt_in;
  bf16_t* wt_o;
  bf16_t* wt_q;
  bf16_t* wt_kv;
  unsigned char* wq1;
  unsigned char* wq2;
  unsigned char* cvdump;
  unsigned char* h1q;
  unsigned char* actq;
};

DI unsigned pack2(float a, float b) {
  f32x2_t v = {a, b};
  bf16x2_t r = __builtin_convertvector(v, bf16x2_t);
  return __builtin_bit_cast(unsigned, r);
}
DI bf16_t f2bf(float a) { return (bf16_t)(pack2(a, 0.f) & 0xffffu); }
DI float bf2f(bf16_t h) { return __uint_as_float(((unsigned)h) << 16); }
DI float bflo(unsigned u) { return __uint_as_float(u << 16); }
DI float bfhi(unsigned u) { return __uint_as_float(u & 0xffff0000u); }
DI int crow(int reg, int h) { return (reg & 3) + 8 * (reg >> 2) + 4 * h; }
DI float wave_sum(float v) {
#pragma unroll
  for (int o = 32; o > 0; o >>= 1) v += __shfl_xor(v, o);
  return v;
}
DI float wave_max(float v) {
#pragma unroll
  for (int o = 32; o > 0; o >>= 1) v = fmaxf(v, __shfl_xor(v, o));
  return v;
}

__constant__ float INV_FREQ[32] = {1.000000000e+00f, 7.498942093e-01f, 5.623413252e-01f, 4.216965034e-01f, 3.162277660e-01f, 2.371373706e-01f, 1.778279410e-01f, 1.333521432e-01f, 1.000000000e-01f, 7.498942093e-02f, 5.623413252e-02f, 4.216965034e-02f, 3.162277660e-02f, 2.371373706e-02f, 1.778279410e-02f, 1.333521432e-02f, 1.000000000e-02f, 7.498942093e-03f, 5.623413252e-03f, 4.216965034e-03f, 3.162277660e-03f, 2.371373706e-03f, 1.778279410e-03f, 1.333521432e-03f, 1.000000000e-03f, 7.498942093e-04f, 5.623413252e-04f, 4.216965034e-04f, 3.162277660e-04f, 2.371373706e-04f, 1.778279410e-04f, 1.333521432e-04f};
DI void rope_sc(int pos, int i, float& sn, float& cs) {
  const float ang = (float)pos * INV_FREQ[i];
  double rev = (double)ang * 0.15915494309189535;
  rev -= rint(rev);
  const float fr = (float)rev;
  sn = __builtin_amdgcn_sinf(fr);
  cs = __builtin_amdgcn_cosf(fr);
}
typedef __attribute__((ext_vector_type(4))) short s16x4;
#define LDS_AS __attribute__((address_space(3)))
DI s16x4 tr_read4(const bf16_t* p) { return __builtin_amdgcn_ds_read_tr16_b64_v4i16((LDS_AS s16x4*)p); }
DI bf16x8 tr_frag(const bf16_t* p0, const bf16_t* p1) {
  const s16x4 a = tr_read4(p0), b = tr_read4(p1);
  return __builtin_shufflevector(a, b, 0, 1, 2, 3, 4, 5, 6, 7);
}
DI int lane_id_now() { int l; asm volatile("v_mbcnt_lo_u32_b32 %0, -1, 0\n\tv_mbcnt_hi_u32_b32 %0, -1, %0" : "=v"(l)); return l; }
#define OPAQUE_TID(P) (((P).wid0 << 6) | lane_id_now())
DI int pack4_fp8(float a, float b, float c, float d) {
  int pk = 0;
  pk = __builtin_amdgcn_cvt_pk_fp8_f32(a, b, pk, false);
  pk = __builtin_amdgcn_cvt_pk_fp8_f32(c, d, pk, true);
  return pk;
}
#define MFMA32(a, b, c) __builtin_amdgcn_mfma_f32_32x32x16_bf16((a), (b), (c), 0, 0, 0)

DI void ln_row_store(const float (&v)[32], int lane, const float* g, const float* b, float* outf, bf16_t* outb) {
  float s = 0.f;
#pragma unroll
  for (int i = 0; i < 32; ++i) s += v[i];
  s = wave_sum(s);
  const float mu = s * (1.f / 2048.f);
  float q = 0.f;
#pragma unroll
  for (int i = 0; i < 32; ++i) { const float d = v[i] - mu; q += d * d; }
  q = wave_sum(q);
  const float rs = rsqrtf(q * (1.f / 2048.f) + LN_EPS);
#pragma unroll
  for (int i = 0; i < 8; ++i) {
    const int c = (i * 64 + lane) * 4;
    const float4 gg = *(const float4*)(g + c);
    const float4 bb = *(const float4*)(b + c);
    float4 o;
    o.x = (v[4 * i + 0] - mu) * rs * gg.x + bb.x;
    o.y = (v[4 * i + 1] - mu) * rs * gg.y + bb.y;
    o.z = (v[4 * i + 2] - mu) * rs * gg.z + bb.z;
    o.w = (v[4 * i + 3] - mu) * rs * gg.w + bb.w;
    if (outf) *(float4*)(outf + c) = o;
    if (outb) { uint2 pk; pk.x = pack2(o.x, o.y); pk.y = pack2(o.z, o.w); *(uint2*)(outb + c) = pk; }
  }
}

DI void phase_ln_in(const Params& p, int bid, int nb) {
  const int tid_ = OPAQUE_TID(p), lane = tid_ & 63, wv = tid_ >> 6;
  for (int t = bid * NWAVES + wv; t < NTOK; t += nb * NWAVES) {
    float v[32];
    const float* xr = p.x + (size_t)t * DM;
#pragma unroll
    for (int i = 0; i < 8; ++i) {
      const float4 a = *(const float4*)(xr + (i * 64 + lane) * 4);
      v[4 * i] = a.x; v[4 * i + 1] = a.y; v[4 * i + 2] = a.z; v[4 * i + 3] = a.w;
    }
    ln_row_store(v, lane, p.ln_in_g, p.ln_in_b, nullptr, p.h0b + (size_t)t * DM);
  }
}

#define XB_TMO      128
#define XB_XCNT(j)  (256  + 64 * (j))
#define XB_XSUB(j)  (1280 + 64 * (j))
#define XB_XGEN(j)  (2304 + 64 * (j))
#define XB_TOP      3328
#define XB_TOPGEN   3392
#define XCD_BAR_WORDS 3456
#define XB_SPIN_CAP (1u << 18)
#define LAS __attribute__((address_space(3)))

__device__ __forceinline__ unsigned xb_ld(unsigned* p)              { return __hip_atomic_load(p, __ATOMIC_RELAXED, __HIP_MEMORY_SCOPE_AGENT); }
__device__ __forceinline__ unsigned xb_add(unsigned* p, unsigned v) { return __hip_atomic_fetch_add(p, v, __ATOMIC_RELAXED, __HIP_MEMORY_SCOPE_AGENT); }
__device__ __forceinline__ unsigned xb_xcc_id() { return (unsigned)__builtin_amdgcn_s_getreg((3 << 11) | 20) & 0xFu; }
#define XB_SPIN(cond, bar) do { unsigned _sp = 0; while (cond) { __builtin_amdgcn_s_sleep(1); \
    if ((++_sp & 255u) == 0u) { if (xb_ld(&(bar)[XB_TMO])) break; if (_sp > XB_SPIN_CAP) { atomicAdd(&(bar)[XB_TMO], 1u); break; } } } } while (0)

struct XcdBarrier {
    unsigned* bar; unsigned x;
    volatile LAS unsigned* st;
    unsigned G;
};

__device__ __forceinline__ XcdBarrier xcd_barrier_post(unsigned* bar, volatile LAS unsigned* st, unsigned G) {
    XcdBarrier b; b.bar = bar; b.x = xb_xcc_id(); b.st = st; b.G = G;
    if (threadIdx.x == 0) (void)xb_add(&bar[XB_XCNT(b.x)], 1u);
    return b;
}
__device__ __forceinline__ void xcd_barrier_complete(unsigned* bar, unsigned x, unsigned G, unsigned& nloc, unsigned& nx) {
    unsigned sum, cnt, mine, sp = 0u;
    for (;;) {
        sum = 0u; cnt = 0u; mine = 0u;
#pragma unroll
        for (unsigned j = 0; j < 16; ++j) { const unsigned c = xb_ld(&bar[XB_XCNT(j)]); sum += c; cnt += (c > 0u) ? 1u : 0u; mine = (j == x) ? c : mine; }
        if (sum == G) break;
        __builtin_amdgcn_s_sleep(1);
        if ((++sp & 255u) == 0u) { if (xb_ld(&bar[XB_TMO])) break; if (sp > XB_SPIN_CAP) { atomicAdd(&bar[XB_TMO], 1u); break; } }
    }
    nloc = mine > 0u ? mine : 1u; nx = cnt > 0u ? cnt : 1u;
}

__device__ __forceinline__ void xcd_barrier(const XcdBarrier& b) {
    asm volatile("s_waitcnt vmcnt(0)" ::: "memory");
    __syncthreads();
    if (threadIdx.x == 0) {
        unsigned* bar = b.bar;
        __builtin_amdgcn_s_waitcnt(0);
        unsigned nloc = b.st[0], nx = b.st[1];
        if (nloc == 0u) { xcd_barrier_complete(bar, b.x, b.G, nloc, nx); b.st[0] = nloc; b.st[1] = nx; }
        const unsigned old = xb_add(&bar[XB_XSUB(b.x)], 1u);
        const unsigned gen = old / nloc;
        if (old + 1u == (gen + 1u) * nloc) {
            __builtin_amdgcn_fence(__ATOMIC_RELEASE, "agent");
            asm volatile("s_waitcnt vmcnt(0)" ::: "memory");
            const unsigned og = xb_add(&bar[XB_TOP], 1u);
            const unsigned tg = og / nx;
            if (og + 1u == (tg + 1u) * nx) xb_add(&bar[XB_TOPGEN], 1u);
            else XB_SPIN(xb_ld(&bar[XB_TOPGEN]) == tg, bar);
            __builtin_amdgcn_fence(__ATOMIC_ACQUIRE, "agent");
            xb_add(&bar[XB_XGEN(b.x)], 1u);
            asm volatile("s_waitcnt vmcnt(0)" ::: "memory");
        } else {
            XB_SPIN(xb_ld(&bar[XB_XGEN(b.x)]) == gen, bar);
            __builtin_amdgcn_fence(__ATOMIC_ACQUIRE, "agent");
            asm volatile("s_waitcnt vmcnt(0)" ::: "memory");
        }
    }
    __syncthreads();
}

constexpr int HTB = 16384;
constexpr int G256_LDS = 8 * HTB;
#define G_SA(b, h) (((b) * 2 + (h)) * HTB)
#define G_SB(b, h) ((4 + (b) * 2 + (h)) * HTB)
typedef __attribute__((ext_vector_type(4))) float f32x4;
typedef __attribute__((ext_vector_type(4))) unsigned u32x4;
typedef __attribute__((ext_vector_type(2))) unsigned u32x2;

DI int lds_byte(int r, int c) { const int st = (r >> 4) * 2 + (c >> 5), rr = r & 15, cc = c & 31, ob = rr * 64 + cc * 2; return st * 1024 + (ob ^ (((ob >> 9) & 1) << 5)); }
DI void stage_rc(int b, int& R, int& C) { const int st = b / 1024, sb = b % 1024, swz = sb ^ (((sb >> 9) & 1) << 5); R = (st >> 1) * 16 + swz / 64; C = (st & 1) * 32 + (swz % 64) / 2; }
DI unsigned offb(unsigned row, unsigned ch) { return 256u * row + 16u * (ch ^ (((row & 3u) << 2) | ((row >> 2) & 3u))); }

DI f32x4 bufload4(__amdgpu_buffer_rsrc_t rs, unsigned voff, unsigned soff) {
#if defined(__HIP_DEVICE_COMPILE__)
  return __builtin_bit_cast(f32x4, __builtin_amdgcn_raw_buffer_load_b128(rs, voff, soff, 0));
#else
  return (f32x4){0.f, 0.f, 0.f, 0.f};
#endif
}
DI int tcol_p64(int lc) { return (lc & ~0x30) | ((lc & 0x10) << 1) | ((lc & 0x20) >> 1); }
DI int tcol_adj(int R) { return (R & 3) | (((R >> 4) & 1) << 2) | (((R >> 2) & 3) << 3) | (R & 0x60); }
DI int tcol_gu(int lc) { return ((lc & 0x30) << 1) | ((lc & 0x40) >> 2) | (lc & 15); }

#define G_WAIT_V(n) asm volatile("s_waitcnt vmcnt(" #n ")" ::: "memory")
#define G_WAIT_L0() asm volatile("s_waitcnt lgkmcnt(0)" ::: "memory")
#define G_BAR() __builtin_amdgcn_s_barrier()
#define G_SCHED() __builtin_amdgcn_sched_barrier(0)

template <class Cfg, int MODE = 0, bool TOPHALF = false>
DI void gemm256_unit(LDS_AS unsigned char* lds, const Cfg& cfg) {
  const int tid = OPAQUE_TID(cfg.p), wid = __builtin_amdgcn_readfirstlane(tid >> 6), lane = tid & 63, wr = wid >> 2, wc = wid & 3, fr = lane & 15, fq = lane >> 4;
  const int nt = cfg.nkt();
  constexpr bool act0 = true, act1 = !TOPHALF;
  unsigned voffA[2][2];
#pragma unroll
  for (int i = 0; i < 2; ++i) {
    int R, C; stage_rc(tid * 16 + i * 8192, R, C);
    voffA[0][i] = cfg.a_rowoff(R) + (unsigned)C * 2u;
    voffA[1][i] = cfg.a_rowoff(128 + R) + (unsigned)C * 2u;
  }
  const __amdgpu_buffer_rsrc_t rsA = __builtin_amdgcn_make_buffer_rsrc((void*)cfg.a_base(), 0, cfg.a_bytes(), 0x00020000);
  const __amdgpu_buffer_rsrc_t rsB = __builtin_amdgcn_make_buffer_rsrc((void*)cfg.b_base(), 0, cfg.b_bytes(), 0x00020000);
  const unsigned ldsw = (unsigned)__builtin_amdgcn_readfirstlane((int)(unsigned)(size_t)lds) + (unsigned)wid * 1024u;
#define G_STAGE_A(slot, half, kt) do { if (MODE == 3 || MODE == 4) break; _Pragma("unroll") for (int _i = 0; _i < 2; ++_i) { const unsigned _m0 = ldsw + (unsigned)((slot) + _i * 8192); const unsigned _so = (unsigned)(kt) * 128u; \
    asm volatile("s_mov_b32 m0, %0\n\ts_nop 4\n\tbuffer_load_dwordx4 %1, %2, %3 offen lds" :: "s"(_m0), "v"(voffA[half][_i]), "s"(rsA), "s"(_so) : "m0", "memory"); } } while (0)
  const int kk = tid >> 5, lc = (tid & 31) * 4;
  const int ldb = cfg.ldb();
  unsigned voffB[2];
  voffB[0] = (unsigned)(kk * ldb + cfg.b_gcol(0, lc)) * 4u;
  voffB[1] = (unsigned)(kk * ldb + cfg.b_gcol(1, lc)) * 4u;
  const int tc = Cfg::GU ? tcol_gu(lc) : tcol_p64(lc);
  const unsigned wofB = offb((unsigned)kk, (unsigned)(tc >> 3)) + ((tc & 4) ? 8u : 0u);
  const unsigned ldb64 = (unsigned)ldb * 256u;
  const unsigned ldb16 = (unsigned)ldb * 64u;
#define G_LOAD_B(dst, half, kt) do { if (MODE == 3 || MODE == 5) { _Pragma("unroll") for (int _i = 0; _i < 4; ++_i) asm volatile("" : "+v"(dst[_i])); break; } _Pragma("unroll") for (int _i = 0; _i < 4; ++_i) { const unsigned _so = (unsigned)(kt) * ldb64 + _i * ldb16; \
    asm volatile("s_nop 4\n\tbuffer_load_dwordx4 %0, %1, %2, %3 offen" : "=v"(dst[_i]) : "v"(voffB[half]), "s"(rsB), "s"(_so) : "memory"); } } while (0)
#define G_WAIT_B(n, r) asm volatile("s_waitcnt vmcnt(" #n ")" : "+v"(r[0]), "+v"(r[1]), "+v"(r[2]), "+v"(r[3]) :: "memory")
#define G_WRITE_B(slot, src) do { _Pragma("unroll") for (int _i = 0; _i < 4; ++_i) { u32x2 _pk; _pk.x = pack2(src[_i][0], src[_i][1]); _pk.y = pack2(src[_i][2], src[_i][3]); \
    *(LDS_AS u32x2*)(lds + (slot) + wofB + _i * 4096) = _pk; } } while (0)
  const int aoff = lds_byte(wr * 64 + fr, fq * 8);
  unsigned boff[2][2];
  {
    const unsigned q = (unsigned)(lane & 15) >> 2, pp = (unsigned)lane & 3u;
#pragma unroll
    for (int n = 0; n < 2; ++n)
#pragma unroll
      for (int t = 0; t < 2; ++t)
        boff[n][t] = offb(8u * fq + 4u * t + q, (unsigned)(4 * wc + 2 * n) + (pp >> 1)) + 8u * (pp & 1u);
  }
#define G_LDA(dst, slot) do { if (MODE == 6) { _Pragma("unroll") for (int m = 0; m < 4; ++m) _Pragma("unroll") for (int k = 0; k < 2; ++k) asm volatile("" : "+v"(dst[m][k])); break; } _Pragma("unroll") for (int m = 0; m < 4; ++m) _Pragma("unroll") for (int k = 0; k < 2; ++k) \
    dst[m][k] = *(const LDS_AS bf16x8*)(lds + (slot) + aoff + m * 2048 + k * 1024); } while (0)
#define G_LDB(dst, slot) do { if (MODE == 6) { _Pragma("unroll") for (int n = 0; n < 2; ++n) _Pragma("unroll") for (int k = 0; k < 2; ++k) asm volatile("" : "+v"(dst[n][k])); break; } _Pragma("unroll") for (int n = 0; n < 2; ++n) _Pragma("unroll") for (int k = 0; k < 2; ++k) { \
    const s16x4 _lo = __builtin_amdgcn_ds_read_tr16_b64_v4i16((LDS_AS s16x4*)(lds + (slot) + boff[n][0] + k * 8192)); \
    const s16x4 _hi = __builtin_amdgcn_ds_read_tr16_b64_v4i16((LDS_AS s16x4*)(lds + (slot) + boff[n][1] + k * 8192)); \
    dst[n][k] = __builtin_shufflevector(_lo, _hi, 0, 1, 2, 3, 4, 5, 6, 7); } } while (0)
#define G_MMA(ai, bj, At, Bf) do { if (!((ai) ? act1 : act0)) break; if (MODE == 2) { _Pragma("unroll") for (int m = 0; m < 4; ++m) _Pragma("unroll") for (int k = 0; k < 2; ++k) asm volatile("" :: "v"(At[m][k])); _Pragma("unroll") for (int n = 0; n < 2; ++n) _Pragma("unroll") for (int k = 0; k < 2; ++k) asm volatile("" :: "v"(Bf[n][k])); break; } __builtin_amdgcn_s_setprio(1); _Pragma("unroll") for (int m = 0; m < 4; ++m) _Pragma("unroll") for (int n = 0; n < 2; ++n) _Pragma("unroll") for (int k = 0; k < 2; ++k) \
    acc[ai][bj][m][n] = __builtin_amdgcn_mfma_f32_16x16x32_bf16(Bf[n][k], At[m][k], acc[ai][bj][m][n], 0, 0, 0); __builtin_amdgcn_s_setprio(0); } while (0)

#define G_MFMA4(ai, bj, At, Bf, m) do { if (!((ai) ? act1 : act0)) break; _Pragma("unroll") for (int n = 0; n < 2; ++n) _Pragma("unroll") for (int k = 0; k < 2; ++k) \
    acc[ai][bj][m][n] = __builtin_amdgcn_mfma_f32_16x16x32_bf16(Bf[n][k], At[m][k], acc[ai][bj][m][n], 0, 0, 0); } while (0)
#define G_WRITE_B2(slot, src, i0) do { if (MODE == 8) break; _Pragma("unroll") for (int _i = i0; _i < i0 + 2; ++_i) { u32x2 _pk; _pk.x = pack2(src[_i][0], src[_i][1]); _pk.y = pack2(src[_i][2], src[_i][3]); \
    *(LDS_AS u32x2*)(lds + (slot) + wofB + _i * 4096) = _pk; } } while (0)
#define G_LOAD_B2(dst, half, kt, i0) do { if (MODE == 3 || MODE == 5) { _Pragma("unroll") for (int _i = i0; _i < i0 + 2; ++_i) asm volatile("" : "+v"(dst[_i])); break; } \
    _Pragma("unroll") for (int _i = i0; _i < i0 + 2; ++_i) { const unsigned _so = (unsigned)(kt) * ldb64 + _i * ldb16; \
    asm volatile("s_nop 4\n\tbuffer_load_dwordx4 %0, %1, %2, %3 offen" : "=v"(dst[_i]) : "v"(voffB[half]), "s"(rsB), "s"(_so) : "memory"); } } while (0)
#define G_MMA_STAGE(ai, bj, At, Bf, slot, Rs, half, kt) do { if (MODE == 2) { G_MMA(ai, bj, At, Bf); G_WAIT_B(8, Rs); G_WRITE_B(slot, Rs); G_LOAD_B(Rs, half, kt); break; } \
    __builtin_amdgcn_s_setprio(1); \
    G_MFMA4(ai, bj, At, Bf, 0); G_SCHED(); G_WAIT_B(8, Rs); G_WRITE_B2(slot, Rs, 0); G_SCHED(); \
    G_MFMA4(ai, bj, At, Bf, 1); G_SCHED(); G_WRITE_B2(slot, Rs, 2); G_SCHED(); \
    G_MFMA4(ai, bj, At, Bf, 2); G_SCHED(); G_LOAD_B2(Rs, half, kt, 0); G_SCHED(); \
    G_MFMA4(ai, bj, At, Bf, 3); G_SCHED(); G_LOAD_B2(Rs, half, kt, 2); \
    __builtin_amdgcn_s_setprio(0); } while (0)
  f32x4 Ra[4], Rb[4];
  if (MODE == 3 || MODE == 5) { _Pragma("unroll") for (int i = 0; i < 4; ++i) { const float f = (float)((tid * 2654435761u + i * 40503u) & 0xffffu) * (1.f / 32768.f) - 1.f; Ra[i] = (f32x4){f, -f * 0.7f, f * 0.3f + 0.1f, 0.5f - f}; Rb[i] = (f32x4){0.2f - f, f * 0.9f, -f, f * 0.5f}; } }
  {
    G_STAGE_A(G_SA(0, 0), 0, 0); G_STAGE_A(G_SA(0, 1), 1, 0); G_STAGE_A(G_SA(1, 0), 0, 1);
    f32x4 X0[4], X1[4], X2[4];
    G_LOAD_B(X0, 1, 0); G_LOAD_B(X1, 0, 0); G_LOAD_B(X2, 1, 1); G_LOAD_B(Ra, 0, 1); G_LOAD_B(Rb, 1, (2 < nt ? 2 : 0));
    G_WAIT_B(8, X0); G_WAIT_B(8, X1); G_WAIT_B(8, X2);
    G_WRITE_B(G_SB(0, 1), X0); G_WRITE_B(G_SB(0, 0), X1); G_WRITE_B(G_SB(1, 1), X2);
    G_WAIT_B(0, Ra); G_WAIT_B(0, Rb);
    G_WAIT_L0();
    G_BAR();
  }
  f32x4 acc[2][2][4][2];
#pragma unroll
  for (int a = 0; a < 2; ++a)
#pragma unroll
    for (int b = 0; b < 2; ++b)
#pragma unroll
      for (int m = 0; m < 4; ++m)
#pragma unroll
        for (int n = 0; n < 2; ++n) acc[a][b][m][n] = (f32x4){0.f, 0.f, 0.f, 0.f};
  bf16x8 At[4][2], B0[2][2], B1[2][2];
  if (MODE == 6) { _Pragma("unroll") for (int m = 0; m < 4; ++m) _Pragma("unroll") for (int k = 0; k < 2; ++k) At[m][k] = (bf16x8){1, 2, 3, 4, 5, 6, 7, 8}; _Pragma("unroll") for (int n = 0; n < 2; ++n) _Pragma("unroll") for (int k = 0; k < 2; ++k) { B0[n][k] = (bf16x8){1, 2, 3, 4, 5, 6, 7, 8}; B1[n][k] = B0[n][k]; } }
  if (wr == 1 && MODE != 7) G_BAR();
#define G_LBAR() do { if (MODE != 7) G_BAR(); } while (0)
#pragma clang loop unroll(disable)
  for (int t = 0; t < nt; t += 2) {
    const int t1 = t + 1;
    const int t2 = (t + 2 < nt) ? t + 2 : 0;
    const int t3 = (t + 2 < nt) ? t + 3 : 1;
    const int t4 = (t + 4 < nt) ? t + 4 : (t + 4 - nt < nt ? t + 4 - nt : 0);
    G_LDB(B0, G_SB(0, 0)); G_LDA(At, G_SA(0, 0)); G_STAGE_A(G_SA(1, 1), 1, t1);
    G_LBAR(); G_WAIT_L0(); G_SCHED(); G_MMA(0, 0, At, B0); G_LBAR(); G_SCHED();
    G_LDB(B1, G_SB(0, 1));
    G_LBAR(); G_WAIT_L0(); G_SCHED(); G_MMA_STAGE(0, 1, At, B1, G_SB(1, 0), Ra, 0, t2); G_LBAR(); G_SCHED();
    G_LDA(At, G_SA(0, 1)); G_STAGE_A(G_SA(0, 0), 0, t2);
    G_LBAR(); G_WAIT_L0(); G_SCHED(); G_MMA(1, 1, At, B1); G_LBAR(); G_SCHED();
    G_LDB(B0, G_SB(0, 0));
    G_LBAR(); G_WAIT_L0(); G_SCHED(); G_MMA_STAGE(1, 0, At, B0, G_SB(0, 1), Rb, 1, t3); G_LBAR(); G_SCHED();
    G_LDB(B0, G_SB(1, 0)); G_LDA(At, G_SA(1, 0)); G_STAGE_A(G_SA(0, 1), 1, t2);
    G_LBAR(); G_WAIT_L0(); G_SCHED(); G_MMA(0, 0, At, B0); G_LBAR(); G_SCHED();
    G_LDB(B1, G_SB(1, 1));
    G_LBAR(); G_WAIT_L0(); G_SCHED(); G_MMA_STAGE(0, 1, At, B1, G_SB(0, 0), Ra, 0, t3); G_LBAR(); G_SCHED();
    G_LDA(At, G_SA(1, 1)); G_STAGE_A(G_SA(1, 0), 0, t3);
    G_LBAR(); G_WAIT_L0(); G_SCHED(); G_MMA(1, 1, At, B1); G_LBAR(); G_SCHED();
    G_LDB(B0, G_SB(1, 0));
    G_LBAR(); G_WAIT_L0(); G_SCHED(); G_MMA_STAGE(1, 0, At, B0, G_SB(1, 1), Rb, 1, t4); G_LBAR(); G_SCHED();
  }
  G_WAIT_B(0, Ra); G_WAIT_B(0, Rb); G_SCHED();
  if (wr == 0 && MODE != 7) G_BAR();
  {
    const int wid2 = wid, ln2 = lane_id_now(), wr2 = wid2 >> 2, wc2 = wid2 & 3, fr2 = ln2 & 15, fq2 = ln2 >> 4;
#pragma unroll
    for (int ai = 0; ai < 2; ++ai)
#pragma unroll
      for (int m = 0; m < 4; ++m)
#pragma unroll
        for (int bj = 0; bj < 2; ++bj)
          if (MODE == 0) cfg.epi(ai * 128 + wr2 * 64 + m * 16 + fr2, bj, wc2, fq2, acc[ai][bj][m][0], acc[ai][bj][m][1]);
          else asm volatile("" :: "v"(acc[ai][bj][m][0]), "v"(acc[ai][bj][m][1]));
  }
  G_BAR();
#undef G_STAGE_A
#undef G_LOAD_B
#undef G_WRITE_B
#undef G_LDA
#undef G_LDB
#undef G_MMA
#undef G_MFMA4
#undef G_WRITE_B2
#undef G_LOAD_B2
#undef G_MMA_STAGE
}

constexpr int F8_SA_BYTES = 16384, F8_SB_BYTES = 128 * 144;
constexpr int G256F8_LDS = 4 * F8_SA_BYTES + 4 * F8_SB_BYTES;
#define F_SA(b, h) (((b) * 2 + (h)) * F8_SA_BYTES)
#define F_SB(b, h) (4 * F8_SA_BYTES + ((b) * 2 + (h)) * F8_SB_BYTES)
typedef __attribute__((ext_vector_type(8))) int i32x8;
typedef __attribute__((ext_vector_type(4))) int i32x4;

template <class Cfg, bool TOPHALF = false>
DI void gemm256f8_unit(LDS_AS unsigned char* lds, const Cfg& cfg) {
  const int tid = OPAQUE_TID(cfg.p), wid = __builtin_amdgcn_readfirstlane(tid >> 6), lane = tid & 63, wr = wid >> 2, wc = wid & 3, fr = lane & 15, fq = lane >> 4;
  const int nt = cfg.nkt();
  constexpr bool act1 = !TOPHALF;
  unsigned voffA[2][2];
#pragma unroll
  for (int i = 0; i < 2; ++i) {
    const int r = 8 * (wid + 8 * i) + (lane >> 3);
    const unsigned cofs = 16u * (((unsigned)lane & 7u) ^ (((unsigned)lane >> 3) & 7u));
    voffA[0][i] = cfg.a_rowoff(r) + cofs;
    voffA[1][i] = cfg.a_rowoff(128 + r) + cofs;
  }
  const __amdgpu_buffer_rsrc_t rsA = __builtin_amdgcn_make_buffer_rsrc((void*)cfg.a_base(), 0, cfg.a_bytes(), 0x00020000);
  const __amdgpu_buffer_rsrc_t rsB = __builtin_amdgcn_make_buffer_rsrc((void*)cfg.b_base(), 0, cfg.b_bytes(), 0x00020000);
  const unsigned ldsw = (unsigned)__builtin_amdgcn_readfirstlane((int)(unsigned)(size_t)lds) + (unsigned)wid * 1024u;
#define F_STAGE_A(slot, half, kt) do { _Pragma("unroll") for (int _i = 0; _i < 2; ++_i) { const unsigned _m0 = ldsw + (unsigned)((slot) + _i * 8192); const unsigned _so = (unsigned)(kt) * 128u; \
    asm volatile("s_mov_b32 m0, %0\n\ts_nop 4\n\tbuffer_load_dwordx4 %1, %2, %3 offen lds" :: "s"(_m0), "v"(voffA[half][_i]), "s"(rsA), "s"(_so) : "m0", "memory"); } } while (0)
  const int kg = tid >> 5, lc = (tid & 31) * 4;
  const int ldb = cfg.ldb();
  unsigned voffB[2];
  voffB[0] = (unsigned)(4 * kg * ldb + cfg.b_gcol(0, lc)) * 4u;
  voffB[1] = (unsigned)(4 * kg * ldb + cfg.b_gcol(1, lc)) * 4u;
  const int tc = Cfg::GU ? tcol_gu(lc) : tcol_p64(lc);
  const unsigned wofB = (unsigned)tc * 144u + 4u * (unsigned)kg;
  const unsigned ldb128 = (unsigned)ldb * 512u;
  const unsigned ldb1 = (unsigned)ldb * 4u;
  const float bmul = cfg.bmul();
#define F_LOAD_B4(dst, half, kt, b) do { _Pragma("unroll") for (int _r = 0; _r < 4; ++_r) { const unsigned _so = (unsigned)(kt) * ldb128 + (unsigned)(64 * (b) + _r) * ldb1; \
    asm volatile("s_nop 4\n\tbuffer_load_dwordx4 %0, %1, %2, %3 offen" : "=v"(dst[4 * (b) + _r]) : "v"(voffB[half]), "s"(rsB), "s"(_so) : "memory"); } } while (0)
#define F_LOAD_B(dst, half, kt) do { F_LOAD_B4(dst, half, kt, 0); F_LOAD_B4(dst, half, kt, 1); } while (0)
#define F_WRITE_B4(slot, src, b) do { _Pragma("unroll") for (int _j = 0; _j < 4; ++_j) { int _pk = 0; \
    _pk = __builtin_amdgcn_cvt_pk_fp8_f32(src[4 * (b) + 0][_j] * bmul, src[4 * (b) + 1][_j] * bmul, _pk, false); \
    _pk = __builtin_amdgcn_cvt_pk_fp8_f32(src[4 * (b) + 2][_j] * bmul, src[4 * (b) + 3][_j] * bmul, _pk, true); \
    *(LDS_AS int*)(lds + (slot) + wofB + _j * 144 + (b) * 64) = _pk; } } while (0)
#define F_WRITE_B(slot, src) do { F_WRITE_B4(slot, src, 0); F_WRITE_B4(slot, src, 1); } while (0)
#define F_WAIT_B(n, r) asm volatile("s_waitcnt vmcnt(" #n ")" : "+v"(r[0]), "+v"(r[1]), "+v"(r[2]), "+v"(r[3]), "+v"(r[4]), "+v"(r[5]), "+v"(r[6]), "+v"(r[7]) :: "memory")
  unsigned aoff[2];
  aoff[0] = (unsigned)(64 * wr + fr) * 128u + 16u * ((2u * fq) ^ ((unsigned)fr & 7u));
  aoff[1] = (unsigned)(64 * wr + fr) * 128u + 16u * ((2u * fq + 1u) ^ ((unsigned)fr & 7u));
  const unsigned boff = (unsigned)(32 * wc + fr) * 144u + 32u * fq;
#define F_LDA(dst, slot) do { _Pragma("unroll") for (int m = 0; m < 4; ++m) { \
    const i32x4 _lo = *(const LDS_AS i32x4*)(lds + (slot) + aoff[0] + m * 2048); const i32x4 _hi = *(const LDS_AS i32x4*)(lds + (slot) + aoff[1] + m * 2048); \
    dst[m] = __builtin_shufflevector(_lo, _hi, 0, 1, 2, 3, 4, 5, 6, 7); } } while (0)
#define F_LDB(dst, slot) do { _Pragma("unroll") for (int n = 0; n < 2; ++n) { \
    const i32x4 _lo = *(const LDS_AS i32x4*)(lds + (slot) + boff + n * 2304); const i32x4 _hi = *(const LDS_AS i32x4*)(lds + (slot) + boff + n * 2304 + 16); \
    dst[n] = __builtin_shufflevector(_lo, _hi, 0, 1, 2, 3, 4, 5, 6, 7); } } while (0)
  const int scw = cfg.scale_w(), scx = cfg.scale_x();
#define F_MFMA2(ai, bj, At, Bf, m) do { if ((ai) && !act1) break; _Pragma("unroll") for (int n = 0; n < 2; ++n) \
    acc[ai][bj][m][n] = __builtin_amdgcn_mfma_scale_f32_16x16x128_f8f6f4(Bf[n], At[m], acc[ai][bj][m][n], 0, 0, 0, scw, 0, scx); } while (0)
#define F_MMA(ai, bj, At, Bf) do { __builtin_amdgcn_s_setprio(1); _Pragma("unroll") for (int m = 0; m < 4; ++m) F_MFMA2(ai, bj, At, Bf, m); __builtin_amdgcn_s_setprio(0); } while (0)
#define F_MMA_STAGE(ai, bj, At, Bf, slot, Rs, half, kt) do { __builtin_amdgcn_s_setprio(1); \
    F_MFMA2(ai, bj, At, Bf, 0); G_SCHED(); F_WAIT_B(2, Rs); F_WRITE_B4(slot, Rs, 0); G_SCHED(); \
    F_MFMA2(ai, bj, At, Bf, 1); G_SCHED(); F_WRITE_B4(slot, Rs, 1); G_SCHED(); \
    F_MFMA2(ai, bj, At, Bf, 2); G_SCHED(); F_LOAD_B4(Rs, half, kt, 0); G_SCHED(); \
    F_MFMA2(ai, bj, At, Bf, 3); G_SCHED(); F_LOAD_B4(Rs, half, kt, 1); \
    __builtin_amdgcn_s_setprio(0); } while (0)
  f32x4 R[8];
  {
    F_STAGE_A(F_SA(0, 0), 0, 0); F_STAGE_A(F_SA(0, 1), 1, 0); F_STAGE_A(F_SA(1, 0), 0, 1);
    f32x4 X0[8], X1[8], X2[8];
    F_LOAD_B(X0, 1, 0); F_LOAD_B(X1, 0, 0); F_LOAD_B(X2, 1, 1); F_LOAD_B(R, 0, 1);
    F_WAIT_B(8, X0); F_WAIT_B(8, X1); F_WAIT_B(8, X2);
    F_WRITE_B(F_SB(0, 1), X0); F_WRITE_B(F_SB(0, 0), X1); F_WRITE_B(F_SB(1, 1), X2);
    G_WAIT_L0();
    G_BAR();
  }
  f32x4 acc[2][2][4][2];
#pragma unroll
  for (int a = 0; a < 2; ++a)
#pragma unroll
    for (int b = 0; b < 2; ++b)
#pragma unroll
      for (int m = 0; m < 4; ++m)
#pragma unroll
        for (int n = 0; n < 2; ++n) acc[a][b][m][n] = (f32x4){0.f, 0.f, 0.f, 0.f};
  i32x8 At[4], B0[2], B1[2];
  if (wr == 1) G_BAR();
#pragma clang loop unroll(disable)
  for (int t = 0; t < nt; t += 2) {
    const int t1 = t + 1;
    const int t2 = (t + 2 < nt) ? t + 2 : 0;
    const int t3 = (t + 2 < nt) ? t + 3 : 1;
    F_LDB(B0, F_SB(0, 0)); F_LDA(At, F_SA(0, 0)); F_STAGE_A(F_SA(1, 1), 1, t1);
    G_BAR(); G_WAIT_L0(); G_SCHED(); F_MMA(0, 0, At, B0); G_BAR(); G_SCHED();
    F_LDB(B1, F_SB(0, 1));
    G_BAR(); G_WAIT_L0(); G_SCHED(); F_MMA_STAGE(0, 1, At, B1, F_SB(1, 0), R, 1, t2); G_BAR(); G_SCHED();
    F_LDA(At, F_SA(0, 1)); F_STAGE_A(F_SA(0, 0), 0, t2);
    G_BAR(); G_WAIT_L0(); G_SCHED(); F_MMA(1, 1, At, B1); G_BAR(); G_SCHED();
    F_LDB(B0, F_SB(0, 0));
    G_BAR(); G_WAIT_L0(); G_SCHED(); F_MMA_STAGE(1, 0, At, B0, F_SB(0, 1), R, 0, t2); G_BAR(); G_SCHED();
    F_LDB(B0, F_SB(1, 0)); F_LDA(At, F_SA(1, 0)); F_STAGE_A(F_SA(0, 1), 1, t2);
    G_BAR(); G_WAIT_L0(); G_SCHED(); F_MMA(0, 0, At, B0); G_BAR(); G_SCHED();
    F_LDB(B1, F_SB(1, 1));
    G_BAR(); G_WAIT_L0(); G_SCHED(); F_MMA_STAGE(0, 1, At, B1, F_SB(0, 0), R, 1, t3); G_BAR(); G_SCHED();
    F_LDA(At, F_SA(1, 1)); F_STAGE_A(F_SA(1, 0), 0, t3);
    G_BAR(); G_WAIT_L0(); G_SCHED(); F_MMA(1, 1, At, B1); G_BAR(); G_SCHED();
    F_LDB(B0, F_SB(1, 0));
    G_BAR(); G_WAIT_L0(); G_SCHED(); F_MMA_STAGE(1, 0, At, B0, F_SB(1, 1), R, 0, t3); G_BAR(); G_SCHED();
  }
  F_WAIT_B(0, R); G_SCHED();
  if (wr == 0) G_BAR();
  {
    const int wid2 = wid, ln2 = lane_id_now(), wr2 = wid2 >> 2, wc2 = wid2 & 3, fr2 = ln2 & 15, fq2 = ln2 >> 4;
#pragma unroll
    for (int ai = 0; ai < 2; ++ai)
#pragma unroll
      for (int m = 0; m < 4; ++m)
#pragma unroll
        for (int bj = 0; bj < 2; ++bj)
          cfg.epi(ai * 128 + wr2 * 64 + m * 16 + fr2, bj, wc2, fq2, acc[ai][bj][m][0], acc[ai][bj][m][1]);
  }
  G_BAR();
#undef F_STAGE_A
#undef F_LOAD_B4
#undef F_LOAD_B
#undef F_WRITE_B4
#undef F_WRITE_B
#undef F_WAIT_B
#undef F_LDA
#undef F_LDB
#undef F_MFMA2
#undef F_MMA
#undef F_MMA_STAGE
}

template <class Cfg>
DI void gemm256dma_unit(LDS_AS unsigned char* lds, const Cfg& cfg) {
  const int tid = OPAQUE_TID(cfg.p), wid = __builtin_amdgcn_readfirstlane(tid >> 6), lane = tid & 63, wr = wid >> 2, wc = wid & 3, fr = lane & 15, fq = lane >> 4;
  const int nt = cfg.nkt();
  unsigned voffA[2][2], voffB[2][2];
#pragma unroll
  for (int i = 0; i < 2; ++i) {
    int R, C; stage_rc(tid * 16 + i * 8192, R, C);
    voffA[0][i] = cfg.a_rowoff(R) + (unsigned)C * 2u;
    voffA[1][i] = cfg.a_rowoff(128 + R) + (unsigned)C * 2u;
    voffB[0][i] = cfg.bt_rowoff(0, R) + (unsigned)C * 2u;
    voffB[1][i] = cfg.bt_rowoff(1, R) + (unsigned)C * 2u;
  }
  const __amdgpu_buffer_rsrc_t rsA = __builtin_amdgcn_make_buffer_rsrc((void*)cfg.a_base(), 0, cfg.a_bytes(), 0x00020000);
  const __amdgpu_buffer_rsrc_t rsB = __builtin_amdgcn_make_buffer_rsrc((void*)cfg.bt_base(), 0, cfg.bt_bytes(), 0x00020000);
  const unsigned ldsw = (unsigned)__builtin_amdgcn_readfirstlane((int)(unsigned)(size_t)lds) + (unsigned)wid * 1024u;
#define D_STAGE(rs, voff, slot, half, kt) do { _Pragma("unroll") for (int _i = 0; _i < 2; ++_i) { const unsigned _m0 = ldsw + (unsigned)((slot) + _i * 8192); const unsigned _so = (unsigned)(kt) * 128u; \
    asm volatile("s_mov_b32 m0, %0\n\ts_nop 4\n\tbuffer_load_dwordx4 %1, %2, %3 offen lds" :: "s"(_m0), "v"(voff[half][_i]), "s"(rs), "s"(_so) : "m0", "memory"); } } while (0)
#define D_STAGE_A(slot, half, kt) D_STAGE(rsA, voffA, slot, half, kt)
#define D_STAGE_B(slot, half, kt) D_STAGE(rsB, voffB, slot, half, kt)
  const int aoff = lds_byte(wr * 64 + fr, fq * 8), boff = lds_byte(wc * 32 + fr, fq * 8);
#define D_LDA(dst, slot) do { _Pragma("unroll") for (int m = 0; m < 4; ++m) _Pragma("unroll") for (int k = 0; k < 2; ++k) \
    dst[m][k] = *(const LDS_AS bf16x8*)(lds + (slot) + aoff + m * 2048 + k * 1024); } while (0)
#define D_LDB(dst, slot) do { _Pragma("unroll") for (int n = 0; n < 2; ++n) _Pragma("unroll") for (int k = 0; k < 2; ++k) \
    dst[n][k] = *(const LDS_AS bf16x8*)(lds + (slot) + boff + n * 2048 + k * 1024); } while (0)
#define D_MMA(ai, bj, At, Bf) do { __builtin_amdgcn_s_setprio(1); _Pragma("unroll") for (int m = 0; m < 4; ++m) _Pragma("unroll") for (int n = 0; n < 2; ++n) _Pragma("unroll") for (int k = 0; k < 2; ++k) \
    acc[ai][bj][m][n] = __builtin_amdgcn_mfma_f32_16x16x32_bf16(Bf[n][k], At[m][k], acc[ai][bj][m][n], 0, 0, 0); __builtin_amdgcn_s_setprio(0); } while (0)
#define D_WAIT_L(n) asm volatile("s_waitcnt lgkmcnt(" #n ")" ::: "memory")
  f32x4 acc[2][2][4][2];
#pragma unroll
  for (int a = 0; a < 2; ++a)
#pragma unroll
    for (int b = 0; b < 2; ++b)
#pragma unroll
      for (int m = 0; m < 4; ++m)
#pragma unroll
        for (int n = 0; n < 2; ++n) acc[a][b][m][n] = (f32x4){0.f, 0.f, 0.f, 0.f};
  bf16x8 At[4][2], B0[2][2], B1[2][2];
  D_STAGE_B(G_SB(0, 0), 0, 0); D_STAGE_A(G_SA(0, 0), 0, 0); D_STAGE_B(G_SB(0, 1), 1, 0); D_STAGE_A(G_SA(0, 1), 1, 0);
  if (wr == 1) G_BAR();
  G_WAIT_V(4); G_BAR();
  D_STAGE_B(G_SB(1, 0), 0, 1); D_STAGE_A(G_SA(1, 0), 0, 1); D_STAGE_B(G_SB(1, 1), 1, 1);
  G_WAIT_V(6); G_BAR();
#pragma clang loop unroll(disable)
  for (int t = 0; t < nt; t += 2) {
    const int t1 = t + 1;
    const int t2 = (t + 2 < nt) ? t + 2 : 0;
    const int t3 = (t + 2 < nt) ? t + 3 : 1;
    D_LDB(B0, G_SB(0, 0)); G_SCHED(); D_LDA(At, G_SA(0, 0)); D_STAGE_A(G_SA(1, 1), 1, t1);
    D_WAIT_L(8); G_BAR(); D_WAIT_L(0); G_SCHED(); D_MMA(0, 0, At, B0); G_BAR(); G_SCHED();
    D_LDB(B1, G_SB(0, 1)); D_STAGE_B(G_SB(0, 0), 0, t2);
    G_BAR(); D_WAIT_L(0); G_SCHED(); D_MMA(0, 1, At, B1); G_BAR(); G_SCHED();
    D_LDA(At, G_SA(0, 1)); D_STAGE_A(G_SA(0, 0), 0, t2);
    G_BAR(); D_WAIT_L(0); G_SCHED(); D_MMA(1, 0, At, B0); G_BAR(); G_SCHED();
    D_STAGE_B(G_SB(0, 1), 1, t2);
    G_WAIT_V(6); G_BAR(); G_SCHED(); D_MMA(1, 1, At, B1); G_BAR(); G_SCHED();
    D_LDB(B0, G_SB(1, 0)); G_SCHED(); D_LDA(At, G_SA(1, 0)); D_STAGE_A(G_SA(0, 1), 1, t2);
    D_WAIT_L(8); G_BAR(); D_WAIT_L(0); G_SCHED(); D_MMA(0, 0, At, B0); G_BAR(); G_SCHED();
    D_LDB(B1, G_SB(1, 1)); D_STAGE_B(G_SB(1, 0), 0, t3);
    G_BAR(); D_WAIT_L(0); G_SCHED(); D_MMA(0, 1, At, B1); G_BAR(); G_SCHED();
    D_LDA(At, G_SA(1, 1)); D_STAGE_A(G_SA(1, 0), 0, t3);
    G_BAR(); D_WAIT_L(0); G_SCHED(); D_MMA(1, 0, At, B0); G_BAR(); G_SCHED();
    D_STAGE_B(G_SB(1, 1), 1, t3);
    G_WAIT_V(6); G_BAR(); G_SCHED(); D_MMA(1, 1, At, B1); G_BAR(); G_SCHED();
  }
  G_WAIT_V(0);
  if (wr == 0) G_BAR();
  {
    const int wid2 = wid, ln2 = lane_id_now(), wr2 = wid2 >> 2, wc2 = wid2 & 3, fr2 = ln2 & 15, fq2 = ln2 >> 4;
#pragma unroll
    for (int ai = 0; ai < 2; ++ai)
#pragma unroll
      for (int m = 0; m < 4; ++m)
#pragma unroll
        for (int bj = 0; bj < 2; ++bj)
          cfg.epi(ai * 128 + wr2 * 64 + m * 16 + fr2, bj, wc2, fq2, acc[ai][bj][m][0], acc[ai][bj][m][1]);
  }
  G_BAR();
#undef D_STAGE
#undef D_STAGE_A
#undef D_STAGE_B
#undef D_LDA
#undef D_LDB
#undef D_MMA
#undef D_WAIT_L
}

#ifndef F8_PEEL
#define F8_PEEL 0
#endif
#ifndef EPI_HOIST
#define EPI_HOIST 1
#endif
template <class Cfg>
DI void f8dma_issue_prologue(LDS_AS unsigned char* lds, const Cfg& cfg) {
  const int tid = OPAQUE_TID(cfg.p), wid = __builtin_amdgcn_readfirstlane(tid >> 6), lane = tid & 63;
  unsigned voffA[2][2], voffB0;
#pragma unroll
  for (int i = 0; i < 2; ++i) {
    const int r = 8 * (wid + 8 * i) + (lane >> 3);
    const unsigned cofs = 16u * (((unsigned)lane & 7u) ^ (((unsigned)lane >> 3) & 7u));
    voffA[0][i] = cfg.a_rowoff(r) + cofs;
    voffA[1][i] = cfg.a_rowoff(128 + r) + cofs;
    if (i == 0) voffB0 = cfg.bt_rowoff(0, r) + cofs;
  }
  const unsigned bt_half = cfg.bt_rowoff(1, 0) - cfg.bt_rowoff(0, 0), bt_piece = cfg.bt_rowoff(0, 64) - cfg.bt_rowoff(0, 0);
  const __amdgpu_buffer_rsrc_t rsA = __builtin_amdgcn_make_buffer_rsrc((void*)cfg.a_base(), 0, cfg.a_bytes(), 0x00020000);
  const __amdgpu_buffer_rsrc_t rsB = __builtin_amdgcn_make_buffer_rsrc((void*)cfg.bt_base(), 0, cfg.bt_bytes(), 0x00020000);
  const unsigned ldsw = (unsigned)__builtin_amdgcn_readfirstlane((int)(unsigned)(size_t)lds) + (unsigned)wid * 1024u;
#define P_STAGE_A(slot, half, kt) do { _Pragma("unroll") for (int _i = 0; _i < 2; ++_i) { const unsigned _m0 = ldsw + (unsigned)((slot) + _i * 8192); const unsigned _so = (unsigned)(kt) * 128u; \
    asm volatile("s_mov_b32 m0, %0\n\ts_nop 4\n\tbuffer_load_dwordx4 %1, %2, %3 offen lds" :: "s"(_m0), "v"(voffA[half][_i]), "s"(rsA), "s"(_so) : "m0", "memory"); } } while (0)
#define P_STAGE_B(slot, half, kt) do { _Pragma("unroll") for (int _i = 0; _i < 2; ++_i) { const unsigned _m0 = ldsw + (unsigned)((slot) + _i * 8192); const unsigned _so = (unsigned)(kt) * 128u + (half) * bt_half + _i * bt_piece; \
    asm volatile("s_mov_b32 m0, %0\n\ts_nop 4\n\tbuffer_load_dwordx4 %1, %2, %3 offen lds" :: "s"(_m0), "v"(voffB0), "s"(rsB), "s"(_so) : "m0", "memory"); } } while (0)
  P_STAGE_B(G_SB(0, 0), 0, 0); P_STAGE_A(G_SA(0, 0), 0, 0); P_STAGE_B(G_SB(0, 1), 1, 0); P_STAGE_A(G_SA(0, 1), 1, 0);
  P_STAGE_B(G_SB(1, 0), 0, 1); P_STAGE_A(G_SA(1, 0), 0, 1); P_STAGE_B(G_SB(1, 1), 1, 1);
#undef P_STAGE_A
#undef P_STAGE_B
}
constexpr int F8_STASH = G256F8_LDS + 1024;
template <class Cfg>
DI void f8dma_issue_prologue_st(LDS_AS unsigned char* lds, const Cfg& cfg) {
  const int tid = OPAQUE_TID(cfg.p), wid = __builtin_amdgcn_readfirstlane(tid >> 6), lane = tid & 63;
  const LDS_AS unsigned* stash = (const LDS_AS unsigned*)(lds + F8_STASH);
  unsigned voffA[2][2], voffB0;
  voffA[0][0] = stash[tid]; voffA[0][1] = stash[512 + tid]; voffA[1][0] = stash[1024 + tid]; voffA[1][1] = stash[1536 + tid];
  {
    const int r = 8 * wid + (lane >> 3);
    const unsigned cofs = 16u * (((unsigned)lane & 7u) ^ (((unsigned)lane >> 3) & 7u));
    voffB0 = cfg.bt_rowoff(0, r) + cofs;
  }
  const unsigned bt_half = cfg.bt_rowoff(1, 0) - cfg.bt_rowoff(0, 0), bt_piece = cfg.bt_rowoff(0, 64) - cfg.bt_rowoff(0, 0);
  const __amdgpu_buffer_rsrc_t rsA = __builtin_amdgcn_make_buffer_rsrc((void*)cfg.a_base(), 0, cfg.a_bytes(), 0x00020000);
  const __amdgpu_buffer_rsrc_t rsB = __builtin_amdgcn_make_buffer_rsrc((void*)cfg.bt_base(), 0, cfg.bt_bytes(), 0x00020000);
  const unsigned ldsw = (unsigned)__builtin_amdgcn_readfirstlane((int)(unsigned)(size_t)lds) + (unsigned)wid * 1024u;
#define P_STAGE_A(slot, half, kt) do { _Pragma("unroll") for (int _i = 0; _i < 2; ++_i) { const unsigned _m0 = ldsw + (unsigned)((slot) + _i * 8192); const unsigned _so = (unsigned)(kt) * 128u; \
    asm volatile("s_mov_b32 m0, %0\n\ts_nop 4\n\tbuffer_load_dwordx4 %1, %2, %3 offen lds" :: "s"(_m0), "v"(voffA[half][_i]), "s"(rsA), "s"(_so) : "m0", "memory"); } } while (0)
#define P_STAGE_B(slot, half, kt) do { _Pragma("unroll") for (int _i = 0; _i < 2; ++_i) { const unsigned _m0 = ldsw + (unsigned)((slot) + _i * 8192); const unsigned _so = (unsigned)(kt) * 128u + (half) * bt_half + _i * bt_piece; \
    asm volatile("s_mov_b32 m0, %0\n\ts_nop 4\n\tbuffer_load_dwordx4 %1, %2, %3 offen lds" :: "s"(_m0), "v"(voffB0), "s"(rsB), "s"(_so) : "m0", "memory"); } } while (0)
  P_STAGE_B(G_SB(0, 0), 0, 0); P_STAGE_A(G_SA(0, 0), 0, 0); P_STAGE_B(G_SB(0, 1), 1, 0); P_STAGE_A(G_SA(0, 1), 1, 0);
  P_STAGE_B(G_SB(1, 0), 0, 1); P_STAGE_A(G_SA(1, 0), 0, 1); P_STAGE_B(G_SB(1, 1), 1, 1);
#undef P_STAGE_A
#undef P_STAGE_B
}
template <class Cfg, bool TOPHALF = false, bool PRE = false, int PMODE = 0>
DI void gemm256f8dma_unit(LDS_AS unsigned char* lds, const Cfg& cfg, bool has_nxt, const Cfg& nxt) {
  const int tid = OPAQUE_TID(cfg.p), wid = __builtin_amdgcn_readfirstlane(tid >> 6), lane = tid & 63, wr = wid >> 2, wc = wid & 3, fr = lane & 15, fq = lane >> 4;
  const int nt = PMODE == 2 ? cfg.nkt() / 2 : cfg.nkt();
  unsigned voffA[2][2], voffB0;
  {
    LDS_AS unsigned* stash = (LDS_AS unsigned*)(lds + F8_STASH);
    if (PRE) { voffA[0][0] = stash[tid]; voffA[0][1] = stash[512 + tid]; voffA[1][0] = stash[1024 + tid]; voffA[1][1] = stash[1536 + tid]; }
#pragma unroll
    for (int i = 0; i < 2; ++i) {
      const int r = 8 * (wid + 8 * i) + (lane >> 3);
      const unsigned cofs = 16u * (((unsigned)lane & 7u) ^ (((unsigned)lane >> 3) & 7u));
      if (!PRE) { voffA[0][i] = cfg.a_rowoff(r) + cofs; voffA[1][i] = cfg.a_rowoff(128 + r) + cofs; }
      if (i == 0) voffB0 = cfg.bt_rowoff(0, r) + cofs;
    }
    if (has_nxt) {
#pragma unroll
      for (int i = 0; i < 2; ++i) {
        const int r = 8 * (wid + 8 * i) + (lane >> 3);
        const unsigned cofs = 16u * (((unsigned)lane & 7u) ^ (((unsigned)lane >> 3) & 7u));
        stash[i * 512 + tid] = nxt.a_rowoff(r) + cofs;
        stash[(2 + i) * 512 + tid] = nxt.a_rowoff(128 + r) + cofs;
      }
    }
  }
  const unsigned bt_half = cfg.bt_rowoff(1, 0) - cfg.bt_rowoff(0, 0), bt_piece = cfg.bt_rowoff(0, 64) - cfg.bt_rowoff(0, 0);
  const __amdgpu_buffer_rsrc_t rsA = __builtin_amdgcn_make_buffer_rsrc((void*)cfg.a_base(), 0, cfg.a_bytes(), 0x00020000);
  const __amdgpu_buffer_rsrc_t rsB = __builtin_amdgcn_make_buffer_rsrc((void*)cfg.bt_base(), 0, cfg.bt_bytes(), 0x00020000);
  const unsigned ldsw = (unsigned)__builtin_amdgcn_readfirstlane((int)(unsigned)(size_t)lds) + (unsigned)wid * 1024u;
#define D_STAGE(rs, voff, slot, half, kt) do { _Pragma("unroll") for (int _i = 0; _i < 2; ++_i) { const unsigned _m0 = ldsw + (unsigned)((slot) + _i * 8192); const unsigned _so = (unsigned)(kt) * 128u; \
    asm volatile("s_mov_b32 m0, %0\n\ts_nop 4\n\tbuffer_load_dwordx4 %1, %2, %3 offen lds" :: "s"(_m0), "v"(voff[half][_i]), "s"(rs), "s"(_so) : "m0", "memory"); } } while (0)
#define D_STAGE_A(slot, half, kt) D_STAGE(rsA, voffA, slot, half, kt)
#define D_STAGE_B(slot, half, kt) do { _Pragma("unroll") for (int _i = 0; _i < 2; ++_i) { const unsigned _m0 = ldsw + (unsigned)((slot) + _i * 8192); const unsigned _so = (unsigned)(kt) * 128u + (half) * bt_half + _i * bt_piece; \
    asm volatile("s_mov_b32 m0, %0\n\ts_nop 4\n\tbuffer_load_dwordx4 %1, %2, %3 offen lds" :: "s"(_m0), "v"(voffB0), "s"(rsB), "s"(_so) : "m0", "memory"); } } while (0)
  unsigned aoff[2], boff[2];
#pragma unroll
  for (int j = 0; j < 2; ++j) {
    aoff[j] = (unsigned)(64 * wr + fr) * 128u + 16u * ((2u * fq + j) ^ ((unsigned)fr & 7u));
    boff[j] = (unsigned)(32 * wc + fr) * 128u + 16u * ((2u * fq + j) ^ ((unsigned)fr & 7u));
  }
#define D_LDA(dst, slot) do { _Pragma("unroll") for (int m = 0; m < 4; ++m) { \
    const i32x4 _lo = *(const LDS_AS i32x4*)(lds + (slot) + aoff[0] + m * 2048); const i32x4 _hi = *(const LDS_AS i32x4*)(lds + (slot) + aoff[1] + m * 2048); \
    dst[m] = __builtin_shufflevector(_lo, _hi, 0, 1, 2, 3, 4, 5, 6, 7); } } while (0)
#define D_LDB(dst, slot) do { _Pragma("unroll") for (int n = 0; n < 2; ++n) { \
    const i32x4 _lo = *(const LDS_AS i32x4*)(lds + (slot) + boff[0] + n * 2048); const i32x4 _hi = *(const LDS_AS i32x4*)(lds + (slot) + boff[1] + n * 2048); \
    dst[n] = __builtin_shufflevector(_lo, _hi, 0, 1, 2, 3, 4, 5, 6, 7); } } while (0)
  const int scw = cfg.scale_w(), scx = cfg.scale_x();
#define D_MMA(ai, bj, At, Bf) do { if ((ai) && TOPHALF) break; __builtin_amdgcn_s_setprio(1); _Pragma("unroll") for (int m = 0; m < 4; ++m) _Pragma("unroll") for (int n = 0; n < 2; ++n) \
    acc[ai][bj][m][n] = __builtin_amdgcn_mfma_scale_f32_16x16x128_f8f6f4(Bf[n], At[m], acc[ai][bj][m][n], 0, 0, 0, scw, 0, scx); __builtin_amdgcn_s_setprio(0); } while (0)
#define D_PIN(ai, bj) do { if ((ai) && TOPHALF) break; asm volatile("" : "+v"(acc[ai][bj][0][0]), "+v"(acc[ai][bj][0][1]), "+v"(acc[ai][bj][1][0]), "+v"(acc[ai][bj][1][1]), \
    "+v"(acc[ai][bj][2][0]), "+v"(acc[ai][bj][2][1]), "+v"(acc[ai][bj][3][0]), "+v"(acc[ai][bj][3][1])); } while (0)
#define D_WAIT_L(n) asm volatile("s_waitcnt lgkmcnt(" #n ")" ::: "memory")
  f32x4 acc[2][2][4][2];
#pragma unroll
  for (int a = 0; a < 2; ++a)
#pragma unroll
    for (int b = 0; b < 2; ++b)
#pragma unroll
      for (int m = 0; m < 4; ++m)
#pragma unroll
        for (int n = 0; n < 2; ++n) acc[a][b][m][n] = (f32x4){0.f, 0.f, 0.f, 0.f};
  i32x8 At[4], B0[2], B1[2];
  if (!PRE) {
    D_STAGE_B(G_SB(0, 0), 0, 0); D_STAGE_A(G_SA(0, 0), 0, 0); D_STAGE_B(G_SB(0, 1), 1, 0); D_STAGE_A(G_SA(0, 1), 1, 0);
    D_STAGE_B(G_SB(1, 0), 0, 1); D_STAGE_A(G_SA(1, 0), 0, 1); D_STAGE_B(G_SB(1, 1), 1, 1);
  }
  G_WAIT_V(0); G_BAR();
  if (wr == 1) G_BAR();
#pragma clang loop unroll(disable)
  for (int t = 0; t < (F8_PEEL ? nt - 2 : nt); t += 2) {
    const int t1 = t + 1;
    const int t2 = (F8_PEEL || t + 2 < nt) ? t + 2 : t;
    const int t3 = (F8_PEEL || t + 2 < nt) ? t + 3 : t + 1;
    D_LDB(B0, G_SB(0, 0)); G_SCHED(); D_LDA(At, G_SA(0, 0)); D_STAGE_A(G_SA(1, 1), 1, t1);
    D_WAIT_L(8); G_BAR(); D_WAIT_L(0); G_SCHED(); D_MMA(0, 0, At, B0); G_BAR(); G_SCHED();
    D_LDB(B1, G_SB(0, 1)); D_STAGE_B(G_SB(0, 0), 0, t2);
    G_BAR(); D_WAIT_L(0); G_SCHED(); D_MMA(0, 1, At, B1); G_BAR(); G_SCHED();
    D_LDA(At, G_SA(0, 1)); D_STAGE_A(G_SA(0, 0), 0, t2);
    G_BAR(); D_WAIT_L(0); G_SCHED(); D_MMA(1, 0, At, B0); G_BAR(); G_SCHED();
    D_STAGE_B(G_SB(0, 1), 1, t2);
    G_WAIT_V(6); G_BAR(); G_SCHED(); D_MMA(1, 1, At, B1); G_BAR(); G_SCHED();
    D_LDB(B0, G_SB(1, 0)); G_SCHED(); D_LDA(At, G_SA(1, 0)); D_STAGE_A(G_SA(0, 1), 1, t2);
    D_WAIT_L(8); G_BAR(); D_WAIT_L(0); G_SCHED(); D_MMA(0, 0, At, B0); G_BAR(); G_SCHED();
    D_LDB(B1, G_SB(1, 1)); D_STAGE_B(G_SB(1, 0), 0, t3);
    G_BAR(); D_WAIT_L(0); G_SCHED(); D_MMA(0, 1, At, B1); G_BAR(); G_SCHED();
    D_LDA(At, G_SA(1, 1)); D_STAGE_A(G_SA(1, 0), 0, t3);
    G_BAR(); D_WAIT_L(0); G_SCHED(); D_MMA(1, 0, At, B0); G_BAR(); G_SCHED();
    D_STAGE_B(G_SB(1, 1), 1, t3);
    G_WAIT_V(6); G_BAR(); G_SCHED(); D_MMA(1, 1, At, B1); G_BAR(); G_SCHED();
  }
  if (!F8_PEEL) G_WAIT_V(0);
  if (F8_PEEL) {
    D_LDB(B0, G_SB(0, 0)); G_SCHED(); D_LDA(At, G_SA(0, 0)); D_STAGE_A(G_SA(1, 1), 1, nt - 1);
    D_WAIT_L(8); G_BAR(); D_WAIT_L(0); G_SCHED(); D_MMA(0, 0, At, B0); D_PIN(0, 0); G_BAR(); G_SCHED();
    D_LDB(B1, G_SB(0, 1));
    G_BAR(); D_WAIT_L(0); G_SCHED(); D_MMA(0, 1, At, B1); D_PIN(0, 1); G_BAR(); G_SCHED();
    D_LDA(At, G_SA(0, 1));
    G_BAR(); D_WAIT_L(0); G_SCHED(); D_MMA(1, 0, At, B0); D_PIN(1, 0); G_BAR(); G_SCHED();
    G_WAIT_V(0); G_BAR(); G_SCHED(); D_MMA(1, 1, At, B1); D_PIN(1, 1); G_BAR(); G_SCHED();
    D_LDB(B0, G_SB(1, 0)); G_SCHED(); D_LDA(At, G_SA(1, 0));
    D_WAIT_L(8); G_BAR(); D_WAIT_L(0); G_SCHED(); D_MMA(0, 0, At, B0); D_PIN(0, 0); G_BAR(); G_SCHED();
    D_LDB(B1, G_SB(1, 1));
    G_BAR(); D_WAIT_L(0); G_SCHED(); D_MMA(0, 1, At, B1); D_PIN(0, 1); G_BAR(); G_SCHED();
    D_LDA(At, G_SA(1, 1));
    G_BAR(); D_WAIT_L(0); G_SCHED(); D_MMA(1, 0, At, B0); D_PIN(1, 0); G_BAR(); G_SCHED();
    G_BAR(); G_SCHED(); D_MMA(1, 1, At, B1); D_PIN(1, 1); G_BAR(); G_SCHED();
  }
  if (wr == 0) G_BAR();
  if (has_nxt) f8dma_issue_prologue_st(lds, nxt);
  {
    const int wid2 = wid, ln2 = lane_id_now(), wr2 = wid2 >> 2, wc2 = wid2 & 3, fr2 = ln2 & 15, fq2 = ln2 >> 4;
    if (PMODE == 0 && EPI_HOIST) {
      typename Cfg::RowTok tok[2][4];
#pragma unroll
      for (int ai = 0; ai < 2; ++ai)
#pragma unroll
        for (int m = 0; m < 4; ++m) tok[ai][m] = cfg.row_tok(ai * 128 + wr2 * 64 + m * 16 + fr2);
      typename Cfg::ColCtx cc[2];
#pragma unroll
      for (int bj = 0; bj < 2; ++bj) cc[bj] = cfg.col_ctx(bj, wc2, fq2);
      if constexpr (Cfg::PAIR_BJ) {
#pragma unroll
        for (int ai = 0; ai < 2; ++ai)
#pragma unroll
          for (int m = 0; m < 4; ++m) cfg.epi_pair(tok[ai][m], cc[0], cc[1], acc[ai][0][m][0], acc[ai][0][m][1], acc[ai][1][m][0], acc[ai][1][m][1]);
      } else {
#pragma unroll
      for (int ai = 0; ai < 2; ++ai)
#pragma unroll
        for (int m = 0; m < 4; ++m)
#pragma unroll
          for (int bj = 0; bj < 2; ++bj) cfg.epi_t(tok[ai][m], cc[bj], acc[ai][bj][m][0], acc[ai][bj][m][1]);
      }
    } else if (PMODE == 0) {
#pragma unroll
      for (int ai = 0; ai < 2; ++ai)
#pragma unroll
        for (int m = 0; m < 4; ++m)
#pragma unroll
          for (int bj = 0; bj < 2; ++bj) cfg.epi(ai * 128 + wr2 * 64 + m * 16 + fr2, bj, wc2, fq2, acc[ai][bj][m][0], acc[ai][bj][m][1]);
    } else {
#pragma unroll
      for (int ai = 0; ai < 2; ++ai)
#pragma unroll
        for (int m = 0; m < 4; ++m)
#pragma unroll
          for (int bj = 0; bj < 2; ++bj) asm volatile("" :: "v"(acc[ai][bj][m][0]), "v"(acc[ai][bj][m][1]));
    }
  }
  if (!has_nxt) G_BAR();
#undef D_STAGE
#undef D_STAGE_A
#undef D_STAGE_B
#undef D_LDA
#undef D_LDB
#undef D_MMA
#undef D_WAIT_L
#undef D_PIN
}

DI void convert_tile(const float* W, int ldw, bf16_t* Wt, int K, int kt, int ntile, float* tl, int tid) {
  {
    const int r = tid >> 4, c4 = (tid & 15) * 4;
#pragma unroll
    for (int i = 0; i < 2; ++i) {
      const float4 v = *(const float4*)(W + (size_t)(kt * 64 + r + 32 * i) * ldw + ntile * 64 + c4);
      float* d = tl + (r + 32 * i) * 65 + c4;
      d[0] = v.x; d[1] = v.y; d[2] = v.z; d[3] = v.w;
    }
  }
  __syncthreads();
  {
    const int n = tid >> 3, kc = (tid & 7) * 8;
    uint4 o;
    o.x = pack2(tl[(kc + 0) * 65 + n], tl[(kc + 1) * 65 + n]); o.y = pack2(tl[(kc + 2) * 65 + n], tl[(kc + 3) * 65 + n]);
    o.z = pack2(tl[(kc + 4) * 65 + n], tl[(kc + 5) * 65 + n]); o.w = pack2(tl[(kc + 6) * 65 + n], tl[(kc + 7) * 65 + n]);
    *(uint4*)(Wt + (size_t)(ntile * 64 + n) * K + kt * 64 + kc) = o;
  }
  __syncthreads();
}
DI void phase_convert(const Params& p, char* smem, int bid, int nb) {
  float* tl = (float*)smem;
  const int tid = OPAQUE_TID(p);
  constexpr int U0 = 32 * 61, U1 = U0 + 32 * 32, U2 = U1 + 8 * 24, U3 = U2 + 4 * 32;
  const int nmine = bid < U3 ? (U3 - bid + nb - 1) / nb : 0;
  const int r = tid >> 4, c4 = (tid & 15) * 4;
  const int n = tid >> 3, kc = (tid & 7) * 8;
  f32x4 a[4][2];
#define DC_DECODE(i) \
    const int _u0 = bid + (i) * nb; const bool _ok = _u0 < U3; const int _u = __builtin_amdgcn_readfirstlane(_ok ? _u0 : U3 - 1); \
    const int _w = _u < U0 ? 0 : (_u < U1 ? 1 : (_u < U2 ? 2 : 3)); \
    const int _v = _u - (_w == 0 ? 0 : (_w == 1 ? U0 : (_w == 2 ? U1 : U2))); \
    const int _nn = _w == 0 ? 61 : (_w == 2 ? 24 : 32); \
    const int _kt = _w == 0 ? (int)((unsigned)_v / 61u) : (_w == 2 ? (int)((unsigned)_v / 24u) : (_v >> 5)), _nt = _v - _kt * _nn;     \
    const unsigned long long _m0 = _w == 0 ? ~0ull : 0ull, _m1 = _w == 1 ? ~0ull : 0ull, _m2 = _w == 2 ? ~0ull : 0ull, _m3 = _w == 3 ? ~0ull : 0ull;     \
    const float* _W = (const float*)(((unsigned long long)p.w_in & _m0) | ((unsigned long long)p.w_o & _m1) | ((unsigned long long)p.w_q_b & _m2) | ((unsigned long long)p.w_kv_b & _m3)); \
    const int _ldw = _w == 0 ? INP : (_w == 2 ? 1536 : 2048); \
    bf16_t* _Wt = (bf16_t*)(((unsigned long long)p.wt_in & _m0) | ((unsigned long long)p.wt_o & _m1) | ((unsigned long long)p.wt_q & _m2) | ((unsigned long long)p.wt_kv & _m3)); \
    const int _K = _w == 2 ? 512 : (_w == 3 ? 256 : 2048);
#define DC_LOAD(slot, i) do { DC_DECODE(i) (void)_Wt; (void)_K; \
    _Pragma("unroll") for (int _q = 0; _q < 2; ++_q) { const float* _src = _W + (size_t)(_kt * 64 + r + 32 * _q) * _ldw + _nt * 64 + c4; \
      asm volatile("global_load_dwordx4 %0, %1, off" : "=v"(a[slot][_q]) : "v"(_src) : "memory"); } } while (0)
#define DC_TILE(slot, i, N) do { \
    float* _tl = tl + (((slot) & 1) ? 64 * 65 : 0); \
    asm volatile("s_waitcnt vmcnt(" #N ")" : "+v"(a[slot][0]), "+v"(a[slot][1]) :: "memory");        \
    _Pragma("unroll") for (int _q = 0; _q < 2; ++_q) { float* d = _tl + (r + 32 * _q) * 65 + c4; d[0] = a[slot][_q][0]; d[1] = a[slot][_q][1]; d[2] = a[slot][_q][2]; d[3] = a[slot][_q][3]; } \
    unsigned char* _dst; { DC_DECODE(i) (void)_W; (void)_ldw; \
      _dst = _ok ? (unsigned char*)(_Wt + (size_t)(_nt * 64 + n) * _K + _kt * 64 + kc) : p.cvdump + (size_t)n * 128 + kc * 2; } \
    asm volatile("s_waitcnt lgkmcnt(0)" ::: "memory");        \
    __builtin_amdgcn_sched_barrier(0); \
    DC_LOAD(slot, (i) + 4); \
    __syncthreads(); \
    uint4 o; \
    o.x = pack2(_tl[(kc + 0) * 65 + n], _tl[(kc + 1) * 65 + n]); o.y = pack2(_tl[(kc + 2) * 65 + n], _tl[(kc + 3) * 65 + n]); \
    o.z = pack2(_tl[(kc + 4) * 65 + n], _tl[(kc + 5) * 65 + n]); o.w = pack2(_tl[(kc + 6) * 65 + n], _tl[(kc + 7) * 65 + n]); \
    { u32x4 _o = {o.x, o.y, o.z, o.w}; asm volatile("global_store_dwordx4 %0, %1, off\n\ts_nop 1" :: "v"(_dst), "v"(_o) : "memory"); }   \
  } while (0)
  DC_LOAD(0, 0); DC_LOAD(1, 1); DC_LOAD(2, 2); DC_LOAD(3, 3);
#pragma unroll 1
  DC_TILE(0, 0, 6); DC_TILE(1, 1, 6); DC_TILE(2, 2, 6); DC_TILE(3, 3, 6);
  for (int i0 = 4; i0 < nmine; i0 += 4) { DC_TILE(0, i0, 6); DC_TILE(1, i0 + 1, 6); DC_TILE(2, i0 + 2, 6); DC_TILE(3, i0 + 3, 6); }
  asm volatile("s_waitcnt vmcnt(0)" : "+v"(a[0][0]), "+v"(a[0][1]), "+v"(a[1][0]), "+v"(a[1][1]), "+v"(a[2][0]), "+v"(a[2][1]), "+v"(a[3][0]), "+v"(a[3][1]) :: "memory");
#undef DC_TILE
#undef DC_LOAD
#undef DC_DECODE
  __syncthreads();
  for (int i = bid * NTHREADS + tid; i < 192 * 256; i += nb * NTHREADS) *(uint4*)(p.wt_in + (size_t)3904 * 2048 + (size_t)i * 8) = make_uint4(0u, 0u, 0u, 0u);
}


#define CVX_E(t) ((t) < 16384 ? ((t) >> 9) : (((t) - 16384) >> 10))
#define CVX_R(t) ((t) < 16384 ? (1024 + ((t) & 511)) : (((t) - 16384) & 1023))
DI void cvx_addr(const Params& p, int t, const float*& W, int& ldw, unsigned char*& Wq, int& kt, int& ntile) {
  const int e = CVX_E(t), r = CVX_R(t);
  if (r < 1024) { W = p.w_gate_up + (size_t)e * 2048 * 4096; ldw = 4096; Wq = p.wq1 + (size_t)e * 4096 * 2048; kt = r >> 6; ntile = r & 63; }
  else { const int q = r - 1024; W = p.w_down + (size_t)e * 2048 * 2048; ldw = 2048; Wq = p.wq2 + (size_t)e * 2048 * 2048; kt = q >> 5; ntile = q & 31; }
}
DI void cvx_load(const Params& p, int t, int r, int c4, float4 (&v)[4]) {
  if (t < 32 * 1536) {
    const float* W; int ldw, kt, ntile; unsigned char* Wq;
    cvx_addr(p, t, W, ldw, Wq, kt, ntile);
#pragma unroll
    for (int i = 0; i < 4; ++i) { const f32x4 q = __builtin_nontemporal_load((const f32x4*)(W + (size_t)(kt * 128 + r + 32 * i) * ldw + ntile * 64 + c4)); v[i] = make_float4(q[0], q[1], q[2], q[3]); }
  } else {
#pragma unroll
    for (int i = 0; i < 4; ++i) v[i] = make_float4(0.f, 0.f, 0.f, 0.f);
  }
}
DI void cvx_store(const Params& p, int t, int tid, int r, int c4, const float4 (&v)[4], float* tl) {
  if (t >= 32 * 1536) { __syncthreads(); return; }
  const float* W; int ldw, kt, ntile; unsigned char* Wq;
  cvx_addr(p, t, W, ldw, Wq, kt, ntile);
#pragma unroll
  for (int i = 0; i < 4; ++i) {
    float* d = tl + (r + 32 * i) * 65 + c4;
    d[0] = v[i].x * 512.f; d[1] = v[i].y * 512.f; d[2] = v[i].z * 512.f; d[3] = v[i].w * 512.f;
  }
  __syncthreads();
  {
    const int n = tid & 63, kc = (tid >> 6) * 16;
    uint4 o;
    o.x = (unsigned)pack4_fp8(tl[(kc + 0) * 65 + n], tl[(kc + 1) * 65 + n], tl[(kc + 2) * 65 + n], tl[(kc + 3) * 65 + n]);
    o.y = (unsigned)pack4_fp8(tl[(kc + 4) * 65 + n], tl[(kc + 5) * 65 + n], tl[(kc + 6) * 65 + n], tl[(kc + 7) * 65 + n]);
    o.z = (unsigned)pack4_fp8(tl[(kc + 8) * 65 + n], tl[(kc + 9) * 65 + n], tl[(kc + 10) * 65 + n], tl[(kc + 11) * 65 + n]);
    o.w = (unsigned)pack4_fp8(tl[(kc + 12) * 65 + n], tl[(kc + 13) * 65 + n], tl[(kc + 14) * 65 + n], tl[(kc + 15) * 65 + n]);
    *(uint4*)(Wq + (size_t)(ntile * 64 + n) * 2048 + kt * 128 + kc) = o;
  }
}
DI void convert_chunk(const Params& p, char* smem, int bid, int nb, int slot, const int CVX_SLOTS) {
  float* tl = (float*)smem;
  const int tid = OPAQUE_TID(p);
  const int r = tid >> 4, c4 = (tid & 15) * 4;
  constexpr int NT = 32 * 1536;
  const int nper = (NT + nb - 1) / nb;
  const int i0 = nper * slot / CVX_SLOTS, i1 = nper * (slot + 1) / CVX_SLOTS;
#define CVX_T(i) ((i) < i1 ? bid + (i) * nb : NT)
  float4 a0[4], a1[4], a2[4], a3[4];
  cvx_load(p, CVX_T(i0), r, c4, a0); cvx_load(p, CVX_T(i0 + 1), r, c4, a1); cvx_load(p, CVX_T(i0 + 2), r, c4, a2); cvx_load(p, CVX_T(i0 + 3), r, c4, a3);
#pragma unroll 1
  for (int i = i0; i < i1; i += 4) {
    float4 b0[4], b1[4], b2[4], b3[4];
    cvx_load(p, CVX_T(i + 4), r, c4, b0); cvx_load(p, CVX_T(i + 5), r, c4, b1); cvx_load(p, CVX_T(i + 6), r, c4, b2); cvx_load(p, CVX_T(i + 7), r, c4, b3);
    cvx_store(p, CVX_T(i), tid, r, c4, a0, tl);
    cvx_store(p, CVX_T(i + 1), tid, r, c4, a1, tl + 128 * 65);
    cvx_store(p, CVX_T(i + 2), tid, r, c4, a2, tl);
    cvx_store(p, CVX_T(i + 3), tid, r, c4, a3, tl + 128 * 65);
#pragma unroll
    for (int k = 0; k < 4; ++k) { a0[k] = b0[k]; a1[k] = b1[k]; a2[k] = b2[k]; a3[k] = b3[k]; }
  }
#undef CVX_T
  __syncthreads();
}

template <int NS, bool STREAM_ONLY = false>
DI void convert_experts_dma(const Params& p, LDS_AS unsigned char* lds, int bid, int nb) {
  const int tid = OPAQUE_TID(p), wid = __builtin_amdgcn_readfirstlane(tid >> 6), lane = tid & 63;
  constexpr int NT = 32 * 1536;
  const int nvalid = bid < NT / CVG ? CVG * ((NT / CVG - bid + nb - 1) / nb) : 0;
#define CVX_TILE_OF(i) ((bid + ((i) / CVG) * nb) * CVG + ((i) % CVG))
  const __amdgpu_buffer_rsrc_t rs1 = __builtin_amdgcn_make_buffer_rsrc((void*)p.w_gate_up, 0, 0x40000000u, 0x00020000);
  const __amdgpu_buffer_rsrc_t rs2 = __builtin_amdgcn_make_buffer_rsrc((void*)p.w_down, 0, 0x20000000u, 0x00020000);
  const __amdgpu_buffer_rsrc_t rs0 = __builtin_amdgcn_make_buffer_rsrc((void*)p.w_down, 0, 0u, 0x00020000);
  const unsigned vo1 = ((unsigned)lane >> 4) * 16384u + ((((unsigned)lane & 15u) ^ (unsigned)wid) << 4);
  const unsigned vo2 = ((unsigned)lane >> 4) * 8192u + ((((unsigned)lane & 15u) ^ (unsigned)wid) << 4);
  const unsigned ldsw = (unsigned)__builtin_amdgcn_readfirstlane((int)(unsigned)(size_t)lds) + (unsigned)wid * 4096u;
  const int n = 8 * wid + (lane >> 3), kc = lane & 7;
  const unsigned roff = (unsigned)kc * 4096u + ((((unsigned)n >> 2) ^ (unsigned)kc) << 4) + (((unsigned)n & 3u) << 2);
#define CVD_ISSUE(i, slot) do { \
    const int _t = __builtin_amdgcn_readfirstlane(CVX_TILE_OF(i)); const bool _ok = (i) < nvalid; \
    const int _e = CVX_E(_t), _r = CVX_R(_t); const bool _gu = _r < 1024; \
    const int _kt = _gu ? (_r >> 6) : ((_r - 1024) >> 5), _nt = _gu ? (_r & 63) : ((_r - 1024) & 31); \
    const unsigned _ldw = _gu ? 16384u : 8192u; \
    const unsigned _so = (unsigned)(_e * 2048 + _kt * 128 + wid * 16) * _ldw + (unsigned)_nt * 256u; \
    const unsigned _vo = _gu ? vo1 : vo2; \
    const unsigned _mb = ldsw + (unsigned)(slot) * 32768u; \
    if (!_ok) { _Pragma("unroll") for (int _q = 0; _q < 4; ++_q) asm volatile("s_mov_b32 m0, %0\n\ts_nop 4\n\tbuffer_load_dwordx4 %1, %2, %3 offen lds" :: "s"(_mb + _q * 1024u), "v"(_vo), "s"(rs0), "s"(0u) : "m0", "memory"); } \
    else if (_gu) { _Pragma("unroll") for (int _q = 0; _q < 4; ++_q) asm volatile("s_mov_b32 m0, %0\n\ts_nop 4\n\tbuffer_load_dwordx4 %1, %2, %3 offen lds" :: "s"(_mb + _q * 1024u), "v"(_vo), "s"(rs1), "s"(_so + _q * 4u * _ldw) : "m0", "memory"); } \
    else { _Pragma("unroll") for (int _q = 0; _q < 4; ++_q) asm volatile("s_mov_b32 m0, %0\n\ts_nop 4\n\tbuffer_load_dwordx4 %1, %2, %3 offen lds" :: "s"(_mb + _q * 1024u), "v"(_vo), "s"(rs2), "s"(_so + _q * 4u * _ldw) : "m0", "memory"); } \
  } while (0)
  CVD_ISSUE(0, 0); CVD_ISSUE(1, 1); CVD_ISSUE(2, 2);
  if (NS == 5) CVD_ISSUE(3, 3);
  int si = 0;
#pragma unroll 1
  for (int i = 0; i < nvalid; ++i) {
    if (NS == 4) asm volatile("s_waitcnt vmcnt(8)" ::: "memory");
    else asm volatile("s_waitcnt vmcnt(12)" ::: "memory");
    __builtin_amdgcn_s_barrier();
    __builtin_amdgcn_sched_barrier(0);
    const int sp = si == 0 ? NS - 1 : si - 1;
    CVD_ISSUE(i + NS - 1, sp);
    const int t = __builtin_amdgcn_readfirstlane(CVX_TILE_OF(i));
    const int e = CVX_E(t), r = CVX_R(t); const bool gu = r < 1024;
    const int kt = gu ? (r >> 6) : ((r - 1024) >> 5), ntile = gu ? (r & 63) : ((r - 1024) & 31);
    unsigned char* Wq = gu ? p.wq1 + (size_t)e * 4096 * 2048 : p.wq2 + (size_t)e * 2048 * 2048;
    if (!STREAM_ONLY) {
    const LDS_AS float* src = (const LDS_AS float*)(lds + (unsigned)si * 32768u + roff);
    float v[16];
#pragma unroll
    for (int j = 0; j < 16; ++j) v[j] = src[j * 64] * 512.f;
    uint4 o;
    o.x = (unsigned)pack4_fp8(v[0], v[1], v[2], v[3]); o.y = (unsigned)pack4_fp8(v[4], v[5], v[6], v[7]);
    o.z = (unsigned)pack4_fp8(v[8], v[9], v[10], v[11]); o.w = (unsigned)pack4_fp8(v[12], v[13], v[14], v[15]);
    *(uint4*)(Wq + (size_t)(ntile * 64 + n) * 2048 + kt * 128 + kc * 16) = o;
    }
    si = si == NS - 1 ? 0 : si + 1;
    __builtin_amdgcn_sched_barrier(0);
  }
#undef CVD_ISSUE
  asm volatile("s_waitcnt vmcnt(0)" ::: "memory");
  __syncthreads();
}

DI void convert_experts_wave(const Params& p, LDS_AS unsigned char* lds, int bid, int nb) {
  const int tid = OPAQUE_TID(p), wid = __builtin_amdgcn_readfirstlane(tid >> 6), lane = tid & 63;
  constexpr int NT = 32 * 1536;
  const int nvalid = bid < NT / CVG ? CVG * ((NT / CVG - bid + nb - 1) / nb) : 0;
  const __amdgpu_buffer_rsrc_t rs1 = __builtin_amdgcn_make_buffer_rsrc((void*)p.w_gate_up, 0, 0x40000000u, 0x00020000);
  const __amdgpu_buffer_rsrc_t rs2 = __builtin_amdgcn_make_buffer_rsrc((void*)p.w_down, 0, 0x20000000u, 0x00020000);
  const __amdgpu_buffer_rsrc_t rs0 = __builtin_amdgcn_make_buffer_rsrc((void*)p.w_down, 0, 0u, 0x00020000);
  const unsigned vo1 = ((unsigned)lane >> 4) * 16384u + (((unsigned)lane & 15u) << 4);
  const unsigned vo2 = ((unsigned)lane >> 4) * 8192u + (((unsigned)lane & 15u) << 4);
  const unsigned ldsw = (unsigned)__builtin_amdgcn_readfirstlane((int)(unsigned)(size_t)lds) + (unsigned)wid * 16384u;
  LDS_AS unsigned char* ring = lds + (unsigned)wid * 16384u + (unsigned)lane * 4u;
#define CVW_ISSUE(i) do { \
    const int _t = __builtin_amdgcn_readfirstlane(CVX_TILE_OF(i)); const bool _ok = (i) < nvalid; \
    const int _e = CVX_E(_t), _r = CVX_R(_t); const bool _gu = _r < 1024; \
    const int _kt = _gu ? (_r >> 6) : ((_r - 1024) >> 5), _nt = _gu ? (_r & 63) : ((_r - 1024) & 31); \
    const unsigned _ldw = _gu ? 16384u : 8192u; \
    const unsigned _so = (unsigned)(_e * 2048 + _kt * 128 + wid * 16) * _ldw + (unsigned)_nt * 256u; \
    const unsigned _vo = _gu ? vo1 : vo2; \
    const unsigned _mb = ldsw + (unsigned)((i) & 3) * 4096u; \
    if (!_ok) { _Pragma("unroll") for (int _q = 0; _q < 4; ++_q) asm volatile("s_mov_b32 m0, %0\n\ts_nop 4\n\tbuffer_load_dwordx4 %1, %2, %3 offen lds" :: "s"(_mb + _q * 1024u), "v"(_vo), "s"(rs0), "s"(0u) : "m0", "memory"); } \
    else if (_gu) { _Pragma("unroll") for (int _q = 0; _q < 4; ++_q) asm volatile("s_mov_b32 m0, %0\n\ts_nop 4\n\tbuffer_load_dwordx4 %1, %2, %3 offen lds" :: "s"(_mb + _q * 1024u), "v"(_vo), "s"(rs1), "s"(_so + _q * 4u * _ldw) : "m0", "memory"); } \
    else { _Pragma("unroll") for (int _q = 0; _q < 4; ++_q) asm volatile("s_mov_b32 m0, %0\n\ts_nop 4\n\tbuffer_load_dwordx4 %1, %2, %3 offen lds" :: "s"(_mb + _q * 1024u), "v"(_vo), "s"(rs2), "s"(_so + _q * 4u * _ldw) : "m0", "memory"); } \
  } while (0)
  CVW_ISSUE(0); CVW_ISSUE(1); CVW_ISSUE(2);
#pragma unroll 1
  for (int i = 0; i < nvalid; ++i) {
    if (i < 3) asm volatile("s_waitcnt vmcnt(8)" ::: "memory"); else asm volatile("s_waitcnt vmcnt(11)" ::: "memory");
    __builtin_amdgcn_sched_barrier(0);
    CVW_ISSUE(i + 3);
    const int t = __builtin_amdgcn_readfirstlane(CVX_TILE_OF(i));
    const int e = CVX_E(t), r = CVX_R(t); const bool gu = r < 1024;
    const int kt = gu ? (r >> 6) : ((r - 1024) >> 5), ntile = gu ? (r & 63) : ((r - 1024) & 31);
    unsigned char* Wq = gu ? p.wq1 + (size_t)e * 4096 * 2048 : p.wq2 + (size_t)e * 2048 * 2048;
    const LDS_AS float* src = (const LDS_AS float*)(ring + (unsigned)(i & 3) * 4096u);
    float v[16];
#pragma unroll
    for (int j = 0; j < 16; ++j) v[j] = src[j * 64] * 512.f;
    uint4 o;
    o.x = (unsigned)pack4_fp8(v[0], v[1], v[2], v[3]); o.y = (unsigned)pack4_fp8(v[4], v[5], v[6], v[7]);
    o.z = (unsigned)pack4_fp8(v[8], v[9], v[10], v[11]); o.w = (unsigned)pack4_fp8(v[12], v[13], v[14], v[15]);
    *(uint4*)(Wq + (size_t)(ntile * 64 + lane) * 2048 + kt * 128 + wid * 16) = o;
    __builtin_amdgcn_sched_barrier(0);
  }
#undef CVW_ISSUE
  asm volatile("s_waitcnt vmcnt(0)" ::: "memory");
  __syncthreads();
}
DI void convert_experts_reg(const Params& p, LDS_AS unsigned char* lds, int bid, int nb) {
  const int tid = OPAQUE_TID(p), wid = __builtin_amdgcn_readfirstlane(tid >> 6), lane = tid & 63;
  constexpr int NT = 32 * 1536;
  const int nvalid = bid < NT / CVG ? CVG * ((NT / CVG - bid + nb - 1) / nb) : 0;
  const int r = tid >> 4, c = tid & 15;
  const unsigned vo1 = (unsigned)r * 16384u + (unsigned)c * 16u, vo2 = (unsigned)r * 8192u + (unsigned)c * 16u;
  const unsigned woff = (unsigned)r * 256u;
  const int n = 8 * wid + (lane >> 3), kc = lane & 7;
  const unsigned roff = (unsigned)kc * 4096u + ((((unsigned)n >> 2) ^ (unsigned)kc) << 4) + (((unsigned)n & 3u) << 2);
  f32x4 a[8][4];
#define CVR_LOAD(u, i) do { \
    const int _i = (i); const bool _ok = _i < nvalid; const int _t = __builtin_amdgcn_readfirstlane(_ok ? CVX_TILE_OF(_i) : 0); \
    const int _e = CVX_E(_t), _r = CVX_R(_t); const bool _gu = _r < 1024; \
    const int _kt = _gu ? (_r >> 6) : ((_r - 1024) >> 5), _nt = _gu ? (_r & 63) : ((_r - 1024) & 31); \
    const unsigned _ldw = _gu ? 16384u : 8192u; \
    const unsigned _so = (unsigned)(_e * 2048 + _kt * 128) * _ldw + (unsigned)_nt * 256u; \
    const unsigned _vo = _ok ? (_gu ? vo1 : vo2) : 0xFFFFFFF0u;            \
    const __amdgpu_buffer_rsrc_t _rs = __builtin_amdgcn_make_buffer_rsrc((void*)(_gu ? p.w_gate_up : p.w_down), 0, 0x40000000u, 0x00020000); \
    _Pragma("unroll") for (int _q = 0; _q < 4; ++_q) \
      asm volatile("buffer_load_dwordx4 %0, %1, %2, %3 offen" : "=v"(a[u][_q]) : "v"(_vo), "s"(_rs), "s"(_so + (unsigned)_q * 32u * _ldw) : "memory"); \
  } while (0)
#define CVR_TILE(u, i, N) do { \
    const int _ii = (i); \
    LDS_AS unsigned char* buf = lds + (unsigned)((u) & 1) * 32768u; \
    asm volatile("s_waitcnt vmcnt(" #N ")" : "+v"(a[u][0]), "+v"(a[u][1]), "+v"(a[u][2]), "+v"(a[u][3]) :: "memory"); \
    _Pragma("unroll") for (int q = 0; q < 4; ++q) \
      *(LDS_AS f32x4*)(buf + woff + (unsigned)q * 8192u + ((((unsigned)c) ^ (((unsigned)r >> 4) + 2u * q)) << 4)) = a[u][q]; \
    const bool ok = _ii < nvalid; \
    const int t = __builtin_amdgcn_readfirstlane(ok ? CVX_TILE_OF(_ii) : 0); \
    const int e = CVX_E(t), rr = CVX_R(t); const bool gu = rr < 1024; \
    const int kt = gu ? (rr >> 6) : ((rr - 1024) >> 5), ntile = gu ? (rr & 63) : ((rr - 1024) & 31); \
    unsigned char* Wq = gu ? p.wq1 + (size_t)e * 4096 * 2048 : p.wq2 + (size_t)e * 2048 * 2048; \
    unsigned char* dst = ok ? Wq + (size_t)(ntile * 64 + n) * 2048 + kt * 128 + kc * 16 : p.cvdump + (size_t)n * 2048 + kc * 16; \
    asm volatile("s_waitcnt lgkmcnt(0)" ::: "memory"); \
    __builtin_amdgcn_sched_barrier(0); \
    CVR_LOAD(u, _ii + 8); \
    __builtin_amdgcn_s_barrier();                   \
    __builtin_amdgcn_sched_barrier(0); \
    const LDS_AS float* src = (const LDS_AS float*)(buf + roff); \
    float v[16]; \
    _Pragma("unroll") for (int j = 0; j < 16; ++j) v[j] = src[j * 64] * 512.f; \
    u32x4 o; \
    o[0] = (unsigned)pack4_fp8(v[0], v[1], v[2], v[3]); o[1] = (unsigned)pack4_fp8(v[4], v[5], v[6], v[7]); \
    o[2] = (unsigned)pack4_fp8(v[8], v[9], v[10], v[11]); o[3] = (unsigned)pack4_fp8(v[12], v[13], v[14], v[15]); \
    asm volatile("global_store_dwordx4 %0, %1, off\n\ts_nop 1" :: "v"(dst), "v"(o) : "memory"); \
    __builtin_amdgcn_sched_barrier(0); \
  } while (0)
  CVR_LOAD(0, 0); CVR_LOAD(1, 1); CVR_LOAD(2, 2); CVR_LOAD(3, 3); CVR_LOAD(4, 4); CVR_LOAD(5, 5); CVR_LOAD(6, 6); CVR_LOAD(7, 7);
  CVR_TILE(0, 0, 28); CVR_TILE(1, 1, 29); CVR_TILE(2, 2, 30); CVR_TILE(3, 3, 31); CVR_TILE(4, 4, 32); CVR_TILE(5, 5, 33); CVR_TILE(6, 6, 34); CVR_TILE(7, 7, 35);
#pragma unroll 1
  for (int i0 = 8; i0 < nvalid; i0 += 8) {
    CVR_TILE(0, i0, 36); CVR_TILE(1, i0 + 1, 36); CVR_TILE(2, i0 + 2, 36); CVR_TILE(3, i0 + 3, 36);
    CVR_TILE(4, i0 + 4, 36); CVR_TILE(5, i0 + 5, 36); CVR_TILE(6, i0 + 6, 36); CVR_TILE(7, i0 + 7, 36);
  }
  asm volatile("s_waitcnt vmcnt(0)" : "+v"(a[0][0]), "+v"(a[0][1]), "+v"(a[0][2]), "+v"(a[0][3]), "+v"(a[1][0]), "+v"(a[1][1]), "+v"(a[1][2]), "+v"(a[1][3]) :: "memory");
  asm volatile("" : "+v"(a[2][0]), "+v"(a[2][1]), "+v"(a[2][2]), "+v"(a[2][3]), "+v"(a[3][0]), "+v"(a[3][1]), "+v"(a[3][2]), "+v"(a[3][3]) :: "memory");
  asm volatile("" : "+v"(a[4][0]), "+v"(a[4][1]), "+v"(a[4][2]), "+v"(a[4][3]), "+v"(a[5][0]), "+v"(a[5][1]), "+v"(a[5][2]), "+v"(a[5][3]) :: "memory");
  asm volatile("" : "+v"(a[6][0]), "+v"(a[6][1]), "+v"(a[6][2]), "+v"(a[6][3]), "+v"(a[7][0]), "+v"(a[7][1]), "+v"(a[7][2]), "+v"(a[7][3]) :: "memory");
#undef CVR_LOAD
#undef CVR_TILE
  __syncthreads();
}


#if DENSE_DMA
#define DENSE_UNIT(lds, cfg) gemm256dma_unit(lds, cfg)
#else
#define DENSE_UNIT(lds, cfg) gemm256_unit(lds, cfg)
#endif
DI void st_bf16x4(bf16_t* dst, const f32x4& v) { u32x2 pk; pk.x = pack2(v[0], v[1]); pk.y = pack2(v[2], v[3]); *(u32x2*)dst = pk; }
DI int tile_gc(int pn, int bj, int wc, int fq) { return pn * 256 + 128 * bj + 64 * (wc >> 1) + 16 * (wc & 1) + 4 * fq; }

struct CfgInProj {
  const Params& p; int pm, pn;
  static constexpr bool GU = false;
  DI int vrows() const { return 256; }
  DI const void* bt_base() const { return p.wt_in; }
  DI unsigned bt_bytes() const { return 4096u * 4096u; }
  DI unsigned bt_rowoff(int h, int R) const { return (unsigned)(pn * 256 + 128 * h + (pn < 15 ? tcol_adj(R) : tcol_p64(R))) * 4096u; }
  DI int nkt() const { return 32; }
  DI const void* a_base() const { return p.h0b; }
  DI unsigned a_bytes() const { return (unsigned)NTOK * 4096u; }
  DI unsigned a_rowoff(int r) const { return (unsigned)(pm * 256 + r) * 4096u; }
  DI const float* b_base() const { return p.w_in; }
  DI unsigned b_bytes() const { return 2048u * (unsigned)INP * 4u; }
  DI int ldb() const { return INP; }
  DI int b_gcol(int h, int lc) const { return pn * 256 + 128 * h + lc; }
  DI void epi(int r, int bj, int wc, int fq, const f32x4& v0, const f32x4& v1) const {
    const int t = pm * 256 + r;
    if (pn < 15) {
      const int ga = pn * 256 + 128 * bj + 64 * (wc >> 1) + 32 * (wc & 1) + 8 * fq;
      u32x4 pk; pk.x = pack2(v0[0], v0[1]); pk.y = pack2(v0[2], v0[3]); pk.z = pack2(v1[0], v1[1]); pk.w = pack2(v1[2], v1[3]);
      bf16_t* dst = pn < 12 ? p.qkv + (size_t)t * 3072 + ga : (pn < 14 ? p.qlat + (size_t)t * 512 + (ga - 3072) : p.kvlat + (size_t)t * 256 + (ga - 3584));
      *(u32x4*)dst = pk;
      return;
    }
    const int gc = tile_gc(pn, bj, wc, fq);
    if (gc < 3072) { st_bf16x4(p.qkv + (size_t)t * 3072 + gc, v0); st_bf16x4(p.qkv + (size_t)t * 3072 + gc + 32, v1); }
    else if (gc < 3584) { st_bf16x4(p.qlat + (size_t)t * 512 + gc - 3072, v0); st_bf16x4(p.qlat + (size_t)t * 512 + gc - 3072 + 32, v1); }
    else if (gc < 3840) { st_bf16x4(p.kvlat + (size_t)t * 256 + gc - 3584, v0); st_bf16x4(p.kvlat + (size_t)t * 256 + gc - 3584 + 32, v1); }
    else if (gc < 3872) {
      const int i0 = gc - 3840; const int ps = p.pos[t];
      f32x4 a, b;
#pragma unroll
      for (int e = 0; e < 4; ++e) { float sn, cs; rope_sc(ps, i0 + e, sn, cs); a[e] = v0[e] * cs - v1[e] * sn; b[e] = v1[e] * cs + v0[e] * sn; }
      st_bf16x4(p.krope + (size_t)t * 64 + i0, a); st_bf16x4(p.krope + (size_t)t * 64 + i0 + 32, b);
    }
  }
};
DI void phase_in_proj(const Params& p, LDS_AS unsigned char* lds, char* smem, int bid, int nb) {
  for (int u = bid; u < 32 * 16; u += nb) {
    const int uu = __builtin_amdgcn_readfirstlane(u);
    CfgInProj cfg{p, uu >> 4, uu & 15};
    DENSE_UNIT(lds, cfg);
  }
}

DI void phase_norm_latents(const Params& p, int bid, int nb) {
  const int tid_ = OPAQUE_TID(p), lane = tid_ & 63, wv = tid_ >> 6;
  for (int t = bid * NWAVES + wv; t < NTOK; t += nb * NWAVES) {
    const uint4 a = *(const uint4*)(p.qlat + (size_t)t * 512 + lane * 8);
    float v[8] = {bflo(a.x), bfhi(a.x), bflo(a.y), bfhi(a.y), bflo(a.z), bfhi(a.z), bflo(a.w), bfhi(a.w)};
    float s = 0.f;
#pragma unroll
    for (int i = 0; i < 8; ++i) s += v[i] * v[i];
    s = wave_sum(s);
    const float rs = rsqrtf(s * (1.f / 512.f) + RMS_EPS);
    const float4 g0 = *(const float4*)(p.q_a_norm + lane * 8), g1 = *(const float4*)(p.q_a_norm + lane * 8 + 4);
    uint4 o;
    o.x = pack2(v[0] * rs * g0.x, v[1] * rs * g0.y); o.y = pack2(v[2] * rs * g0.z, v[3] * rs * g0.w);
    o.z = pack2(v[4] * rs * g1.x, v[5] * rs * g1.y); o.w = pack2(v[6] * rs * g1.z, v[7] * rs * g1.w);
    *(uint4*)(p.qn + (size_t)t * 512 + lane * 8) = o;
    const uint2 b = *(const uint2*)(p.kvlat + (size_t)t * 256 + lane * 4);
    float w[4] = {bflo(b.x), bfhi(b.x), bflo(b.y), bfhi(b.y)};
    float s2 = w[0] * w[0] + w[1] * w[1] + w[2] * w[2] + w[3] * w[3];
    s2 = wave_sum(s2);
    const float rs2 = rsqrtf(s2 * (1.f / 256.f) + RMS_EPS);
    const float4 g2 = *(const float4*)(p.kv_a_norm + lane * 4);
    uint2 o2;
    o2.x = pack2(w[0] * rs2 * g2.x, w[1] * rs2 * g2.y); o2.y = pack2(w[2] * rs2 * g2.z, w[3] * rs2 * g2.w);
    *(uint2*)(p.kvn + (size_t)t * 256 + lane * 4) = o2;
  }
}

struct CfgMlaQ {
  const Params& p; int pm, pn;
  static constexpr bool GU = false;
  DI int vrows() const { return 256; }
  DI const void* bt_base() const { return p.wt_q; }
  DI unsigned bt_bytes() const { return 1536u * 1024u; }
  DI unsigned bt_rowoff(int h, int R) const {
    const bool rope = ((pn * 4 + 2 * h + ((R >> 6) & 1)) % 3) == 2;
    return (unsigned)(pn * 256 + 128 * h + (rope ? tcol_p64(R) : tcol_adj(R))) * 1024u;
  }
  DI int nkt() const { return 8; }
  DI const void* a_base() const { return p.qn; }
  DI unsigned a_bytes() const { return (unsigned)NTOK * 1024u; }
  DI unsigned a_rowoff(int r) const { return (unsigned)(pm * 256 + r) * 1024u; }
  DI const float* b_base() const { return p.w_q_b; }
  DI unsigned b_bytes() const { return 512u * 1536u * 4u; }
  DI int ldb() const { return 1536; }
  DI int b_gcol(int h, int lc) const { return pn * 256 + 128 * h + lc; }
  DI void epi(int r, int bj, int wc, int fq, const f32x4& v0, const f32x4& v1) const {
    const int t = pm * 256 + r;
    if (((pn * 4 + 2 * bj + (wc >> 1)) % 3) != 2) {
      const int ga = pn * 256 + 128 * bj + 64 * (wc >> 1) + 32 * (wc & 1) + 8 * fq;
      u32x4 pk; pk.x = pack2(v0[0], v0[1]); pk.y = pack2(v0[2], v0[3]); pk.z = pack2(v1[0], v1[1]); pk.w = pack2(v1[2], v1[3]);
      *(u32x4*)(p.mq + (size_t)t * 1536 + ga) = pk;
      return;
    }
    const int gc = tile_gc(pn, bj, wc, fq);
    f32x4 a = v0, b = v1;
    if (((gc >> 6) % 3) == 2) {
      const int i0 = gc & 31; const int ps = p.pos[t];
#pragma unroll
      for (int e = 0; e < 4; ++e) { float sn, cs; rope_sc(ps, i0 + e, sn, cs); a[e] = v0[e] * cs - v1[e] * sn; b[e] = v1[e] * cs + v0[e] * sn; }
    }
    st_bf16x4(p.mq + (size_t)t * 1536 + gc, a); st_bf16x4(p.mq + (size_t)t * 1536 + gc + 32, b);
  }
};
struct CfgMlaKV {
  const Params& p; int pm, pn;
  static constexpr bool GU = false;
  DI int vrows() const { return 256; }
  DI const void* bt_base() const { return p.wt_kv; }
  DI unsigned bt_bytes() const { return 2048u * 512u; }
  DI unsigned bt_rowoff(int h, int R) const { return (unsigned)(pn * 256 + 128 * h + tcol_adj(R)) * 512u; }
  DI int nkt() const { return 4; }
  DI const void* a_base() const { return p.kvn; }
  DI unsigned a_bytes() const { return (unsigned)NTOK * 512u; }
  DI unsigned a_rowoff(int r) const { return (unsigned)(pm * 256 + r) * 512u; }
  DI const float* b_base() const { return p.w_kv_b; }
  DI unsigned b_bytes() const { return 256u * 2048u * 4u; }
  DI int ldb() const { return 2048; }
  DI int b_gcol(int h, int lc) const { return pn * 256 + 128 * h + lc; }
  DI void epi(int r, int bj, int wc, int fq, const f32x4& v0, const f32x4& v1) const {
    const int t = pm * 256 + r; const int ga = pn * 256 + 128 * bj + 64 * (wc >> 1) + 32 * (wc & 1) + 8 * fq;
    u32x4 pk; pk.x = pack2(v0[0], v0[1]); pk.y = pack2(v0[2], v0[3]); pk.z = pack2(v1[0], v1[1]); pk.w = pack2(v1[2], v1[3]);
    *(u32x4*)(p.mkv + (size_t)t * 2048 + ga) = pk;
  }
};
DI void phase_mla_proj(const Params& p, LDS_AS unsigned char* lds, char* smem, int bid, int nb) {
  for (int u = bid; u < 32 * 6; u += nb) {
    const int uu = __builtin_amdgcn_readfirstlane(u);
    CfgMlaQ cfg{p, uu / 6, uu % 6}; DENSE_UNIT(lds, cfg);
  }
  for (int u = nb - 1 - bid; u < 32 * 8; u += nb) {
    const int uu = __builtin_amdgcn_readfirstlane(u);
    CfgMlaKV cfg{p, uu >> 3, uu & 7}; DENSE_UNIT(lds, cfg);
  }
}

struct CfgWo {
  const Params& p; int pm, pn;
  static constexpr bool GU = false;
  DI int vrows() const { return 256; }
  DI const void* bt_base() const { return p.wt_o; }
  DI unsigned bt_bytes() const { return 2048u * 4096u; }
  DI unsigned bt_rowoff(int h, int R) const { return (unsigned)(pn * 256 + 128 * h + tcol_adj(R)) * 4096u; }
  DI int nkt() const { return 32; }
  DI const void* a_base() const { return p.on; }
  DI unsigned a_bytes() const { return (unsigned)NTOK * 4096u; }
  DI unsigned a_rowoff(int r) const { return (unsigned)(pm * 256 + r) * 4096u; }
  DI const float* b_base() const { return p.w_o; }
  DI unsigned b_bytes() const { return 2048u * 2048u * 4u; }
  DI int ldb() const { return 2048; }
  DI int b_gcol(int h, int lc) const { return pn * 256 + 128 * h + lc; }
  DI void epi(int r, int bj, int wc, int fq, const f32x4& v0, const f32x4& v1) const {
    const size_t o = (size_t)(pm * 256 + r) * 2048 + pn * 256 + 128 * bj + 64 * (wc >> 1) + 32 * (wc & 1) + 8 * fq;
    const u32x4 rr = *(const u32x4*)(p.h0b + o);
    const f32x4 h0 = {bflo(rr.x), bfhi(rr.x), bflo(rr.y), bfhi(rr.y)}, h1 = {bflo(rr.z), bfhi(rr.z), bflo(rr.w), bfhi(rr.w)};
    const f32x4 x0 = h0 * DN_ALPHA + v0, x1 = h1 * DN_ALPHA + v1;
    u32x4 pk; pk.x = pack2(x0[0], x0[1]); pk.y = pack2(x0[2], x0[3]); pk.z = pack2(x1[0], x1[1]); pk.w = pack2(x1[2], x1[3]);
    *(u32x4*)(p.z1b + o) = pk;
  }
};
template <int MODE = 0>
DI void phase_wo(const Params& p, LDS_AS unsigned char* lds, char* smem, int bid, int nb) {
  for (int u = bid; u < 32 * 8; u += nb) {
    const int uu = __builtin_amdgcn_readfirstlane(u);
    CfgWo cfg{p, uu >> 3, uu & 7};
    if (MODE == 0) DENSE_UNIT(lds, cfg); else gemm256_unit<CfgWo, MODE>(lds, cfg);
  }
}

struct MoeSched { int base[33]; int mt[32]; int cnt[32]; };
DI void moe_sched_build(const Params& p, MoeSched* s, int ntn, bool rev) {
  if (threadIdx.x == 0) {
    int acc = 0;
    for (int e = 0; e < 32; ++e) { const int c = p.cnt[(rev ? 31 - e : e) * 32]; const int m = (c + 255) >> 8; s->cnt[e] = c; s->mt[e] = m; s->base[e] = acc; acc += m * ntn; }
    s->base[32] = acc;
  }
  __syncthreads();
}
struct CfgMoe1 {
  const Params& p; int e, m0, tn, cnt;
  static constexpr bool GU = true;
  DI int vrows() const { return cnt - m0; }
  DI int nkt() const { return 32; }
  DI const void* a_base() const { return p.h1b; }
  DI unsigned a_bytes() const { return (unsigned)NTOK * 4096u; }
  DI unsigned a_rowoff(int r) const {
    int rr = m0 + r; rr = rr < cnt ? rr : cnt - 1;
    return (unsigned)(p.rowlist[e * 8192 + rr] >> 2) * 4096u;
  }
  DI const float* b_base() const { return p.w_gate_up + (size_t)e * 2048 * 4096; }
  DI unsigned b_bytes() const { return 2048u * 4096u * 4u; }
  DI int ldb() const { return 4096; }
  DI int b_gcol(int h, int lc) const { return (lc < 64 ? 0 : 2048 - 64) + tn * 128 + 64 * h + lc; }
  DI void epi(int r, int bj, int wc, int fq, const f32x4& v0, const f32x4& v1) const {
    const int rr = m0 + r;
    if (rr >= cnt) return;
    const int a = p.rowlist[e * 8192 + rr];
    const int j0 = tn * 128 + 64 * bj + 16 * wc + 4 * fq;
    const f32x4 bg = *(const f32x4*)(p.b_gate_up + e * 4096 + j0), bu = *(const f32x4*)(p.b_gate_up + e * 4096 + 2048 + j0);
    f32x4 o;
#pragma unroll
    for (int i = 0; i < 4; ++i) {
      const float g = fminf(v0[i] + bg[i], 7.f);
      const float up = fminf(fmaxf(v1[i] + bu[i], -7.f), 7.f);
      const float sg = 1.f / (1.f + __expf(-1.702f * g));
      o[i] = (up + 1.f) * (g * sg);
    }
    st_bf16x4(p.act + (size_t)a * 2048 + j0, o);
  }
};
struct CfgMoe2 {
  const Params& p; int e, m0, tn, cnt;
  static constexpr bool GU = false;
  DI int vrows() const { return cnt - m0; }
  DI int nkt() const { return 32; }
  DI const void* a_base() const { return p.act; }
  DI unsigned a_bytes() const { return (unsigned)NTOK * 4u * 4096u; }
  DI unsigned a_rowoff(int r) const {
    int rr = m0 + r; rr = rr < cnt ? rr : cnt - 1;
    return (unsigned)p.rowlist[e * 8192 + rr] * 4096u;
  }
  DI const float* b_base() const { return p.w_down + (size_t)e * 2048 * 2048; }
  DI unsigned b_bytes() const { return 2048u * 2048u * 4u; }
  DI int ldb() const { return 2048; }
  DI int b_gcol(int h, int lc) const { return tn * 256 + 128 * h + lc; }
  DI void epi(int r, int bj, int wc, int fq, const f32x4& v0, const f32x4& v1) const {
    const int rr = m0 + r;
    if (rr >= cnt) return;
    const int a = p.rowlist[e * 8192 + rr];
    const int gc = tile_gc(tn, bj, wc, fq);
    const float gt = p.gate[a];
    const f32x4 b0 = *(const f32x4*)(p.b_down + e * 2048 + gc), b1 = *(const f32x4*)(p.b_down + e * 2048 + gc + 32);
    st_bf16x4(p.yb + (size_t)a * 2048 + gc, (v0 + b0) * gt);
    st_bf16x4(p.yb + (size_t)a * 2048 + gc + 32, (v1 + b1) * gt);
  }
};
template <int MOE_HOT>
struct CfgMoe1F8T {
  const Params& p; int e, m0, tn, cnt;
  static constexpr bool GU = true;
#if 0
#elif 1
  DI const void* bt_base() const { return p.wq1 + (size_t)(MOE_HOT == 1 ? 0 : e) * 4096 * 2048; }
  DI unsigned bt_rowoff(int h, int R) const { return (unsigned)((((R >> 4) & 1) ? 2048 : 0) + (MOE_HOT == 1 ? 0 : tn) * 128 + 32 * (R >> 5) + 8 * ((R >> 2) & 3) + 4 * h + (R & 3)) * 2048u; }
#elif 0
  DI const void* bt_base() const { return p.wq1 + (size_t)(e & 0) * 4096 * 2048; }
  DI unsigned bt_rowoff(int h, int R) const { return (unsigned)((((R >> 4) & 1) ? 2048 : 0) + (tn & 0) * 128 + 64 * h + 16 * (R >> 5) + (R & 15)) * 2048u; }
#else
  DI const void* bt_base() const { return p.wq1 + (size_t)e * 4096 * 2048; }
  DI unsigned bt_rowoff(int h, int R) const { return (unsigned)((((R >> 4) & 1) ? 2048 : 0) + tn * 128 + 64 * h + 16 * (R >> 5) + (R & 15)) * 2048u; }
#endif
  DI unsigned bt_bytes() const { return 4096u * 2048u; }
  DI int nkt() const { return 16; }
  DI float bmul() const { return 512.f; }
  DI int scale_w() const { return 0x76767676; }
  DI int scale_x() const { return 0x7B7B7B7B; }
  DI const void* a_base() const { return p.h1q; }
  DI unsigned a_bytes() const { return (unsigned)NTOK * 2048u; }
  DI unsigned a_rowoff(int r) const {
    int rr = m0 + r; rr = rr < cnt ? rr : cnt - 1;
    if (MOE_HOT == 2) return (unsigned)r * 2048u + 0u * (unsigned)p.rowlist[e * 8192 + rr];
    return (unsigned)(p.rowlist[e * 8192 + rr] >> 2) * 2048u;
  }
  DI const float* b_base() const { return p.w_gate_up + (size_t)e * 2048 * 4096; }
  DI unsigned b_bytes() const { return 2048u * 4096u * 4u; }
  DI int ldb() const { return 4096; }
  DI int b_gcol(int h, int lc) const { return (lc < 64 ? 0 : 2048 - 64) + tn * 128 + 64 * h + lc; }
  typedef int RowTok;
  struct ColCtx { int j0; f32x4 bg, bu; };
  DI RowTok row_tok(int r) const { const int rr = m0 + r; const int a = p.rowlist[e * 8192 + (rr < cnt ? rr : cnt - 1)]; return rr < cnt ? a : -1; }
  DI ColCtx col_ctx(int bj, int wc, int fq) const {
    ColCtx c; c.j0 = tn * 128 + 32 * wc + 8 * fq + 4 * bj;
    c.bg = *(const f32x4*)(p.b_gate_up + e * 4096 + c.j0); c.bu = *(const f32x4*)(p.b_gate_up + e * 4096 + 2048 + c.j0);
    return c;
  }
  static constexpr bool PAIR_BJ = true;
  DI int glu4(const ColCtx& c, const f32x4& v0, const f32x4& v1) const {
    float o[4];
#pragma unroll
    for (int i = 0; i < 4; ++i) {
      const float g = fminf(v0[i] + c.bg[i], 7.f);
      const float up = __builtin_amdgcn_fmed3f(v1[i] + c.bu[i], -7.f, 7.f);
      const float sg = __builtin_amdgcn_rcpf(1.f + __builtin_amdgcn_exp2f(g * (-1.702f * 1.44269504088896f)));
      o[i] = fmaf(up, 4.f, 4.f) * (g * sg);
    }
    return pack4_fp8(o[0], o[1], o[2], o[3]);
  }
  DI void epi_pair(RowTok a, const ColCtx& c0, const ColCtx& c1, const f32x4& g0, const f32x4& u0, const f32x4& g1, const f32x4& u1) const {
    if (a < 0) return;
    u32x2 pk; pk.x = (unsigned)glu4(c0, g0, u0); pk.y = (unsigned)glu4(c1, g1, u1);
    *(u32x2*)(p.actq + (size_t)a * 2048 + c0.j0) = pk;
  }
  DI void epi_t(RowTok a, const ColCtx& c, const f32x4& v0, const f32x4& v1) const {
    if (a < 0) return;
    float o[4];
#pragma unroll
    for (int i = 0; i < 4; ++i) {
      const float g = fminf(v0[i] + c.bg[i], 7.f);
      const float up = __builtin_amdgcn_fmed3f(v1[i] + c.bu[i], -7.f, 7.f);
      const float sg = __builtin_amdgcn_rcpf(1.f + __builtin_amdgcn_exp2f(g * (-1.702f * 1.44269504088896f)));
      o[i] = fmaf(up, 4.f, 4.f) * (g * sg);
    }
    *(int*)(p.actq + (size_t)a * 2048 + c.j0) = pack4_fp8(o[0], o[1], o[2], o[3]);
  }
  DI void epi(int r, int bj, int wc, int fq, const f32x4& v0, const f32x4& v1) const {
    const int rr = m0 + r;
    if (rr >= cnt) return;
    const int a = p.rowlist[e * 8192 + rr];
    const int j0 = tn * 128 + 64 * bj + 16 * wc + 4 * fq;
    const f32x4 bg = *(const f32x4*)(p.b_gate_up + e * 4096 + j0), bu = *(const f32x4*)(p.b_gate_up + e * 4096 + 2048 + j0);
    float o[4];
#pragma unroll
    for (int i = 0; i < 4; ++i) {
      const float g = fminf(v0[i] + bg[i], 7.f);
      const float up = fminf(fmaxf(v1[i] + bu[i], -7.f), 7.f);
      const float sg = 1.f / (1.f + __expf(-1.702f * g));
      o[i] = fminf(fmaxf((up + 1.f) * (g * sg) * 4.f, -440.f), 440.f);
    }
    *(int*)(p.actq + (size_t)a * 2048 + j0) = pack4_fp8(o[0], o[1], o[2], o[3]);
  }
};
typedef CfgMoe1F8T<0> CfgMoe1F8;
struct CfgMoe2F8 {
  const Params& p; int e, m0, tn, cnt;
  static constexpr bool GU = false;
  DI const void* bt_base() const { return p.wq2 + (size_t)e * 2048 * 2048; }
  DI unsigned bt_bytes() const { return 2048u * 2048u; }
  DI unsigned bt_rowoff(int h, int R) const { return (unsigned)(tn * 256 + 128 * h + tcol_adj(R)) * 2048u; }
  DI int nkt() const { return 16; }
  DI float bmul() const { return 512.f; }
  DI int scale_w() const { return 0x76767676; }
  DI int scale_x() const { return 0x7D7D7D7D; }
  DI const void* a_base() const { return p.actq; }
  DI unsigned a_bytes() const { return (unsigned)NTOK * 4u * 2048u; }
  DI unsigned a_rowoff(int r) const {
    int rr = m0 + r; rr = rr < cnt ? rr : cnt - 1;
    return (unsigned)p.rowlist[e * 8192 + rr] * 2048u;
  }
  DI const float* b_base() const { return p.w_down + (size_t)e * 2048 * 2048; }
  DI unsigned b_bytes() const { return 2048u * 2048u * 4u; }
  DI int ldb() const { return 2048; }
  DI int b_gcol(int h, int lc) const { return tn * 256 + 128 * h + lc; }
  static constexpr bool PAIR_BJ = false;
  struct RowTok { int a; float gt; };
  struct ColCtx { int gc; f32x4 b0, b1; };
  DI RowTok row_tok(int r) const {
    const int rr = m0 + r; const unsigned long long pr = p.rowpair[e * 8192 + (rr < cnt ? rr : cnt - 1)];
    RowTok t; t.a = rr < cnt ? (int)(unsigned)pr : -1; t.gt = __uint_as_float((unsigned)(pr >> 32)); return t;
  }
  DI ColCtx col_ctx(int bj, int wc, int fq) const {
    ColCtx c; c.gc = tn * 256 + 128 * bj + 64 * (wc >> 1) + 32 * (wc & 1) + 8 * fq;
    c.b0 = *(const f32x4*)(p.b_down + e * 2048 + c.gc); c.b1 = *(const f32x4*)(p.b_down + e * 2048 + c.gc + 4);
    return c;
  }
  DI void epi_t(const RowTok& t, const ColCtx& c, const f32x4& v0, const f32x4& v1) const {
    if (t.a < 0) return;
    const f32x4 x0 = (v0 + c.b0) * t.gt, x1 = (v1 + c.b1) * t.gt;
    u32x4 pk; pk.x = pack2(x0[0], x0[1]); pk.y = pack2(x0[2], x0[3]); pk.z = pack2(x1[0], x1[1]); pk.w = pack2(x1[2], x1[3]);
    *(u32x4*)(p.yb + (size_t)t.a * 2048 + c.gc) = pk;
  }
  DI void epi(int r, int bj, int wc, int fq, const f32x4& v0, const f32x4& v1) const {
    const int rr = m0 + r;
    if (rr >= cnt) return;
    const int a = p.rowlist[e * 8192 + rr];
    const int gc = tn * 256 + 128 * bj + 64 * (wc >> 1) + 32 * (wc & 1) + 8 * fq;
    const float gt = p.gate[a];
    const f32x4 b0 = *(const f32x4*)(p.b_down + e * 2048 + gc), b1 = *(const f32x4*)(p.b_down + e * 2048 + gc + 4);
    st_bf16x4(p.yb + (size_t)a * 2048 + gc, (v0 + b0) * gt);
    st_bf16x4(p.yb + (size_t)a * 2048 + gc + 4, (v1 + b1) * gt);
  }
};
template <int WHICH, int PMODE = 0>
DI void phase_moe(const Params& p, LDS_AS unsigned char* lds, int bid, int nb) {
  constexpr int NTN = WHICH == 1 ? 16 : 8;
  MoeSched* sch = (MoeSched*)((char*)lds + G256F8_LDS);
  moe_sched_build(p, sch, NTN, WHICH == 1);
  const int total = sch->base[32];
  const int slot = (bid & 7) * (nb >> 3) + (bid >> 3);
  int ehint = 0;
  auto decode = [&](int u, int& ee, int& m0, int& tn, int& cn) {
    int e = ehint;
    while (u >= sch->base[e + 1]) ++e;
    ehint = e;
    const int loc = u - sch->base[e];
    const int mt = sch->mt[e];
    ee = __builtin_amdgcn_readfirstlane(WHICH == 1 ? 31 - e : e); tn = __builtin_amdgcn_readfirstlane(loc / mt); m0 = __builtin_amdgcn_readfirstlane(loc % mt) * 256;
    cn = __builtin_amdgcn_readfirstlane(sch->cnt[e]);
  };
#if MOE_FP8 == 2
  typedef typename std::conditional<WHICH == 1, CfgMoe1F8T<(PMODE == 3 ? 1 : (PMODE == 4 ? 2 : 0))>, CfgMoe2F8>::type CfgT;
  int u = slot;
  if (u < total) {
    int ee, m0, tn, cn; decode(u, ee, m0, tn, cn);
    CfgT cur{p, ee, m0, tn, cn};
    bool pre = false;
#pragma unroll 1
    for (;;) {
      const int un = u + nb;
      const bool has_next = un < total;
      int e2 = 0, m2 = 0, t2 = 0, c2 = 1;
      if (has_next) decode(un, e2, m2, t2, c2);
      const CfgT nxtc{p, e2, m2, t2, c2};
      const bool tophalf = cur.cnt - cur.m0 <= 128;
      if (pre) { if (tophalf) gemm256f8dma_unit<CfgT, true, true, PMODE>(lds, cur, has_next, nxtc); else gemm256f8dma_unit<CfgT, false, true, PMODE>(lds, cur, has_next, nxtc); }
      else { if (tophalf) gemm256f8dma_unit<CfgT, true, false, PMODE>(lds, cur, has_next, nxtc); else gemm256f8dma_unit<CfgT, false, false, PMODE>(lds, cur, has_next, nxtc); }
      if (!has_next) break;
      cur.e = e2; cur.m0 = m2; cur.tn = t2; cur.cnt = c2; u = un; pre = true;
    }
  }
#else
  for (int u = slot; u < total; u += nb) {
    int ee, m0, tn, cn; decode(u, ee, m0, tn, cn);
    const bool tophalf = cn - m0 <= 128;
#if MOE_FP8
    if (WHICH == 1) { CfgMoe1F8 cfg{p, ee, m0, tn, cn}; if (tophalf) gemm256f8_unit<CfgMoe1F8, true>(lds, cfg); else gemm256f8_unit<CfgMoe1F8, false>(lds, cfg); }
    else { CfgMoe2F8 cfg{p, ee, m0, tn, cn}; if (tophalf) gemm256f8_unit<CfgMoe2F8, true>(lds, cfg); else gemm256f8_unit<CfgMoe2F8, false>(lds, cfg); }
#else
    if (WHICH == 1) { CfgMoe1 cfg{p, ee, m0, tn, cn}; if (tophalf) gemm256_unit<CfgMoe1, 0, true>(lds, cfg); else gemm256_unit<CfgMoe1, 0, false>(lds, cfg); }
    else { CfgMoe2 cfg{p, ee, m0, tn, cn}; if (tophalf) gemm256_unit<CfgMoe2, 0, true>(lds, cfg); else gemm256_unit<CfgMoe2, 0, false>(lds, cfg); }
#endif
  }
#endif
}

DI bf16x8 pack_frag(const f32x16& x, int s) {
  uint4 r;
  r.x = pack2(x[8 * s + 0], x[8 * s + 1]); r.y = pack2(x[8 * s + 2], x[8 * s + 3]);
  r.z = pack2(x[8 * s + 4], x[8 * s + 5]); r.w = pack2(x[8 * s + 6], x[8 * s + 7]);
  return __builtin_bit_cast(bf16x8, r);
}
DI void xhalf(float x, float& lo, float& hi) {
  auto r = __builtin_amdgcn_permlane32_swap(__float_as_uint(x), __float_as_uint(x), false, false);
  lo = __uint_as_float(r[0]); hi = __uint_as_float(r[1]);
}
constexpr int AT_SBK = 0, AT_SBV = 8192, AT_MLK = 16384, AT_MLR = 24576, AT_MLV = 28672, AT_BUF = 36864;
constexpr int AT_LDS = 3 * AT_BUF;

DI void pv_accum2(LDS_AS unsigned char* vimg, int lane, const bf16x8& wf0, const bf16x8& wf1, f32x16 (&o)[4]) {
  const unsigned hh = (unsigned)lane >> 5, q = ((unsigned)lane & 15u) >> 2, pp = (unsigned)lane & 3u, blk = ((unsigned)lane >> 4) & 1u;
#pragma unroll
  for (int d = 0; d < 4; ++d) {
    bf16x8 v[2];
#pragma unroll
    for (int s = 0; s < 2; ++s) {
      const unsigned a0 = offb(16u * s + 4u * hh + q, 4u * d + 2u * blk + (pp >> 1)) + 8u * (pp & 1u);
      const unsigned a1 = offb(16u * s + 8u + 4u * hh + q, 4u * d + 2u * blk + (pp >> 1)) + 8u * (pp & 1u);
      const s16x4 lo = __builtin_amdgcn_ds_read_tr16_b64_v4i16((LDS_AS s16x4*)(vimg + a0));
      const s16x4 hi = __builtin_amdgcn_ds_read_tr16_b64_v4i16((LDS_AS s16x4*)(vimg + a1));
      v[s] = __builtin_shufflevector(lo, hi, 0, 1, 2, 3, 4, 5, 6, 7);
    }
    o[d] = MFMA32(v[0], wf0, o[d]);
    o[d] = MFMA32(v[1], wf1, o[d]);
  }
}

template <bool DIAG>
DI void sb_weights(const f32x16& z, f32x16& w, float& csum, int l31, int hh) {
  const float c2 = 0.12751743074602268f;
  float sp[16], ls[16];
#pragma unroll
  for (int i = 0; i < 16; ++i) {
    const float t = z[i] * c2;
    const float u = __builtin_amdgcn_exp2f(-fabsf(t));
    const float spv = fmaxf(t, 0.f) + __builtin_amdgcn_logf(1.f + u);
    ls[i] = t - spv;
    sp[i] = (!DIAG || (crow(i, hh) < l31)) ? spv : 0.f;
  }
  float R[4], Rp[4];
#pragma unroll
  for (int g = 0; g < 4; ++g) { R[g] = (sp[4 * g] + sp[4 * g + 1]) + (sp[4 * g + 2] + sp[4 * g + 3]); float lo, hi; xhalf(R[g], lo, hi); Rp[g] = hh ? lo : hi; }
  float later = 0.f;
#pragma unroll
  for (int g = 3; g >= 0; --g) {
    const float base = csum + later + (hh == 0 ? Rp[g] : 0.f);
    float sfx = 0.f;
#pragma unroll
    for (int e = 3; e >= 0; --e) {
      const int i = 4 * g + e;
      const float wv = __builtin_amdgcn_exp2f(ls[i] - (base + sfx));
      w[i] = (!DIAG || (crow(i, hh) < l31)) ? wv : 0.f;
      sfx += sp[i];
    }
    later += R[g] + Rp[g];
  }
  csum += later;
}

struct AttnCtx {
  __amdgpu_buffer_rsrc_t rsQKV, rsMKV, rsKR;
  unsigned ldsb; int wv, lane;
  unsigned voff_sbk, voff_sbv, voff_mlk, voff_mlv, voff_r;
  int b, hd;
};
#define AT_DMA(rs, voff, soff, m0v) asm volatile("s_mov_b32 m0, %0\n\ts_nop 4\n\tbuffer_load_dwordx4 %1, %2, %3 offen lds" :: "s"(m0v), "v"(voff), "s"(rs), "s"(soff) : "m0", "memory")
DI void attn_issue(const AttnCtx& c, int kb, int bufsel) {
  const unsigned tok = (unsigned)(c.b * SEQ + kb * 32);
  const unsigned bb = c.ldsb + (unsigned)bufsel * AT_BUF + (unsigned)c.wv * 1024u;
  AT_DMA(c.rsQKV, c.voff_sbk, tok * 6144u, bb + AT_SBK); AT_DMA(c.rsQKV, c.voff_sbv, tok * 6144u, bb + AT_SBV);
  AT_DMA(c.rsMKV, c.voff_mlk, tok * 4096u, bb + AT_MLK); AT_DMA(c.rsMKV, c.voff_mlv, tok * 4096u, bb + AT_MLV);
  if (c.wv < 4) AT_DMA(c.rsKR, c.voff_r, tok * 128u, bb + AT_MLR);
}
DI void attn_step_end() { asm volatile("s_waitcnt vmcnt(0)" ::: "memory"); __builtin_amdgcn_s_barrier(); }
DI void attn_step_end_sb() { asm volatile("s_waitcnt vmcnt(5)" ::: "memory"); __builtin_amdgcn_s_barrier(); }
DI void attn_step_end_ml() { asm volatile("s_waitcnt vmcnt(4)" ::: "memory"); __builtin_amdgcn_s_barrier(); }

DI void attn_sb_item(const Params& p, LDS_AS unsigned char* lds, const AttnCtx& c, int qb, int nsteps) {
  const int lane = c.lane, l31 = lane & 31, hh = lane >> 5;
  const size_t tokbase = (size_t)c.b * SEQ;
  bf16x8 qf[8];
  {
    const bf16_t* qp = p.qkv + (tokbase + qb * 32 + l31) * 3072 + c.hd * 128 + 8 * hh;
#pragma unroll
    for (int s = 0; s < 8; ++s) qf[s] = *(const bf16x8*)(qp + 16 * s);
  }
  f32x16 o[4];
#pragma unroll
  for (int d = 0; d < 4; ++d)
#pragma unroll
    for (int i = 0; i < 16; ++i) o[d][i] = 0.f;
  float csum = 0.f;
  attn_issue(c, nsteps - 1, 0);
  attn_issue(c, nsteps - 2, 1);
  attn_step_end_sb();
  int s = 0, rb = 0;
  const int nskip = nsteps - 1 - qb;
#pragma unroll 1
  for (; s < nskip; ++s) { if (s + 2 < nsteps) { attn_issue(c, nsteps - 3 - s, rb == 0 ? 2 : rb - 1); attn_step_end_sb(); } else attn_step_end(); rb = rb == 2 ? 0 : rb + 1; }
#pragma unroll 1
  for (; s < nsteps; ++s) {
    const int kb = nsteps - 1 - s;
    if (s + 2 < nsteps) { attn_issue(c, kb - 2, rb == 0 ? 2 : rb - 1); }
    LDS_AS unsigned char* Bf = lds + rb * AT_BUF;
    bf16x8 kf[8];
#pragma unroll
    for (int ks = 0; ks < 8; ++ks) kf[ks] = *(const LDS_AS bf16x8*)(Bf + AT_SBK + offb((unsigned)l31, (unsigned)(2 * ks + hh)));
    __builtin_amdgcn_sched_barrier(0);
    f32x16 z;
#pragma unroll
    for (int i = 0; i < 16; ++i) z[i] = 0.f;
#pragma unroll
    for (int ks = 0; ks < 8; ++ks) z = MFMA32(kf[ks], qf[ks], z);
    f32x16 w;
    if (kb == qb) sb_weights<true>(z, w, csum, l31, hh); else sb_weights<false>(z, w, csum, l31, hh);
    const bf16x8 wf0 = pack_frag(w, 0), wf1 = pack_frag(w, 1);
    pv_accum2(Bf + AT_SBV, lane, wf0, wf1, o);
    if (s + 2 < nsteps) attn_step_end_sb(); else attn_step_end();
    rb = rb == 2 ? 0 : rb + 1;
  }
  bf16_t* op = p.oA + (tokbase + qb * 32 + l31) * 1024 + c.hd * 128;
#pragma unroll
  for (int d = 0; d < 4; ++d)
#pragma unroll
    for (int g = 0; g < 4; g += 2) {
      unsigned ax = pack2(o[d][4 * g], o[d][4 * g + 1]), ay = pack2(o[d][4 * g + 2], o[d][4 * g + 3]);
      unsigned bx = pack2(o[d][4 * g + 4], o[d][4 * g + 5]), by = pack2(o[d][4 * g + 6], o[d][4 * g + 7]);
      { auto r = __builtin_amdgcn_permlane32_swap(ax, bx, false, false); ax = r[0]; bx = r[1]; }
      { auto r = __builtin_amdgcn_permlane32_swap(ay, by, false, false); ay = r[0]; by = r[1]; }
      *(uint4*)(op + d * 32 + 8 * g + 8 * hh) = make_uint4(ax, ay, bx, by);
    }
}

DI void attn_mla_item(const Params& p, LDS_AS unsigned char* lds, const AttnCtx& c, int qb, int nsteps) {
  const int lane = c.lane, l31 = lane & 31, hh = lane >> 5;
  const size_t tokbase = (size_t)c.b * SEQ;
  bf16x8 qf[12];
  {
    const bf16_t* qp = p.mq + (tokbase + qb * 32 + l31) * 1536 + c.hd * 192 + 8 * hh;
#pragma unroll
    for (int s = 0; s < 12; ++s) qf[s] = *(const bf16x8*)(qp + 16 * s);
  }
  f32x16 o[4];
#pragma unroll
  for (int d = 0; d < 4; ++d)
#pragma unroll
    for (int i = 0; i < 16; ++i) o[d][i] = 0.f;
  float mrun = -1e30f, lrun = 0.f;
  attn_issue(c, nsteps - 1, 0);
  attn_issue(c, nsteps - 2, 1);
  attn_step_end_ml();
  int s = 0, rb = 0;
  const int nskip = nsteps - ((qb >> 1) + 1) * 2;
#pragma unroll 1
  for (; s < nskip; ++s) { if (s + 2 < nsteps) { attn_issue(c, nsteps - 3 - s, rb == 0 ? 2 : rb - 1); attn_step_end_ml(); } else attn_step_end(); rb = rb == 2 ? 0 : rb + 1; }
#pragma unroll 1
  for (; s < nsteps; ++s) {
    const int kb = nsteps - 1 - s;
    if (s + 2 < nsteps) { attn_issue(c, kb - 2, rb == 0 ? 2 : rb - 1); }
    LDS_AS unsigned char* Bf = lds + rb * AT_BUF;
    bf16x8 kf[12];
#pragma unroll
    for (int ks = 0; ks < 8; ++ks) kf[ks] = *(const LDS_AS bf16x8*)(Bf + AT_MLK + offb((unsigned)l31, (unsigned)(2 * ks + hh)));
#pragma unroll
    for (int ks = 0; ks < 4; ++ks) kf[8 + ks] = *(const LDS_AS bf16x8*)(Bf + AT_MLR + 128u * (unsigned)l31 + 16u * ((unsigned)(2 * ks + hh) ^ ((unsigned)l31 & 7u)));
    __builtin_amdgcn_sched_barrier(0);
    f32x16 z;
#pragma unroll
    for (int i = 0; i < 16; ++i) z[i] = 0.f;
#pragma unroll
    for (int ks = 0; ks < 12; ++ks) z = MFMA32(kf[ks], qf[ks], z);
    const float c2 = 0.10411754584378834f;
    float mx = fmaxf(fmaxf(z[0], z[1]), fmaxf(z[2], z[3]));
#pragma unroll
    for (int i = 4; i < 16; i += 2) mx = fmaxf(mx, fmaxf(z[i], z[i + 1]));
    { float lo, hi; xhalf(mx, lo, hi); mx = fmaxf(lo, hi) * c2; }
    if (__builtin_amdgcn_ballot_w64(mx - mrun > 8.f) != 0ull) {
      const float mnew = fmaxf(mrun, mx);
      const float alpha = __builtin_amdgcn_exp2f(mrun - mnew);
      lrun *= alpha; mrun = mnew;
#pragma unroll
      for (int d = 0; d < 4; ++d)
#pragma unroll
        for (int i = 0; i < 16; ++i) o[d][i] *= alpha;
    }
    float ls = 0.f;
#pragma unroll
    for (int i = 0; i < 16; ++i) { z[i] = __builtin_amdgcn_exp2f(fmaf(z[i], c2, -mrun)); ls += z[i]; }
    { float lo, hi; xhalf(ls, lo, hi); ls = lo + hi; }
    lrun += ls;
    const bf16x8 wf0 = pack_frag(z, 0), wf1 = pack_frag(z, 1);
    pv_accum2(Bf + AT_MLV, lane, wf0, wf1, o);
    if (s + 2 < nsteps) attn_step_end_ml(); else attn_step_end();
    rb = rb == 2 ? 0 : rb + 1;
  }
  const float inv = 1.f / lrun;
  bf16_t* op = p.oB + (tokbase + qb * 32 + l31) * 1024 + c.hd * 128;
#pragma unroll
  for (int d = 0; d < 4; ++d)
#pragma unroll
    for (int g = 0; g < 4; g += 2) {
      unsigned ax = pack2(o[d][4 * g] * inv, o[d][4 * g + 1] * inv), ay = pack2(o[d][4 * g + 2] * inv, o[d][4 * g + 3] * inv);
      unsigned bx = pack2(o[d][4 * g + 4] * inv, o[d][4 * g + 5] * inv), by = pack2(o[d][4 * g + 6] * inv, o[d][4 * g + 7] * inv);
      { auto r = __builtin_amdgcn_permlane32_swap(ax, bx, false, false); ax = r[0]; bx = r[1]; }
      { auto r = __builtin_amdgcn_permlane32_swap(ay, by, false, false); ay = r[0]; by = r[1]; }
      *(uint4*)(op + d * 32 + 8 * g + 8 * hh) = make_uint4(ax, ay, bx, by);
    }
}

DI void phase_attn(const Params& p, LDS_AS unsigned char* lds, char* smem, int bid, int nb) {
  const int tid = OPAQUE_TID(p);
  AttnCtx c;
  c.wv = __builtin_amdgcn_readfirstlane(tid >> 6); c.lane = tid & 63;
  const int w4 = c.wv & 3;
  c.ldsb = (unsigned)__builtin_amdgcn_readfirstlane((int)(unsigned)(size_t)lds);
  c.rsQKV = __builtin_amdgcn_make_buffer_rsrc((void*)p.qkv, 0, (unsigned)NTOK * 6144u, 0x00020000);
  c.rsMKV = __builtin_amdgcn_make_buffer_rsrc((void*)p.mkv, 0, (unsigned)NTOK * 4096u, 0x00020000);
  c.rsKR = __builtin_amdgcn_make_buffer_rsrc((void*)p.krope, 0, (unsigned)NTOK * 128u, 0x00020000);
  const unsigned drow = 4u * c.wv + ((unsigned)c.lane >> 4), dchp = (unsigned)c.lane & 15u;
  const unsigned dch = dchp ^ (((drow & 3u) << 2) | ((drow >> 2) & 3u));
  const unsigned rrow = 8u * w4 + ((unsigned)c.lane >> 3), rch = ((unsigned)c.lane & 7u) ^ (rrow & 7u);
#pragma unroll 1
  for (int rnd = 0; rnd * nb < 512; ++rnd) {
    const int s = __builtin_amdgcn_readfirstlane(rnd * nb + ((rnd & 1) ? nb - 1 - bid : bid));
    if (s >= 512) break;
    const int q8 = ((rnd & 1) && (nb & 7) == 0) ? 7 - (s & 7) : (s & 7);
    const int bh = q8 * 4 + ((s >> 3) & 3), ch = 15 - (s >> 5);
    c.b = bh >> 3; c.hd = bh & 7;
    c.voff_sbk = drow * 6144u + (unsigned)(1024 + c.hd * 128) * 2u + dch * 16u;
    c.voff_sbv = drow * 6144u + (unsigned)(2048 + c.hd * 128) * 2u + dch * 16u;
    c.voff_mlk = drow * 4096u + (unsigned)(c.hd * 256) * 2u + dch * 16u;
    c.voff_mlv = drow * 4096u + (unsigned)(c.hd * 256 + 128) * 2u + dch * 16u;
    c.voff_r = rrow * 128u + rch * 16u;
    if (c.wv < 4) attn_sb_item(p, lds, c, 4 * ch + w4, 4 * ch + 4);
    else attn_mla_item(p, lds, c, 4 * ch + w4, 4 * ch + 4);
  }
}
#undef AT_DMA

DI void phase_attn_norm(const Params& p, int bid, int nb) {
  const int tid_ = OPAQUE_TID(p), lane = tid_ & 63, wv = tid_ >> 6;
  for (int t = bid * NWAVES + wv; t < NTOK; t += nb * NWAVES) {
#pragma unroll
    for (int grp = 0; grp < 2; ++grp) {
      const bf16_t* src = (grp ? p.oB : p.oA) + (size_t)t * 1024 + lane * 16;
      const float* g = (grp ? p.mla_out_norm : p.sb_out_norm) + lane * 16;
      const uint4 a0 = *(const uint4*)src, a1 = *(const uint4*)(src + 8);
      float v[16] = {bflo(a0.x), bfhi(a0.x), bflo(a0.y), bfhi(a0.y), bflo(a0.z), bfhi(a0.z), bflo(a0.w), bfhi(a0.w),
                     bflo(a1.x), bfhi(a1.x), bflo(a1.y), bfhi(a1.y), bflo(a1.z), bfhi(a1.z), bflo(a1.w), bfhi(a1.w)};
      float s = 0.f;
#pragma unroll
      for (int i = 0; i < 16; ++i) s += v[i] * v[i];
      s = wave_sum(s);
      const float rs = rsqrtf(s * (1.f / 1024.f) + RMS_EPS);
      uint4 o0, o1;
      o0.x = pack2(v[0] * rs * g[0], v[1] * rs * g[1]); o0.y = pack2(v[2] * rs * g[2], v[3] * rs * g[3]);
      o0.z = pack2(v[4] * rs * g[4], v[5] * rs * g[5]); o0.w = pack2(v[6] * rs * g[6], v[7] * rs * g[7]);
      o1.x = pack2(v[8] * rs * g[8], v[9] * rs * g[9]); o1.y = pack2(v[10] * rs * g[10], v[11] * rs * g[11]);
      o1.z = pack2(v[12] * rs * g[12], v[13] * rs * g[13]); o1.w = pack2(v[14] * rs * g[14], v[15] * rs * g[15]);
      bf16_t* dst = p.on + (size_t)t * 2048 + grp * 1024 + lane * 16;
      *(uint4*)dst = o0; *(uint4*)(dst + 8) = o1;
    }
  }
}

template <bool DRY = false>
DI void phase_ln_router(const Params& p, char* smem, int bid, int nb) {
  float* hs = (float*)smem;
  float* red = hs + 8 * 2048;
  float* lg = red + 32 * 8 * 32;
  int* lcnt = (int*)(lg + 8 * 32);
  int* lbase = lcnt + 32;
  int* lasg = lbase + 32;
  int* lnum = lasg + 1024;
  float* lgate = (float*)(lnum + 4);
  const int tid = OPAQUE_TID(p), lane = tid & 63, wv = tid >> 6;
  const int e = tid & 15, ks = tid >> 4;
  f32x2_t wr[64];
#pragma unroll
  for (int i = 0; i < 64; ++i) { wr[i][0] = p.w_router[(size_t)(ks * 64 + i) * 32 + e]; wr[i][1] = p.w_router[(size_t)(ks * 64 + i) * 32 + e + 16]; }
  if (tid < 32) lcnt[tid] = 0;
  if (tid == 32) lnum[0] = 0;
  __syncthreads();
  u32x2 za[8];
  {
    const int tf = bid * 8 + wv;
    const bf16_t* zr = p.z1b + (size_t)(tf < NTOK ? tf : 0) * DM;
#pragma unroll
    for (int i = 0; i < 8; ++i) za[i] = *(const u32x2*)(zr + (i * 64 + lane) * 4);
  }
  for (int t0 = bid * 8; t0 < NTOK; t0 += nb * 8) {
    const int t = t0 + wv;
    {
      float v[32];
#pragma unroll
      for (int i = 0; i < 8; ++i) {
        const u32x2 a = za[i];
        v[4 * i] = bflo(a.x); v[4 * i + 1] = bfhi(a.x); v[4 * i + 2] = bflo(a.y); v[4 * i + 3] = bfhi(a.y);
      }
      {
        const int tn2 = t + nb * 8;
        const bf16_t* zr = p.z1b + (size_t)(tn2 < NTOK ? tn2 : t) * DM;
#pragma unroll
        for (int i = 0; i < 8; ++i) za[i] = *(const u32x2*)(zr + (i * 64 + lane) * 4);
      }
      float s = 0.f;
#pragma unroll
      for (int i = 0; i < 32; ++i) s += v[i];
      s = wave_sum(s);
      const float mu = s * (1.f / 2048.f);
      float q = 0.f;
#pragma unroll
      for (int i = 0; i < 32; ++i) { const float d = v[i] - mu; q += d * d; }
      q = wave_sum(q);
      const float rs = rsqrtf(q * (1.f / 2048.f) + LN_EPS);
#pragma unroll
      for (int i = 0; i < 8; ++i) {
        const int c = (i * 64 + lane) * 4;
        const float4 gg = *(const float4*)(p.ln_mix_g + c);
        const float4 bb = *(const float4*)(p.ln_mix_b + c);
        float4 o;
        o.x = (v[4 * i + 0] - mu) * rs * gg.x + bb.x;
        o.y = (v[4 * i + 1] - mu) * rs * gg.y + bb.y;
        o.z = (v[4 * i + 2] - mu) * rs * gg.z + bb.z;
        o.w = (v[4 * i + 3] - mu) * rs * gg.w + bb.w;
        { uint2 pk; pk.x = pack2(o.x, o.y); pk.y = pack2(o.z, o.w); *(uint2*)(p.h1b + (size_t)t * DM + c) = pk; }
#if MOE_FP8
        {
          int pq = 0;
          pq = __builtin_amdgcn_cvt_pk_fp8_f32(fminf(fmaxf(o.x * 16.f, -440.f), 440.f), fminf(fmaxf(o.y * 16.f, -440.f), 440.f), pq, false);
          pq = __builtin_amdgcn_cvt_pk_fp8_f32(fminf(fmaxf(o.z * 16.f, -440.f), 440.f), fminf(fmaxf(o.w * 16.f, -440.f), 440.f), pq, true);
          *(int*)(p.h1q + (size_t)t * DM + c) = pq;
        }
#endif
        *(float4*)(hs + wv * 2048 + c) = o;
      }
    }
    __syncthreads();
    {
      f32x2_t acc[8];
#pragma unroll
      for (int j = 0; j < 8; ++j) acc[j] = (f32x2_t){0.f, 0.f};
#pragma unroll
      for (int j = 0; j < 8; ++j) {
#pragma unroll
        for (int i4 = 0; i4 < 16; ++i4) {
          const float4 h = *(const float4*)(hs + j * 2048 + ks * 64 + 4 * i4);
          acc[j] = __builtin_elementwise_fma((f32x2_t){h.x, h.x}, wr[4 * i4], acc[j]); acc[j] = __builtin_elementwise_fma((f32x2_t){h.y, h.y}, wr[4 * i4 + 1], acc[j]);
          acc[j] = __builtin_elementwise_fma((f32x2_t){h.z, h.z}, wr[4 * i4 + 2], acc[j]); acc[j] = __builtin_elementwise_fma((f32x2_t){h.w, h.w}, wr[4 * i4 + 3], acc[j]);
          if ((i4 & 7) == 7) __builtin_amdgcn_sched_barrier(0);
        }
      }
#pragma unroll
      for (int j = 0; j < 8; ++j) { red[(ks * 8 + j) * 32 + e] = acc[j][0]; red[(ks * 8 + j) * 32 + e + 16] = acc[j][1]; }
    }
    __syncthreads();
    if (tid < 256) {
      const int e2 = tid & 31, j = tid >> 5;
      float s = 0.f;
#pragma unroll
      for (int k2 = 0; k2 < 32; ++k2) s += red[(k2 * 8 + j) * 32 + e2];
      lg[j * 32 + e2] = s + p.b_router[e2];
    }
    __syncthreads();
    {
      float val = (lane < 32) ? lg[wv * 32 + lane] : -3.0e38f;
      float tv[4]; int ti[4];
#pragma unroll
      for (int k = 0; k < 4; ++k) {
        const float m = wave_max(val);
        const unsigned long long bal = __ballot(val == m);
        const int idx = __ffsll((long long)bal) - 1;
        tv[k] = m; ti[k] = idx;
        if (lane == idx) val = -3.0e38f;
      }
      const float e1 = __expf(tv[1] - tv[0]), e2 = __expf(tv[2] - tv[0]), e3 = __expf(tv[3] - tv[0]);
      const float inv = 1.f / (1.f + e1 + e2 + e3);
      if (lane < 4) {
        const float gk = (lane == 0 ? 1.f : lane == 1 ? e1 : lane == 2 ? e2 : e3) * inv;
        const int ek = lane == 0 ? ti[0] : lane == 1 ? ti[1] : lane == 2 ? ti[2] : ti[3];
        const int rank = atomicAdd(lcnt + ek, 1);
        const int slot = atomicAdd(lnum, 1);
        if (slot < 1024) { lasg[slot] = ((t * 4 + lane) << 16) | (ek << 11) | rank; lgate[slot] = gk; }
        p.gate[t * 4 + lane] = gk;
      }
    }
    __syncthreads();
  }
  if (DRY) return;
  if (tid < 32) lbase[tid] = atomicAdd(p.cnt + tid * 32, lcnt[tid]);
  __syncthreads();
  {
    const int n = lnum[0] < 1024 ? lnum[0] : 1024;
    for (int i = tid; i < n; i += NTHREADS) {
      const int v = lasg[i], a = (int)((unsigned)v >> 16), ek = (v >> 11) & 31, rank = v & 2047;
      p.rowlist[ek * 8192 + lbase[ek] + rank] = a;
      p.rowpair[ek * 8192 + lbase[ek] + rank] = ((unsigned long long)__float_as_uint(lgate[i]) << 32) | (unsigned)a;
    }
  }
  __syncthreads();
}

DI void phase_final(const Params& p, int bid, int nb) {
  const int tid_ = OPAQUE_TID(p), lane = tid_ & 63, wv = tid_ >> 6;
  for (int t = bid * NWAVES + wv; t < NTOK; t += nb * NWAVES) {
    float v[32];
    const bf16_t* hr = p.h1b + (size_t)t * DM;
#pragma unroll
    for (int i = 0; i < 4; ++i) {
      const int c = (i * 64 + lane) * 8;
      const u32x4 ab = *(const u32x4*)(hr + c);
      float s[8];
      s[0] = DN_ALPHA * bflo(ab.x); s[1] = DN_ALPHA * bfhi(ab.x); s[2] = DN_ALPHA * bflo(ab.y); s[3] = DN_ALPHA * bfhi(ab.y);
      s[4] = DN_ALPHA * bflo(ab.z); s[5] = DN_ALPHA * bfhi(ab.z); s[6] = DN_ALPHA * bflo(ab.w); s[7] = DN_ALPHA * bfhi(ab.w);
#pragma unroll
      for (int k = 0; k < 4; ++k) {
        const u32x4 y = *(const u32x4*)(p.yb + (size_t)(t * 4 + k) * 2048 + c);
        s[0] += bflo(y.x); s[1] += bfhi(y.x); s[2] += bflo(y.y); s[3] += bfhi(y.y);
        s[4] += bflo(y.z); s[5] += bfhi(y.z); s[6] += bflo(y.w); s[7] += bfhi(y.w);
      }
#pragma unroll
      for (int j = 0; j < 8; ++j) v[8 * i + j] = s[j];
    }
    float sum = 0.f;
#pragma unroll
    for (int i = 0; i < 32; ++i) sum += v[i];
    sum = wave_sum(sum);
    const float mu = sum * (1.f / 2048.f);
    float q = 0.f;
#pragma unroll
    for (int i = 0; i < 32; ++i) { const float d = v[i] - mu; q += d * d; }
    q = wave_sum(q);
    const float rs = rsqrtf(q * (1.f / 2048.f) + LN_EPS);
    float* outr = p.out + (size_t)t * DM;
#pragma unroll
    for (int i = 0; i < 4; ++i) {
      const int c = (i * 64 + lane) * 8;
#pragma unroll
      for (int h = 0; h < 2; ++h) {
        const float4 gg = *(const float4*)(p.ln_ffn_g + c + 4 * h);
        const float4 bb = *(const float4*)(p.ln_ffn_b + c + 4 * h);
        float4 o;
        o.x = (v[8 * i + 4 * h + 0] - mu) * rs * gg.x + bb.x;
        o.y = (v[8 * i + 4 * h + 1] - mu) * rs * gg.y + bb.y;
        o.z = (v[8 * i + 4 * h + 2] - mu) * rs * gg.z + bb.z;
        o.w = (v[8 * i + 4 * h + 3] - mu) * rs * gg.w + bb.w;
        *(float4*)(outr + c + 4 * h) = o;
      }
    }
  }
}

constexpr int MK_LDS = 163840;
extern __shared__ __attribute__((aligned(16))) char dyn_smem[];

__global__ void __launch_bounds__(NTHREADS, 2) k_forward(Params p_in) {
  Params p = p_in;
  p.wid0 = __builtin_amdgcn_readfirstlane((int)(threadIdx.x >> 6));
  if (threadIdx.x == 0) *(uint4*)dyn_smem = make_uint4(0u, 0u, 0u, 0u);
  __syncthreads();
  char* smem = dyn_smem + 16;
  LDS_AS unsigned char* lds = (LDS_AS unsigned char*)(dyn_smem + 16);
  const int bid = blockIdx.x, nb = gridDim.x;
  const bool roles = (nb & 7) == 0 && nb >= 64;
  int ncv = 0, cv_before = 0;
  bool is_cv = false;
  if (roles) {
    const int j = bid >> 3;
    for (int i = 0; i < (nb >> 3); ++i) { const bool c = ((i * 5) & 15) < CV_PER_16; ncv += c ? 8 : 0; cv_before += (c && i < j) ? 8 : 0; if (i == j) is_cv = c; }
  }
  int cvid = cv_before + (bid & 7);
  const int extra = (roles && ((((nb >> 3) - 1) * 5) & 15) >= CV_PER_16) ? CV_EXTRA : 0;
  if (extra > 0 && bid >= nb - extra) { is_cv = true; cvid = ncv + (bid - (nb - extra)); }
  ncv += extra;
  const int nc = nb - ncv;
  const int cbid = (bid & ~7) - cv_before + (bid & 7);
  const int nca = roles ? (nc & ~7) : nc;
  XcdBarrier bar = xcd_barrier_post(p.bar, (volatile LAS unsigned*)dyn_smem, (unsigned)nb);
#if JOIN_LATE
  phase_ln_in(p, bid, nb);
  phase_convert(p, smem, bid, nb);
  xcd_barrier(bar);
#endif
  if (is_cv) {
    {
      volatile LAS unsigned* stw = (volatile LAS unsigned*)dyn_smem;
      const unsigned s0 = stw[0], s1 = stw[1];
      __syncthreads();
      convert_experts_dma<5>(p, (LDS_AS unsigned char*)dyn_smem, cvid, ncv);
#if CV_REPEAT == 2
      convert_experts_dma<5>(p, (LDS_AS unsigned char*)dyn_smem, cvid, ncv);
#elif CV_REPEAT == 3
      convert_experts_dma<5, true>(p, (LDS_AS unsigned char*)dyn_smem, cvid, ncv);
#endif
      if (threadIdx.x == 0) { stw[0] = s0; stw[1] = s1; stw[2] = 0u; stw[3] = 0u; }
      __syncthreads();
    }
  } else {
    XcdBarrier barc = xcd_barrier_post(p.bar + XCD_BAR_WORDS, (volatile LAS unsigned*)dyn_smem + 2, (unsigned)nc);
#if !JOIN_LATE
    phase_ln_in(p, cbid, nc);
    phase_convert(p, smem, cbid, nc);
    xcd_barrier(barc);
#endif
    phase_in_proj(p, lds, smem, cbid, nc);
    xcd_barrier(barc);
    phase_norm_latents(p, cbid, nc);
    xcd_barrier(barc);
    phase_mla_proj(p, lds, smem, cbid, nc);
    xcd_barrier(barc);
    if (cbid < nca) phase_attn(p, lds, smem, cbid, nca);
    xcd_barrier(barc);
    phase_attn_norm(p, cbid, nc);
#if JOIN_LATE == 1
    xcd_barrier(barc);
    phase_wo(p, lds, smem, cbid, nc);
#endif
    if (ncv == 0) convert_experts_dma<4>(p, lds, bid, nb);
  }
  xcd_barrier(bar);
#if JOIN_LATE != 1
  phase_wo(p, lds, smem, bid, nb);
  xcd_barrier(bar);
#endif
  phase_ln_router(p, smem, bid, nb);
  xcd_barrier(bar);
#if MOE_PROBE
  phase_moe<1, MOE_PROBE>(p, lds, bid, nb);
  xcd_barrier(bar);
#endif
  phase_moe<1>(p, lds, bid, nb);
  xcd_barrier(bar);
  phase_moe<2>(p, lds, bid, nb);
  xcd_barrier(bar);
  phase_final(p, bid, nb);
}

extern "C" void kernel_launch(void* const* d_in, const int* in_sizes, int n_in, void* d_out, int out_size, void* d_ws,
                              size_t ws_size, hipStream_t stream) {
  Params p{};
  p.x = (const float*)d_in[0]; p.pos = (const int*)d_in[1]; p.ln_in_g = (const float*)d_in[2]; p.ln_in_b = (const float*)d_in[3];
  p.w_in = (const float*)d_in[4]; p.q_a_norm = (const float*)d_in[5]; p.w_q_b = (const float*)d_in[6];
  p.kv_a_norm = (const float*)d_in[7]; p.w_kv_b = (const float*)d_in[8]; p.sb_out_norm = (const float*)d_in[9];
  p.mla_out_norm = (const float*)d_in[10]; p.w_o = (const float*)d_in[11]; p.ln_mix_g = (const float*)d_in[12];
  p.ln_mix_b = (const float*)d_in[13]; p.w_router = (const float*)d_in[14]; p.b_router = (const float*)d_in[15];
  p.w_gate_up = (const float*)d_in[16]; p.b_gate_up = (const float*)d_in[17]; p.w_down = (const float*)d_in[18];
  p.b_down = (const float*)d_in[19]; p.ln_ffn_g = (const float*)d_in[20]; p.ln_ffn_b = (const float*)d_in[21];
  p.out = (float*)d_out;
  char* w = (char*)d_ws;
  size_t off = 0;
  auto take = [&](size_t bytes) { char* r = w + off; off += (bytes + 255) & ~(size_t)255; return r; };
  constexpr size_t ZERO_BYTES = 2 * XCD_BAR_WORDS * 4 + 4096;
  p.bar = (unsigned*)take(ZERO_BYTES);
  p.cnt = (int*)((char*)p.bar + 2 * XCD_BAR_WORDS * 4);
  p.h0f = (float*)take((size_t)NTOK * DM * 4);
  p.h0b = (bf16_t*)take((size_t)NTOK * DM * 2);
  p.qkv = (bf16_t*)take((size_t)NTOK * 3072 * 2);
  p.qlat = (bf16_t*)take((size_t)NTOK * 512 * 2);
  p.kvlat = (bf16_t*)take((size_t)NTOK * 256 * 2);
  p.krope = (bf16_t*)take((size_t)NTOK * 64 * 2);
  p.qn = (bf16_t*)take((size_t)NTOK * 512 * 2);
  p.kvn = (bf16_t*)take((size_t)NTOK * 256 * 2);
  p.mq = (bf16_t*)take((size_t)NTOK * 1536 * 2);
  p.mkv = (bf16_t*)take((size_t)NTOK * 2048 * 2);
  p.oA = (bf16_t*)take((size_t)NTOK * 1024 * 2);
  p.oB = (bf16_t*)take((size_t)NTOK * 1024 * 2);
  p.on = (bf16_t*)take((size_t)NTOK * 2048 * 2);
  p.z1 = nullptr;
  p.z1b = (bf16_t*)take((size_t)NTOK * DM * 2);
  p.h1f = (float*)take((size_t)NTOK * DM * 4);
  p.h1b = (bf16_t*)take((size_t)NTOK * DM * 2);
  p.gate = (float*)take((size_t)NTOK * 4 * 4);
  p.rowlist = (int*)take((size_t)32 * 8192 * 4);
  p.rowpair = (unsigned long long*)take((size_t)32 * 8192 * 8);
  p.act = (bf16_t*)take((size_t)NTOK * 4 * 2048 * 2);
  p.yb = (bf16_t*)take((size_t)NTOK * 4 * 2048 * 2);
  p.h1q = (unsigned char*)take((size_t)NTOK * 2048);
  p.wq1 = (unsigned char*)take((size_t)32 * 4096 * 2048);
  p.wq2 = (unsigned char*)take((size_t)32 * 2048 * 2048);
  p.cvdump = (unsigned char*)take((size_t)64 * 2048);
  p.wt_in = (bf16_t*)take((size_t)4096 * 2048 * 2);
  p.wt_o = (bf16_t*)take((size_t)2048 * 2048 * 2);
  p.wt_q = (bf16_t*)take((size_t)1536 * 512 * 2);
  p.wt_kv = (bf16_t*)take((size_t)2048 * 256 * 2);
  p.actq = (unsigned char*)take((size_t)NTOK * 4 * 2048);

  static int grid = 0;
  if (!grid) {
    int dev = 0, cus = 0, per_cu = 0;
    (void)hipGetDevice(&dev);
    (void)hipDeviceGetAttribute(&cus, hipDeviceAttributeMultiprocessorCount, dev);
    (void)hipFuncSetAttribute((const void*)k_forward, hipFuncAttributeMaxDynamicSharedMemorySize, MK_LDS);
    (void)hipOccupancyMaxActiveBlocksPerMultiprocessor(&per_cu, (const void*)k_forward, NTHREADS, MK_LDS);
    grid = cus * (per_cu < 1 ? per_cu : 1);
  }
  (void)hipMemsetAsync(p.bar, 0, ZERO_BYTES, stream);
  if (grid > 0) k_forward<<<grid, NTHREADS, MK_LDS, stream>>>(p);
}
```
